# Optimizing an MI355X kernel written in HIP

```python
import jax, jax.numpy as jnp
from jax import lax
import numpy as np

D_MODEL = 4096
BATCH = 2
SEQ = 4096
DEPTH = 4

N_MEM = 256
GROUP_WIDTH = D_MODEL // 4
D_MIX = 4 * GROUP_WIDTH
ROPE_THETA = 500000.0
QBLK = 128

MLA_HEADS = 8
MLA_NOPE = 128
MLA_ROPE = 64
MLA_V = GROUP_WIDTH // MLA_HEADS
MLA_Q_LORA = GROUP_WIDTH
MLA_KV_LORA = GROUP_WIDTH // 2

DSA_HEADS = 8
DSA_KV_HEADS = 2
DSA_GROUP = DSA_HEADS // DSA_KV_HEADS
DSA_HEAD_DIM = GROUP_WIDTH // DSA_HEADS
DSA_ROT = DSA_HEAD_DIM // 4
IDX_HEADS = 16
IDX_DIM = 64
IDX_ROT = IDX_DIM // 4
TOPK_MAX = 256

LRU_WIDTH = GROUP_WIDTH
LRU_BLOCKS = 16
LRU_BLOCK_DIM = LRU_WIDTH // LRU_BLOCKS
CONV_WIDTH = 4
LRU_C = 8.0

MEM_HEADS = 4
MEM_HEAD_DIM = GROUP_WIDTH // MEM_HEADS

DEEPNORM_ALPHA = (2 * DEPTH) ** 0.25
DEEPNORM_BETA = (8 * DEPTH) ** -0.25
LN_EPS = 1e-5
RMS_EPS = 1e-6

IN_SIZES = (
    MLA_Q_LORA, MLA_KV_LORA, MLA_ROPE, GROUP_WIDTH,
    GROUP_WIDTH, DSA_KV_HEADS * DSA_HEAD_DIM, DSA_KV_HEADS * DSA_HEAD_DIM,
    IDX_HEADS * IDX_DIM, IDX_DIM, IDX_HEADS, GROUP_WIDTH,
    LRU_WIDTH, GROUP_WIDTH,
    GROUP_WIDTH, GROUP_WIDTH,
)
D_IN = sum(IN_SIZES)

kernel_name = "hybrid_mla_dsa_rglru_mem_deepnorm"


def layer_norm(x, g, b):
    xf = x.astype(jnp.float32)
    mu = jnp.mean(xf, axis=-1, keepdims=True)
    var = jnp.mean(jnp.square(xf - mu), axis=-1, keepdims=True)
    return ((xf - mu) * lax.rsqrt(var + LN_EPS) * g + b).astype(x.dtype)


def rms_norm(x, g):
    xf = x.astype(jnp.float32)
    return (xf * lax.rsqrt(jnp.mean(jnp.square(xf), axis=-1, keepdims=True) + RMS_EPS) * g).astype(x.dtype)


def rope_tables(positions, rot_dim):
    inv = ROPE_THETA ** (-jnp.arange(0, rot_dim, 2, dtype=jnp.float32) / rot_dim)
    ang = positions.astype(jnp.float32)[:, :, None] * inv
    return jnp.cos(ang)[:, :, None, :], jnp.sin(ang)[:, :, None, :]


def apply_rope(x, cos, sin):
    half = cos.shape[-1]
    x1, x2, rest = x[..., :half], x[..., half:2 * half], x[..., 2 * half:]
    c, s = cos.astype(x.dtype), sin.astype(x.dtype)
    return jnp.concatenate([x1 * c - x2 * s, x2 * c + x1 * s, rest], axis=-1)


def sweep_query_blocks(fn, q_arrays):
    b, s = q_arrays[0].shape[:2]
    nb = s // QBLK
    blocks = tuple(a.reshape((b, nb, QBLK) + a.shape[2:]).swapaxes(0, 1) for a in q_arrays)
    out = lax.map(lambda args: fn(args[0], *args[1:]), (jnp.arange(nb),) + blocks)
    return out.swapaxes(0, 1).reshape(b, s, -1)


def mla_mixer(c_q, c_kv, k_rope_in, g_cq, g_ckv, w_uq, w_ukv, rope):
    b, s, _ = c_q.shape
    cos, sin = rope
    q = (rms_norm(c_q, g_cq) @ w_uq).reshape(b, s, MLA_HEADS, MLA_NOPE + MLA_ROPE)
    q_nope, q_rope = q[..., :MLA_NOPE], apply_rope(q[..., MLA_NOPE:], cos, sin)
    kv = (rms_norm(c_kv, g_ckv) @ w_ukv).reshape(b, s, MLA_HEADS, MLA_NOPE + MLA_V)
    k_nope, v = kv[..., :MLA_NOPE], kv[..., MLA_NOPE:]
    k_rope = apply_rope(k_rope_in[:, :, None, :], cos, sin)[:, :, 0]
    scale = (MLA_NOPE + MLA_ROPE) ** -0.5
    kpos = jnp.arange(s)

    def block(bi, qn, qr):
        qpos = bi * QBLK + jnp.arange(QBLK)
        sc = (jnp.einsum('bqhd,bkhd->bhqk', qn, k_nope)
              + jnp.einsum('bqhr,bkr->bhqk', qr, k_rope)).astype(jnp.float32) * scale
        sc = jnp.where(kpos[None, :] <= qpos[:, None], sc, -jnp.inf)
        p = jax.nn.softmax(sc, axis=-1).astype(v.dtype)
        o = jnp.einsum('bhqk,bkhd->bqhd', p, v)
        return o.reshape(o.shape[0], QBLK, -1)

    return sweep_query_blocks(block, (q_nope, q_rope))


def dsa_mixer(q, k, v, q_idx, k_idx, w_idx, rope_h, rope_i):
    b, s, _ = q.shape
    q = apply_rope(q.reshape(b, s, DSA_HEADS, DSA_HEAD_DIM), *rope_h)
    q = q.reshape(b, s, DSA_KV_HEADS, DSA_GROUP, DSA_HEAD_DIM)
    k = apply_rope(k.reshape(b, s, DSA_KV_HEADS, DSA_HEAD_DIM), *rope_h)
    v = v.reshape(b, s, DSA_KV_HEADS, DSA_HEAD_DIM)
    q_idx = apply_rope(q_idx.reshape(b, s, IDX_HEADS, IDX_DIM), *rope_i)
    k_idx = apply_rope(k_idx[:, :, None, :], *rope_i)[:, :, 0]
    w_idx = w_idx * (IDX_HEADS ** -0.5)
    topk = min(TOPK_MAX, s // 4)
    kpos = jnp.arange(s)
    gather = jax.vmap(lambda arr, ids: arr[ids])

    def block(bi, qb, qib, wib):
        qpos = bi * QBLK + jnp.arange(QBLK)
        causal = kpos[None, :] <= qpos[:, None]
        rel = jax.nn.relu(jnp.einsum('bqhd,bsd->bqhs', qib, k_idx).astype(jnp.float32) * IDX_DIM ** -0.5)
        score = jnp.einsum('bqh,bqhs->bqs', wib.astype(jnp.float32), rel)
        score = jnp.where(causal[None], score, -jnp.inf)
        _, idx = lax.top_k(score, topk)
        valid = idx <= qpos[None, :, None]
        kg = gather(k, idx)
        vg = gather(v, idx)
        sc = jnp.einsum('bqngd,bqsnd->bqngs', qb, kg).astype(jnp.float32) * DSA_HEAD_DIM ** -0.5
        sc = jnp.where(valid[:, :, None, None, :], sc, -jnp.inf)
        p = jax.nn.softmax(sc, axis=-1).astype(vg.dtype)
        o = jnp.einsum('bqngs,bqsnd->bqngd', p, vg)
        return o.reshape(o.shape[0], QBLK, -1)

    return sweep_query_blocks(block, (q, q_idx, w_idx))


def rglru_mixer(u, conv_w, conv_b, w_a, b_a, w_x, b_x, lam):
    b, s, _ = u.shape
    u = lax.conv_general_dilated(u, conv_w[:, None, :], window_strides=(1,),
                                 padding=[(CONV_WIDTH - 1, 0)],
                                 dimension_numbers=('NWC', 'WIO', 'NWC'),
                                 feature_group_count=LRU_WIDTH) + conv_b
    ub = u.reshape(b, s, LRU_BLOCKS, LRU_BLOCK_DIM)
    r = jax.nn.sigmoid(jnp.einsum('bsnd,nde->bsne', ub, w_a).reshape(b, s, -1) + b_a)
    i = jax.nn.sigmoid(jnp.einsum('bsnd,nde->bsne', ub, w_x).reshape(b, s, -1) + b_x)
    log_a = -LRU_C * r.astype(jnp.float32) * jax.nn.softplus(-lam.astype(jnp.float32))
    a = jnp.exp(log_a)
    inp = jnp.sqrt(-jnp.expm1(2.0 * log_a)) * (i * u).astype(jnp.float32)

    def combine(left, right):
        a_l, h_l = left
        a_r, h_r = right
        return a_l * a_r, a_r * h_l + h_r

    _, h = lax.associative_scan(combine, (a, inp), axis=1)
    return h.astype(u.dtype)


def memory_mixer(q, mem, w_mk, w_mv):
    b, s, _ = q.shape
    q = q.reshape(b, s, MEM_HEADS, MEM_HEAD_DIM)
    km = (mem @ w_mk).reshape(b, N_MEM, MEM_HEADS, MEM_HEAD_DIM)
    vm = (mem @ w_mv).reshape(b, N_MEM, MEM_HEADS, MEM_HEAD_DIM)
    sc = jnp.einsum('bqhd,bmhd->bhqm', q, km).astype(jnp.float32) * MEM_HEAD_DIM ** -0.5
    p = jax.nn.softmax(sc, axis=-1).astype(vm.dtype)
    return jnp.einsum('bhqm,bmhd->bqhd', p, vm).reshape(b, s, -1)


def hybrid_layer(x, mem, rope_mla, rope_dsa, rope_idx, w_in, g_cq, g_ckv, w_uq, w_ukv,
                 conv_w, conv_b, w_rg_a, b_rg_a, w_rg_x, b_rg_x, lru_lambda,
                 w_mem_k, w_mem_v, w_o, ln_g, ln_b):
    h = x @ w_in
    splits = [int(c) for c in np.cumsum(IN_SIZES)[:-1]]
    (a_cq, a_ckv, a_kr, a_gate,
     b_q, b_k, b_v, b_qi, b_ki, b_wi, b_gate,
     c_u, c_gate, d_q, d_gate) = jnp.split(h, splits, axis=-1)
    ya = mla_mixer(a_cq, a_ckv, a_kr, g_cq, g_ckv, w_uq, w_ukv, rope_mla)
    yb = dsa_mixer(b_q, b_k, b_v, b_qi, b_ki, b_wi, rope_dsa, rope_idx)
    yc = rglru_mixer(c_u, conv_w, conv_b, w_rg_a, b_rg_a, w_rg_x, b_rg_x, lru_lambda)
    yd = memory_mixer(d_q, mem, w_mem_k, w_mem_v)
    mixed = jnp.concatenate([ya * jax.nn.silu(a_gate), yb * jax.nn.silu(b_gate),
                             yc * jax.nn.silu(c_gate), yd * jax.nn.silu(d_gate)], axis=-1)
    y = mixed @ w_o
    return layer_norm(DEEPNORM_ALPHA * x + y, ln_g, ln_b)


def setup_inputs(seed: int = 0) -> dict:
    key = jax.random.key(seed)
    ks = jax.random.split(key, 24)
    f32 = jnp.float32

    def nrm(k, shape, scale):
        return jax.random.normal(k, shape, f32) * scale

    x = nrm(ks[0], (BATCH, SEQ, D_MODEL), 1.0)
    mem = nrm(ks[1], (BATCH, N_MEM, D_MODEL), 1.0)
    offs = jax.random.randint(ks[2], (BATCH, 1), 0, 1024, dtype=jnp.int32)
    positions = offs + jnp.arange(SEQ, dtype=jnp.int32)[None, :]
    w_in = nrm(ks[3], (DEPTH, D_MODEL, D_IN), D_MODEL ** -0.5)
    g_cq = 1.0 + nrm(ks[4], (DEPTH, MLA_Q_LORA), 0.02)
    g_ckv = 1.0 + nrm(ks[5], (DEPTH, MLA_KV_LORA), 0.02)
    w_uq = nrm(ks[6], (DEPTH, MLA_Q_LORA, MLA_HEADS * (MLA_NOPE + MLA_ROPE)), MLA_Q_LORA ** -0.5)
    w_ukv = nrm(ks[7], (DEPTH, MLA_KV_LORA, MLA_HEADS * (MLA_NOPE + MLA_V)), MLA_KV_LORA ** -0.5)
    conv_w = nrm(ks[8], (DEPTH, CONV_WIDTH, LRU_WIDTH), CONV_WIDTH ** -0.5)
    conv_b = nrm(ks[9], (DEPTH, LRU_WIDTH), 0.01)
    w_rg_a = nrm(ks[10], (DEPTH, LRU_BLOCKS, LRU_BLOCK_DIM, LRU_BLOCK_DIM), LRU_BLOCK_DIM ** -0.5)
    b_rg_a = nrm(ks[11], (DEPTH, LRU_WIDTH), 0.01)
    w_rg_x = nrm(ks[12], (DEPTH, LRU_BLOCKS, LRU_BLOCK_DIM, LRU_BLOCK_DIM), LRU_BLOCK_DIM ** -0.5)
    b_rg_x = nrm(ks[13], (DEPTH, LRU_WIDTH), 0.01)
    a_base = jax.random.uniform(ks[14], (DEPTH, LRU_WIDTH), f32, 0.9, 0.999)
    p = a_base ** (1.0 / LRU_C)
    lru_lambda = jnp.log(p) - jnp.log1p(-p)
    w_mem_k = nrm(ks[15], (DEPTH, D_MODEL, GROUP_WIDTH), D_MODEL ** -0.5)
    w_mem_v = nrm(ks[16], (DEPTH, D_MODEL, GROUP_WIDTH), D_MODEL ** -0.5)
    w_o = nrm(ks[17], (DEPTH, D_MIX, D_MODEL), D_MIX ** -0.5 * DEEPNORM_BETA)
    ln_g = 1.0 + nrm(ks[18], (DEPTH, D_MODEL), 0.02)
    ln_b = nrm(ks[19], (DEPTH, D_MODEL), 0.02)
    return {"x": x, "mem": mem, "positions": positions, "w_in": w_in, "g_cq": g_cq,
            "g_ckv": g_ckv, "w_uq": w_uq, "w_ukv": w_ukv, "conv_w": conv_w, "conv_b": conv_b,
            "w_rg_a": w_rg_a, "b_rg_a": b_rg_a, "w_rg_x": w_rg_x, "b_rg_x": b_rg_x,
            "lru_lambda": lru_lambda, "w_mem_k": w_mem_k, "w_mem_v": w_mem_v, "w_o": w_o,
            "ln_g": ln_g, "ln_b": ln_b}


def reference(x, mem, positions, w_in, g_cq, g_ckv, w_uq, w_ukv, conv_w, conv_b,
              w_rg_a, b_rg_a, w_rg_x, b_rg_x, lru_lambda, w_mem_k, w_mem_v, w_o, ln_g, ln_b):
    rope_mla = rope_tables(positions, MLA_ROPE)
    rope_dsa = rope_tables(positions, DSA_ROT)
    rope_idx = rope_tables(positions, IDX_ROT)
    for l in range(DEPTH):
        x = hybrid_layer(x, mem, rope_mla, rope_dsa, rope_idx, w_in[l], g_cq[l], g_ckv[l],
                         w_uq[l], w_ukv[l], conv_w[l], conv_b[l], w_rg_a[l], b_rg_a[l],
                         w_rg_x[l], b_rg_x[l], lru_lambda[l], w_mem_k[l], w_mem_v[l], w_o[l],
                         ln_g[l], ln_b[l])
    return x
```

```cpp
#include <hip/hip_runtime.h>
#include <cstdio>
#include <cstdint>

#ifndef MK_N_LAUNCHES
#define MK_N_LAUNCHES 1
#endif

#ifndef EN_MASK
#define EN_MASK 0xFFFF
#endif
#define EN(k) (((EN_MASK) >> (k)) & 1)
#ifndef REP_MASK
#define REP_MASK 0
#endif
#define REPS(k) for (int rep_ = 0; rep_ < ((((REP_MASK) >> (k)) & 1) ? 2 : 1); ++rep_)
#define DI __device__ __forceinline__
#define LAS __attribute__((address_space(3)))
#define GAS __attribute__((address_space(1)))
typedef unsigned short bf16;
typedef unsigned short bf16_t;
typedef short bf16x8 __attribute__((ext_vector_type(8)));
typedef short s16x4 __attribute__((ext_vector_type(4)));
typedef float f32x4 __attribute__((ext_vector_type(4)));
typedef float f32x2 __attribute__((ext_vector_type(2)));
typedef float f32x16 __attribute__((ext_vector_type(16)));
typedef unsigned u32x4 __attribute__((ext_vector_type(4)));
typedef unsigned u32x2 __attribute__((ext_vector_type(2)));
typedef __bf16 bf16v2 __attribute__((ext_vector_type(2)));
#define MFMA32(a, b, c) __builtin_amdgcn_mfma_f32_32x32x16_bf16((a), (b), (c), 0, 0, 0)

DI unsigned pk2(float lo, float hi) { f32x2 v = {lo, hi}; bf16v2 b = __builtin_convertvector(v, bf16v2); return __builtin_bit_cast(unsigned, b); }
DI bf16 f2bf(float f) { return (bf16)(pk2(f, 0.f) & 0xffffu); }
DI float bf2f(unsigned short b) { return __builtin_bit_cast(float, ((unsigned)b) << 16); }
DI float bflo(unsigned w) { return __builtin_bit_cast(float, w << 16); }
DI float bfhi(unsigned w) { return __builtin_bit_cast(float, w & 0xffff0000u); }
DI u32x4 pack8(f32x4 a, f32x4 b) { u32x4 w; w.x = pk2(a[0], a[1]); w.y = pk2(a[2], a[3]); w.z = pk2(b[0], b[1]); w.w = pk2(b[2], b[3]); return w; }
DI float frcp(float x) { return __builtin_amdgcn_rcpf(x); }
DI float silu_f(float x) { return x * frcp(1.0f + __expf(-x)); }
DI float ex2(float x) { return __builtin_amdgcn_exp2f(x); }
DI float xhalf_max(float v) { const unsigned b = __builtin_bit_cast(unsigned, v); auto r = __builtin_amdgcn_permlane32_swap(b, b, false, false); return fmaxf(__builtin_bit_cast(float, (unsigned)r[0]), __builtin_bit_cast(float, (unsigned)r[1])); }
DI float max3_asm(float a, float b, float c) { float r; asm("v_max3_f32 %0, %1, %2, %3" : "=v"(r) : "v"(a), "v"(b), "v"(c)); return r; }
DI float max_asm(float a, float b) { float r; asm("v_max_f32 %0, %1, %2" : "=v"(r) : "v"(a), "v"(b)); return r; }
DI float xhalf_max_asm(float v) { const unsigned b = __builtin_bit_cast(unsigned, v); auto r = __builtin_amdgcn_permlane32_swap(b, b, false, false); return max_asm(__builtin_bit_cast(float, (unsigned)r[0]), __builtin_bit_cast(float, (unsigned)r[1])); }
DI float xhalf_sum(float v) { const unsigned b = __builtin_bit_cast(unsigned, v); auto r = __builtin_amdgcn_permlane32_swap(b, b, false, false); return __builtin_bit_cast(float, (unsigned)r[0]) + __builtin_bit_cast(float, (unsigned)r[1]); }

namespace pg8 {
#define PG8_LAS __attribute__((address_space(3)))
constexpr int BM = 256, BK = 64, HALF = 128, HTB = HALF * BK * 2  , STAGE_BYTES = 8 * HTB, NXCD = 8, WGM = 8;

__host__ __device__ __forceinline__ int lds_byte(int r, int c) { const int st = (r >> 4) * 2 + (c >> 5), rr = r & 15, cc = c & 31, ob = rr * 64 + cc * 2; return st * 1024 + (ob ^ (((ob >> 9) & 1) << 5)); }
__host__ __device__ __forceinline__ void stage_rc(int b, int& R, int& C) { const int st = b / 1024, sb = b % 1024, swz = sb ^ (((sb >> 9) & 1) << 5); R = (st >> 1) * 16 + swz / 64; C = (st & 1) * 32 + (swz % 64) / 2; }
__host__ __device__ __forceinline__ int perm32(int rho) { const int n = rho >> 4, i = rho & 15; return 8 * (i >> 2) + 4 * n + (i & 3); }

struct Unit { int pm, pn; };
struct Gemm { const bf16_t* A; const bf16_t* Bt; int K, lda, ldb; };

struct TileOrder {
    int nM, nN, nwg, G, c;
    __device__ __forceinline__ void init(int nM_, int nN_, int G_, int c_) { nM = nM_; nN = nN_; nwg = nM * nN; G = G_; c = c_; }
    __device__ __forceinline__ bool next(int i, Unit& u) const {
        const long L = (long)i * G + c; if (L >= nwg) return false;
        int wgid = (int)L; { const int q = nwg / NXCD, r = nwg % NXCD, xcd = wgid % NXCD, off = wgid / NXCD; wgid = (xcd < r ? xcd * (q + 1) : r * (q + 1) + (xcd - r) * q) + off; }
        const int nig = WGM * nN, gid = wgid / nig, fm = gid * WGM, gsz = (nM - fm) < WGM ? (nM - fm) : WGM;
        u.pm = fm + ((wgid % nig) % gsz); u.pn = (wgid % nig) / gsz; return true;
    }
    __device__ __forceinline__ void a_ready(const Unit&) const {}
    __device__ __forceinline__ void done(const Unit&) const {}
};
template <class Epi, class Sched, bool ALIGN_EPI = false, bool SP2 = false>
__device__ __forceinline__ void gemm_phase(PG8_LAS unsigned char* lds, const Gemm g, const Sched& S, const Epi& E) {
    int tid_ = threadIdx.x; asm volatile("" : "+v"(tid_));
    const int tid = tid_, wid = __builtin_amdgcn_readfirstlane(tid >> 6), lane = tid & 63, wr = wid >> 2, wc = wid & 3, fr = lane & 15, fq = lane >> 4;
    const int K = g.K, nt = K / BK;
    unsigned voffA[2], voffB[2];
#pragma unroll
    for (int i = 0; i < 2; ++i) { int R, C; stage_rc(tid * 16 + i * 8192, R, C); const int Rb = Epi::PERM ? ((R & ~31) + perm32(R & 31)) : R;
        voffA[i] = (unsigned)(R * g.lda + C) * 2u; voffB[i] = (unsigned)(Rb * g.ldb + C) * 2u; }
    const size_t kstep = (size_t)(BK * 2);
    const size_t hstepA = (size_t)HALF * g.lda * 2, hstepB = (size_t)HALF * g.ldb * 2;
    const size_t tstepA = 2 * hstepA, tstepB = 2 * hstepB;
    const unsigned ldsw = (unsigned)wid * 1024u;
    const int aoff = lds_byte(wr * 64 + fr, fq * 8), boff = lds_byte(wc * 32 + fr, fq * 8);
#define PG8_SA(b, h) (((b) * 2 + (h)) * HTB)
#define PG8_SB(b, h) ((4 + (b) * 2 + (h)) * HTB)
#define PG8_STAGE(bufoff, gbase, voff) do { _Pragma("unroll") for (int _i = 0; _i < 2; ++_i) \
        __builtin_amdgcn_global_load_lds((const unsigned*)((const char*)(gbase) + (voff)[_i]), (PG8_LAS unsigned*)(lds + (bufoff) + ldsw + _i * 8192), 16, 0, 0); } while (0)
#define PG8_LDA(dst, b, h) do { _Pragma("unroll") for (int m = 0; m < 4; ++m) _Pragma("unroll") for (int k = 0; k < 2; ++k) dst[m][k] = *(const PG8_LAS bf16x8*)(lds + PG8_SA(b, h) + aoff + m * 2048 + k * 1024); } while (0)
#define PG8_LDB(dst, b, h) do { _Pragma("unroll") for (int n = 0; n < 2; ++n) _Pragma("unroll") for (int k = 0; k < 2; ++k) dst[n][k] = *(const PG8_LAS bf16x8*)(lds + PG8_SB(b, h) + boff + n * 2048 + k * 1024); } while (0)
#define PG8_MMA(ai, bj, At, Bt) do { __builtin_amdgcn_s_setprio(1); _Pragma("unroll") for (int m = 0; m < 4; ++m) _Pragma("unroll") for (int n = 0; n < 2; ++n) _Pragma("unroll") for (int k = 0; k < 2; ++k) \
        acc[ai][bj][m][n] = __builtin_amdgcn_mfma_f32_16x16x32_bf16(Bt[n][k], At[m][k], acc[ai][bj][m][n], 0, 0, 0); __builtin_amdgcn_s_setprio(0); } while (0)
#define PG8_WAIT_V(n) asm volatile("s_waitcnt vmcnt(" #n ")" ::: "memory")
#define PG8_WAIT_L(n) asm volatile("s_waitcnt lgkmcnt(" #n ")" ::: "memory")
#define PG8_BAR __builtin_amdgcn_s_barrier()
#define PG8_SCHED __builtin_amdgcn_sched_barrier(0)
    Unit cur, nxt; int ui = 0;
    if (!S.next(0, cur)) return;
    f32x4 acc[2][2][4][2];
#pragma unroll
    for (int a = 0; a < 2; ++a)
#pragma unroll
        for (int b = 0; b < 2; ++b)
#pragma unroll
            for (int m = 0; m < 4; ++m)
#pragma unroll
                for (int n = 0; n < 2; ++n) acc[a][b][m][n] = (f32x4){0.f, 0.f, 0.f, 0.f};
    bf16x8 At[4][2], B0[2][2], B1[2][2];
    const char* cA = (const char*)g.A + (size_t)cur.pm * tstepA; const char* cB = (const char*)g.Bt + (size_t)cur.pn * tstepB;
    S.a_ready(cur);
    if constexpr (SP2) {
        PG8_STAGE(PG8_SB(0, 0), cB, voffB); PG8_STAGE(PG8_SB(0, 1), cB + hstepB, voffB); PG8_STAGE(PG8_SA(0, 0), cA, voffA); PG8_STAGE(PG8_SA(0, 1), cA + hstepA, voffA);
        if (wr == 1) PG8_BAR;
        PG8_WAIT_V(2); PG8_BAR;
        PG8_STAGE(PG8_SB(1, 0), cB + kstep, voffB); PG8_STAGE(PG8_SA(1, 0), cA + kstep, voffA); PG8_STAGE(PG8_SB(1, 1), cB + hstepB + kstep, voffB);
        PG8_WAIT_V(6); PG8_BAR;
    } else {
        PG8_STAGE(PG8_SB(0, 0), cB, voffB); PG8_STAGE(PG8_SA(0, 0), cA, voffA); PG8_STAGE(PG8_SB(0, 1), cB + hstepB, voffB); PG8_STAGE(PG8_SA(0, 1), cA + hstepA, voffA);
        if (wr == 1) PG8_BAR;
        PG8_WAIT_V(4); PG8_BAR;
        PG8_STAGE(PG8_SB(1, 0), cB + kstep, voffB); PG8_STAGE(PG8_SA(1, 0), cA + kstep, voffA); PG8_STAGE(PG8_SB(1, 1), cB + hstepB + kstep, voffB);
        PG8_WAIT_V(6); PG8_BAR;
    }
    for (;;) {
        const bool has_next = S.next(ui + 1, nxt);
        const char* nA = has_next ? (const char*)g.A + (size_t)nxt.pm * tstepA : cA; const char* nB = has_next ? (const char*)g.Bt + (size_t)nxt.pn * tstepB : cB;
        for (int t = 0; t < nt; t += 2) {
            const bool last = (t == nt - 2);
            const char* a1 = cA + (size_t)(t + 1) * kstep;
            const char* a2 = last ? nA : cA + (size_t)(t + 2) * kstep; const char* b2 = last ? nB : cB + (size_t)(t + 2) * kstep;
            const char* a3 = a2 + kstep; const char* b3 = b2 + kstep;
            if (last && has_next) S.a_ready(nxt);
            if constexpr (SP2) {
            PG8_LDB(B0, 0, 0); PG8_LDB(B1, 0, 1); PG8_SCHED; PG8_LDA(At, 0, 0); PG8_STAGE(PG8_SA(1, 1), a1 + hstepA, voffA);
            PG8_WAIT_V(8); PG8_WAIT_L(0); PG8_BAR; PG8_MMA(0, 0, At, B0); PG8_MMA(0, 1, At, B1); PG8_BAR; PG8_SCHED;
            PG8_LDA(At, 0, 1); PG8_STAGE(PG8_SB(0, 0), b2, voffB); PG8_STAGE(PG8_SB(0, 1), b2 + hstepB, voffB); PG8_STAGE(PG8_SA(0, 0), a2, voffA);
            PG8_WAIT_V(8); PG8_WAIT_L(0); PG8_BAR; PG8_MMA(1, 0, At, B0); PG8_MMA(1, 1, At, B1); PG8_BAR; PG8_SCHED;
            PG8_LDB(B0, 1, 0); PG8_LDB(B1, 1, 1); PG8_SCHED; PG8_LDA(At, 1, 0); PG8_STAGE(PG8_SA(0, 1), a2 + hstepA, voffA);
            PG8_WAIT_V(8); PG8_WAIT_L(0); PG8_BAR; PG8_MMA(0, 0, At, B0); PG8_MMA(0, 1, At, B1); PG8_BAR; PG8_SCHED;
            PG8_LDA(At, 1, 1); PG8_STAGE(PG8_SB(1, 0), b3, voffB); PG8_STAGE(PG8_SB(1, 1), b3 + hstepB, voffB); PG8_STAGE(PG8_SA(1, 0), a3, voffA);
            PG8_WAIT_V(8); PG8_WAIT_L(0); PG8_BAR; PG8_MMA(1, 0, At, B0); PG8_MMA(1, 1, At, B1); PG8_BAR; PG8_SCHED;
            } else {
            PG8_LDB(B0, 0, 0); PG8_SCHED; PG8_LDA(At, 0, 0); PG8_STAGE(PG8_SA(1, 1), a1 + hstepA, voffA);
            PG8_WAIT_L(8); PG8_BAR; PG8_WAIT_L(0); PG8_MMA(0, 0, At, B0); PG8_BAR; PG8_SCHED;
            PG8_LDB(B1, 0, 1); PG8_STAGE(PG8_SB(0, 0), b2, voffB);
            PG8_BAR; PG8_WAIT_L(0); PG8_MMA(0, 1, At, B1); PG8_BAR;
            PG8_LDA(At, 0, 1); PG8_STAGE(PG8_SA(0, 0), a2, voffA);
            PG8_BAR; PG8_WAIT_L(0); PG8_MMA(1, 0, At, B0); PG8_BAR; PG8_SCHED;
            PG8_STAGE(PG8_SB(0, 1), b2 + hstepB, voffB);
            PG8_WAIT_V(6); PG8_BAR; PG8_MMA(1, 1, At, B1); PG8_BAR;
            PG8_LDB(B0, 1, 0); PG8_SCHED; PG8_LDA(At, 1, 0); PG8_STAGE(PG8_SA(0, 1), a2 + hstepA, voffA);
            PG8_WAIT_L(8); PG8_BAR; PG8_WAIT_L(0); PG8_MMA(0, 0, At, B0); PG8_BAR; PG8_SCHED;
            PG8_LDB(B1, 1, 1); PG8_STAGE(PG8_SB(1, 0), b3, voffB);
            PG8_BAR; PG8_WAIT_L(0); PG8_MMA(0, 1, At, B1); PG8_BAR;
            PG8_LDA(At, 1, 1); PG8_STAGE(PG8_SA(1, 0), a3, voffA);
            PG8_BAR; PG8_WAIT_L(0); PG8_MMA(1, 0, At, B0); PG8_BAR; PG8_SCHED;
            PG8_STAGE(PG8_SB(1, 1), b3 + hstepB, voffB);
            PG8_WAIT_V(6); PG8_BAR; PG8_MMA(1, 1, At, B1); PG8_BAR;
            }
        }
        if constexpr (ALIGN_EPI) { if (wr == 0) PG8_BAR; }
        if constexpr (!Epi::AFTER_DRAIN) { E(acc, cur, wr, wc, fr, fq); S.done(cur); }
        if (!has_next) break;
#pragma unroll
        for (int a = 0; a < 2; ++a)
#pragma unroll
            for (int b = 0; b < 2; ++b)
#pragma unroll
                for (int m = 0; m < 4; ++m)
#pragma unroll
                    for (int n = 0; n < 2; ++n) acc[a][b][m][n] = (f32x4){0.f, 0.f, 0.f, 0.f};
        cur = nxt; cA = nA; cB = nB; ++ui;
        if constexpr (ALIGN_EPI) { if (wr == 1) PG8_BAR; }
    }
    PG8_WAIT_V(0);
    if constexpr (!ALIGN_EPI) { if (wr == 0) PG8_BAR; }
    PG8_BAR;
    if constexpr (Epi::AFTER_DRAIN) { E.fused(acc, cur, wr, wc, fr, fq, lds, wid, lane); S.done(cur); }
#undef PG8_SA
#undef PG8_SB
#undef PG8_STAGE
#undef PG8_LDA
#undef PG8_LDB
#undef PG8_MMA
#undef PG8_WAIT_V
#undef PG8_WAIT_L
#undef PG8_BAR
#undef PG8_SCHED
}
}


constexpr int NB = 2, S = 4096, M = NB * S, D = 4096, DEPTH = 4, NMEM = 256;
constexpr int DIN = 10384, NT_IN = 41, NPAD = NT_IN * 256;
constexpr float LN_EPS = 1e-5f, RMS_EPS = 1e-6f;
constexpr float ALPHA = 1.681792830507429f;
constexpr float LOG2E = 1.4426950408889634f;
constexpr float QS_MLA = 0.07216878364870322f * LOG2E;
constexpr float QS_DSA = 0.08838834764831845f * LOG2E;
constexpr float QS_MEM = 0.0625f * LOG2E;
constexpr int NWAVES = 8, NTHR = 512;

constexpr size_t MiB = 1u << 20;
constexpr size_t WS_CTL = 0, CTL_ZERO_BYTES = 1 * MiB;
constexpr size_t SZ_WIN = (size_t)NPAD * D * 2, SZ_WO = (size_t)D * D * 2, SZ_WUQ = (size_t)1536 * 1024 * 2, SZ_WUKV = (size_t)2048 * 512 * 2,
                 SZ_WMKV = (size_t)2048 * 4096 * 2, SZ_WG = (size_t)16 * 64 * 64 * 2;
constexpr size_t WS_WIN = 1 * MiB;
constexpr size_t WS_WO = WS_WIN + DEPTH * SZ_WIN;
constexpr size_t WS_WUQ = WS_WO + DEPTH * SZ_WO;
constexpr size_t WS_WUKV = WS_WUQ + DEPTH * SZ_WUQ;
constexpr size_t WS_WMKV = WS_WUKV + DEPTH * SZ_WUKV;
constexpr size_t WS_WA = WS_WMKV + DEPTH * SZ_WMKV;
constexpr size_t WS_WX = WS_WA + DEPTH * SZ_WG;
constexpr size_t WS_ACT = ((WS_WX + DEPTH * SZ_WG + MiB - 1) / MiB) * MiB;
constexpr size_t WS_XB = WS_ACT;
constexpr size_t WS_XN = WS_XB + (size_t)M * D * 2;
constexpr size_t WS_HL = WS_XN + MiB;
constexpr size_t WS_Z = WS_XN + (size_t)M * D * 4;
constexpr size_t WS_MEMB = WS_Z + (size_t)M * D * 4;
constexpr size_t WS_CQ = WS_MEMB + (size_t)512 * D * 2;
constexpr size_t WS_CKV = WS_CQ + (size_t)M * 1024 * 2;
constexpr size_t WS_G = WS_CKV + (size_t)M * 512 * 2;
constexpr size_t WS_BQ = WS_G + (size_t)M * 4096 * 2;
constexpr size_t WS_BK = WS_BQ + (size_t)M * 1024 * 2;
constexpr size_t WS_VTD = WS_BK + (size_t)M * 256 * 2;
constexpr size_t WS_QI = WS_VTD + (size_t)M * 256 * 2;
constexpr size_t WS_KI = WS_QI + (size_t)M * 1024 * 2;
constexpr size_t WS_WI = WS_KI + (size_t)M * 64 * 2;
constexpr size_t WS_CU = WS_WI + (size_t)M * 16 * 4;
constexpr size_t WS_DQ = WS_CU + (size_t)M * 1024 * 4;
constexpr size_t WS_SMALL = WS_DQ + (size_t)M * 1024 * 2;
constexpr size_t WS_SSQ = WS_SMALL + (size_t)M * 256 * 4;
constexpr size_t WS_SSKV = WS_SSQ + (size_t)M * 16 * 4;
constexpr size_t WS_QM = WS_SSKV + (size_t)M * 8 * 4;
constexpr size_t WS_KM = WS_QM + (size_t)M * 1536 * 2;
constexpr size_t WS_VTM = WS_KM + (size_t)M * 1536 * 2;
constexpr size_t WS_SC = WS_VTM + (size_t)M * 1024 * 2;
constexpr size_t WS_MASK = WS_SC + (size_t)NB * S * S * 4;
constexpr size_t WS_MIX = WS_MASK + (size_t)M * 128 * 4;
constexpr size_t WS_LSUM = WS_MIX + (size_t)M * 4096 * 2;
constexpr size_t WS_KMEM = WS_LSUM + (size_t)NB * 32 * 1024 * 8;
constexpr size_t WS_VTMEM = WS_KMEM + (size_t)512 * 1024 * 2;
constexpr size_t WS_CSM = WS_VTMEM + (size_t)512 * 1024 * 2;
constexpr size_t WS_CSD = WS_CSM + (size_t)M * 32 * 8;
constexpr size_t WS_CSI = WS_CSD + (size_t)M * 16 * 8;
constexpr size_t WS_END = WS_CSI + (size_t)M * 8 * 8;
constexpr int CW_BAR = 4096;

constexpr int RING_BYTES = 131072;
constexpr int LDSCTL_OFF = RING_BYTES, MISC_OFF = LDSCTL_OFF + 320;
constexpr int LDS_BYTES = 147456;

#define LDS_WAIT() asm volatile("s_waitcnt lgkmcnt(0)" ::: "memory")
#define VM_WAIT() asm volatile("s_waitcnt vmcnt(0)" ::: "memory")

#define XB_TMO      128
#define XB_XCNT(j)  (256  + 64 * (j))
#define XB_XSUB(j)  (1280 + 64 * (j))
#define XB_XGEN(j)  (2304 + 64 * (j))
#define XB_TOP      3328
#define XB_TOPGEN   3392
#define XCD_BAR_WORDS 3456
#define XB_SPIN_CAP (1u << 18)

__device__ __forceinline__ unsigned xb_ld(unsigned* p)              { return __hip_atomic_load(p, __ATOMIC_RELAXED, __HIP_MEMORY_SCOPE_AGENT); }
__device__ __forceinline__ unsigned xb_add(unsigned* p, unsigned v) { return __hip_atomic_fetch_add(p, v, __ATOMIC_RELAXED, __HIP_MEMORY_SCOPE_AGENT); }
__device__ __forceinline__ unsigned xb_xcc_id() { return (unsigned)__builtin_amdgcn_s_getreg((3 << 11) | 20) & 0xFu; }
#define XB_SPIN(cond, bar) do { unsigned _sp = 0; while (cond) { __builtin_amdgcn_s_sleep(1); \
    if ((++_sp & 255u) == 0u) { if (xb_ld(&(bar)[XB_TMO])) break; if (_sp > XB_SPIN_CAP) { atomicAdd(&(bar)[XB_TMO], 1u); break; } } } } while (0)

struct XcdBarrier {
    unsigned* bar; unsigned x;
    volatile LAS unsigned* st;
};

__device__ __forceinline__ XcdBarrier xcd_barrier_post(unsigned* bar, volatile LAS unsigned* st) {
    XcdBarrier b; b.bar = bar; b.x = xb_xcc_id(); b.st = st;
    if (threadIdx.x == 0) (void)xb_add(&bar[XB_XCNT(b.x)], 1u);
    return b;
}
__device__ __forceinline__ void xcd_barrier_complete(unsigned* bar, unsigned x, unsigned& nloc, unsigned& nx) {
    const unsigned G = gridDim.x * gridDim.y * gridDim.z;
    unsigned sum, cnt, mine, sp = 0u;
    for (;;) {
        sum = 0u; cnt = 0u; mine = 0u;
#pragma unroll
        for (unsigned j = 0; j < 16; ++j) { const unsigned c = xb_ld(&bar[XB_XCNT(j)]); sum += c; cnt += (c > 0u) ? 1u : 0u; mine = (j == x) ? c : mine; }
        if (sum == G) break;
        __builtin_amdgcn_s_sleep(1);
        if ((++sp & 255u) == 0u) { if (xb_ld(&bar[XB_TMO])) break; if (sp > XB_SPIN_CAP) { atomicAdd(&bar[XB_TMO], 1u); break; } }
    }
    nloc = mine > 0u ? mine : 1u; nx = cnt > 0u ? cnt : 1u;
}

__device__ __forceinline__ void xcd_barrier(const XcdBarrier& b) {
    asm volatile("s_waitcnt vmcnt(0)" ::: "memory");
    __syncthreads();
    if (threadIdx.x == 0) {
        unsigned* bar = b.bar;
        __builtin_amdgcn_s_waitcnt(0);
        unsigned nloc = b.st[0], nx = b.st[1];
        if (nloc == 0u) { xcd_barrier_complete(bar, b.x, nloc, nx); b.st[0] = nloc; b.st[1] = nx; }
        const unsigned old = xb_add(&bar[XB_XSUB(b.x)], 1u);
        const unsigned gen = old / nloc;
        if (old + 1u == (gen + 1u) * nloc) {
            __builtin_amdgcn_fence(__ATOMIC_RELEASE, "agent");
            asm volatile("s_waitcnt vmcnt(0)" ::: "memory");
            const unsigned og = xb_add(&bar[XB_TOP], 1u);
            const unsigned tg = og / nx;
            if (og + 1u == (tg + 1u) * nx) xb_add(&bar[XB_TOPGEN], 1u);
            else XB_SPIN(xb_ld(&bar[XB_TOPGEN]) == tg, bar);
            __builtin_amdgcn_fence(__ATOMIC_ACQUIRE, "agent");
            xb_add(&bar[XB_XGEN(b.x)], 1u);
            asm volatile("s_waitcnt vmcnt(0)" ::: "memory");
        } else {
            XB_SPIN(xb_ld(&bar[XB_XGEN(b.x)]) == gen, bar);
            __builtin_amdgcn_fence(__ATOMIC_ACQUIRE, "agent");
            asm volatile("s_waitcnt vmcnt(0)" ::: "memory");
        }
    }
    __syncthreads();

}

struct Frame {
    LAS unsigned char* lds;
    int tid, lane, wave, G, bid;
    float* out; unsigned char* ws;
};
constexpr int PTR_OFF = LDSCTL_OFF + 1024;
enum { I_X = 0, I_MEM, I_POS, I_WIN, I_GCQ, I_GCKV, I_WUQ, I_WUKV, I_CONVW, I_CONVB, I_WA, I_BA, I_WX, I_BX, I_LAM, I_WMK, I_WMV, I_WO, I_LNG, I_LNB };
template <class T> DI const T* inp(const Frame& F, int k) {
    const unsigned long long v = ((const LAS unsigned long long*)(F.lds + PTR_OFF))[k];
    const unsigned lo = __builtin_amdgcn_readfirstlane((unsigned)v), hi = __builtin_amdgcn_readfirstlane((unsigned)(v >> 32));
    return (const T*)(const GAS T*)(((unsigned long long)hi << 32) | lo);
}
template <class T> DI T* wsp(const Frame& F, size_t off) { return (T*)(F.ws + off); }

DI int ropeperm(int dp, int half) { const int i = dp >> 1; return (dp & 1) ? half + i : i; }
DI int win_src(int nc) {
    const int t = nc >> 8, j = nc & 255;
    if (t < 4) return t * 256 + j;
    if (t < 6) return 1024 + (t - 4) * 256 + j;
    if (t < 10) return 1600 + (t - 6) * 256 + j;
    if (t < 14) { const int c = (t - 10) * 256 + j, hd = c >> 7, dp = c & 127; return 2624 + hd * 128 + (dp < 32 ? ropeperm(dp, 16) : dp); }
    if (t == 14) { const int hd = j >> 7, dp = j & 127; return 3648 + hd * 128 + (dp < 32 ? ropeperm(dp, 16) : dp); }
    if (t == 15) return 3904 + j;
    if (t < 20) { const int c = (t - 16) * 256 + j, hd = c >> 6, dp = c & 63; return 4160 + hd * 64 + (dp < 16 ? ropeperm(dp, 8) : dp); }
    if (t < 24) return 5264 + (t - 20) * 256 + j;
    if (t < 28) return 6288 + (t - 24) * 256 + j;
    if (t < 32) return 7312 + (t - 28) * 256 + j;
    if (t < 36) return 8336 + (t - 32) * 256 + j;
    if (t < 40) return 9360 + (t - 36) * 256 + j;
    if (j < 64) return 1536 + ropeperm(j, 32);
    if (j < 128) { const int dp = j - 64; return 5184 + (dp < 16 ? ropeperm(dp, 8) : dp); }
    if (j < 144) return 5248 + (j - 128);
    return -1;
}
DI int wuq_src(int nc) {
    if (nc < 1024) return (nc >> 7) * 192 + (nc & 127);
    const int r = nc - 1024; return (r >> 6) * 192 + 128 + ropeperm(r & 63, 32);
}
template <int MAP> DI int conv_src(int n) { return (MAP == 1) ? win_src(n) : (MAP == 2) ? wuq_src(n) : n; }
template <int MAP> DI void conv_item(const float* W, int ldw, const float* kscale, bf16* WT, int ldk, int k0, int n0, LAS unsigned char* scr, int lane) {
    const int nq = lane & 15, kq = lane >> 4;
    const int sc0 = conv_src<MAP>(n0 + 4 * nq), sc1 = conv_src<MAP>(n0 + 4 * nq + 1), sc2 = conv_src<MAP>(n0 + 4 * nq + 2), sc3 = conv_src<MAP>(n0 + 4 * nq + 3);
    const bool contig = (sc0 >= 0) && (sc3 == sc0 + 3) && (sc1 == sc0 + 1) && (sc2 == sc0 + 2);
    f32x4 v[16];
    if (contig) {
#pragma unroll
        for (int i = 0; i < 16; ++i) v[i] = __builtin_nontemporal_load((const f32x4*)(W + (size_t)(k0 + 4 * i + kq) * ldw + sc0));
    } else {
#pragma unroll
        for (int i = 0; i < 16; ++i) { const float* wr = W + (size_t)(k0 + 4 * i + kq) * ldw;
            v[i][0] = sc0 >= 0 ? wr[sc0] : 0.f; v[i][1] = sc1 >= 0 ? wr[sc1] : 0.f; v[i][2] = sc2 >= 0 ? wr[sc2] : 0.f; v[i][3] = sc3 >= 0 ? wr[sc3] : 0.f; }
    }
    if (kscale) {
#pragma unroll
        for (int i = 0; i < 16; ++i) v[i] = v[i] * kscale[k0 + 4 * i + kq];
    }
#pragma unroll
    for (int i = 0; i < 16; ++i) { const int k = 4 * i + kq; *(LAS f32x4*)(scr + k * 256 + 16 * (nq ^ ((k >> 3) & 7))) = v[i]; }
    LDS_WAIT(); asm volatile("" ::: "memory");
#pragma unroll
    for (int j = 0; j < 8; ++j) { const int c = lane + 64 * j, n = c >> 3, kc = c & 7;
        const LAS unsigned char* p = scr + 16 * ((n >> 2) ^ kc) + 4 * (n & 3) + (8 * kc) * 256;
        u32x4 o; o.x = pk2(*(const LAS float*)(p), *(const LAS float*)(p + 256)); o.y = pk2(*(const LAS float*)(p + 512), *(const LAS float*)(p + 768));
        o.z = pk2(*(const LAS float*)(p + 1024), *(const LAS float*)(p + 1280)); o.w = pk2(*(const LAS float*)(p + 1536), *(const LAS float*)(p + 1792));
        __builtin_nontemporal_store(o, (u32x4*)(WT + (size_t)(n0 + n) * ldk + k0 + 8 * kc)); }
    LDS_WAIT(); asm volatile("" ::: "memory");
}
constexpr int I_IN = (D / 64) * (NPAD / 64), I_O = (D / 64) * (D / 64), I_UQ = (1024 / 64) * (1536 / 64), I_UKV = (512 / 64) * (2048 / 64), I_MK = (D / 64) * (1024 / 64), I_G = 16;
constexpr int I_LAYER = I_IN + I_O + I_UQ + I_UKV + 2 * I_MK + 2 * I_G;
DI void conv_layer_item(const Frame& F, int l, int r, LAS unsigned char* scr) {
    if (r < I_IN) { const int nb = NPAD / 64; conv_item<1>(inp<float>(F, I_WIN) + (size_t)l * D * DIN, DIN, nullptr, wsp<bf16>(F, WS_WIN + l * SZ_WIN), D, 64 * (r / nb), 64 * (r % nb), scr, F.lane); return; } r -= I_IN;
    if (r < I_O) { const int nb = D / 64; conv_item<0>(inp<float>(F, I_WO) + (size_t)l * D * D, D, nullptr, wsp<bf16>(F, WS_WO + l * SZ_WO), D, 64 * (r / nb), 64 * (r % nb), scr, F.lane); return; } r -= I_O;
    if (r < I_UQ) { const int nb = 1536 / 64; conv_item<2>(inp<float>(F, I_WUQ) + (size_t)l * 1024 * 1536, 1536, inp<float>(F, I_GCQ) + l * 1024, wsp<bf16>(F, WS_WUQ + l * SZ_WUQ), 1024, 64 * (r / nb), 64 * (r % nb), scr, F.lane); return; } r -= I_UQ;
    if (r < I_UKV) { const int nb = 2048 / 64; conv_item<0>(inp<float>(F, I_WUKV) + (size_t)l * 512 * 2048, 2048, inp<float>(F, I_GCKV) + l * 512, wsp<bf16>(F, WS_WUKV + l * SZ_WUKV), 512, 64 * (r / nb), 64 * (r % nb), scr, F.lane); return; } r -= I_UKV;
    if (r < I_MK) { const int nb = 1024 / 64; conv_item<0>(inp<float>(F, I_WMK) + (size_t)l * D * 1024, 1024, nullptr, wsp<bf16>(F, WS_WMKV + l * SZ_WMKV), D, 64 * (r / nb), 64 * (r % nb), scr, F.lane); return; } r -= I_MK;
    if (r < I_MK) { const int nb = 1024 / 64; conv_item<0>(inp<float>(F, I_WMV) + (size_t)l * D * 1024, 1024, nullptr, wsp<bf16>(F, WS_WMKV + l * SZ_WMKV) + (size_t)1024 * D, D, 64 * (r / nb), 64 * (r % nb), scr, F.lane); return; } r -= I_MK;
    if (r < I_G) { conv_item<0>(inp<float>(F, I_WA) + ((size_t)l * 16 + r) * 4096, 64, nullptr, wsp<bf16>(F, WS_WA + l * SZ_WG) + r * 4096, 64, 0, 0, scr, F.lane); return; } r -= I_G;
    conv_item<0>(inp<float>(F, I_WX) + ((size_t)l * 16 + r) * 4096, 64, nullptr, wsp<bf16>(F, WS_WX + l * SZ_WG) + r * 4096, 64, 0, 0, scr, F.lane);
}
DI void conv_layer(const Frame& F, int l, int wg_lo, int it_lo, int it_hi) {
    if (F.bid < wg_lo) return;
    LAS unsigned char* scr = F.lds + F.wave * 16384;
    const int gw = (F.bid - wg_lo) * NWAVES + F.wave, NGW = (F.G - wg_lo) * NWAVES;
    for (int it = it_lo + gw; it < it_hi; it += NGW) conv_layer_item(F, l, it, scr);
}
DI void rope_entry(int pos, int i, int rot, float& c, float& s) {
    const double e = -((double)(2 * i) / (double)rot) * 13.122363377404329;
    const float inv = (float)exp(e);
    const float ang = (float)pos * inv;
    const double a = (double)ang; const double n = rint(a * 0.15915494309189535); const double r = a - n * 6.283185307179586;
    const float rf = (float)r; c = cosf(rf); s = sinf(rf);
}
DI void p0_prologue(const Frame& F) {
    conv_layer(F, 0, 0, 0, I_IN);
    conv_layer(F, 0, 0, I_IN + I_O + I_UQ + I_UKV, I_IN + I_O + I_UQ + I_UKV + 2 * I_MK);
    const int gw = F.bid * NWAVES + F.wave, NGW = F.G * NWAVES; (void)gw; (void)NGW;
    const size_t gt = (size_t)F.bid * NTHR + F.tid, NGT = (size_t)F.G * NTHR;
    { bf16* xb = wsp<bf16>(F, WS_XB); const float* xin = inp<float>(F, I_X); for (size_t i = gt; i < (size_t)M * D / 8; i += NGT) { const f32x4 a = *(const f32x4*)(xin + i * 8), b = *(const f32x4*)(xin + i * 8 + 4); *(u32x4*)(xb + i * 8) = pack8(a, b); } }
    { bf16* mb = wsp<bf16>(F, WS_MEMB); const float* min_ = inp<float>(F, I_MEM); for (size_t i = gt; i < (size_t)512 * D / 8; i += NGT) { const f32x4 a = *(const f32x4*)(min_ + i * 8), b = *(const f32x4*)(min_ + i * 8 + 4); *(u32x4*)(mb + i * 8) = pack8(a, b); } }
    { f32x2* csm = wsp<f32x2>(F, WS_CSM); f32x2* csd = wsp<f32x2>(F, WS_CSD); f32x2* csi = wsp<f32x2>(F, WS_CSI);
      for (size_t i = gt; i < (size_t)M * 56; i += NGT) { const int row = (int)(i / 56), e = (int)(i % 56); const int p = inp<int>(F, I_POS)[row]; float c, s;
          if (e < 32) { rope_entry(p, e, 64, c, s); csm[(size_t)row * 32 + e] = (f32x2){c, s}; }
          else if (e < 48) { rope_entry(p, e - 32, 32, c, s); csd[(size_t)row * 16 + e - 32] = (f32x2){c, s}; }
          else { rope_entry(p, e - 48, 16, c, s); csi[(size_t)row * 8 + e - 48] = (f32x2){c, s}; } } }
}

using pg8::Unit;
DI void rope8(f32x4& v0, f32x4& v1, const f32x2* cs) {
    const f32x4 a = *(const f32x4*)cs, b = *(const f32x4*)(cs + 2);
    float x1, x2;
    x1 = v0[0]; x2 = v0[1]; v0[0] = x1 * a[0] - x2 * a[1]; v0[1] = x2 * a[0] + x1 * a[1];
    x1 = v0[2]; x2 = v0[3]; v0[2] = x1 * a[2] - x2 * a[3]; v0[3] = x2 * a[2] + x1 * a[3];
    x1 = v1[0]; x2 = v1[1]; v1[0] = x1 * b[0] - x2 * b[1]; v1[1] = x2 * b[0] + x1 * b[1];
    x1 = v1[2]; x2 = v1[3]; v1[2] = x1 * b[2] - x2 * b[3]; v1[3] = x2 * b[2] + x1 * b[3];
}
#define EPI_LOOP_BEGIN _Pragma("unroll") for (int ai = 0; ai < 2; ++ai) _Pragma("unroll") for (int m = 0; m < 4; ++m) { const int row = rbase + ai * 128 + m * 16; _Pragma("unroll") for (int bj = 0; bj < 2; ++bj) { \
        f32x4 v0 = acc[ai][bj][m][0], v1 = acc[ai][bj][m][1]; const int ct = ctb + bj * 128; (void)ct; (void)row;
#define EPI_LOOP_END } }

struct EpiA {
    static constexpr bool PERM = true, AFTER_DRAIN = false;
    unsigned char* ws;
    DI void operator()(const f32x4 (&acc)[2][2][4][2], const Unit& u, int wr, int wc, int fr, int fq) const {
        asm volatile("" : "+v"(fr), "+v"(fq));
        bf16 *cq = (bf16*)(ws + WS_CQ), *ckv = (bf16*)(ws + WS_CKV), *G = (bf16*)(ws + WS_G), *bq = (bf16*)(ws + WS_BQ), *bk = (bf16*)(ws + WS_BK), *vtd = (bf16*)(ws + WS_VTD), *qi = (bf16*)(ws + WS_QI), *dq = (bf16*)(ws + WS_DQ),
             *km = (bf16*)(ws + WS_KM), *ki = (bf16*)(ws + WS_KI); float *cu = (float*)(ws + WS_CU), *wi = (float*)(ws + WS_WI), *ssq = (float*)(ws + WS_SSQ), *sskv = (float*)(ws + WS_SSKV);
        const f32x2 *csm = (const f32x2*)(ws + WS_CSM), *csd = (const f32x2*)(ws + WS_CSD), *csi = (const f32x2*)(ws + WS_CSI);
        const int tile = u.pn, rbase = u.pm * 256 + wr * 64 + fr, ctb = wc * 32 + 8 * fq;
        if (tile < 6) {
            const bool isq = tile < 4; bf16* dst = isq ? cq : ckv; const int ld = isq ? 1024 : 512, tcol = isq ? tile * 256 : (tile - 4) * 256;
#pragma unroll
            for (int ai = 0; ai < 2; ++ai)
#pragma unroll
                for (int m = 0; m < 4; ++m) { const int row = rbase + ai * 128 + m * 16; float ss = 0.f;
#pragma unroll
                    for (int bj = 0; bj < 2; ++bj) { const f32x4 v0 = acc[ai][bj][m][0], v1 = acc[ai][bj][m][1];
                        *(u32x4*)(dst + (size_t)row * ld + tcol + ctb + bj * 128) = pack8(v0, v1);
                        ss += (v0[0] * v0[0] + v0[1] * v0[1]) + (v0[2] * v0[2] + v0[3] * v0[3]) + (v1[0] * v1[0] + v1[1] * v1[1]) + (v1[2] * v1[2] + v1[3] * v1[3]); }
                    ss += __shfl_xor(ss, 16); ss += __shfl_xor(ss, 32);
                    if (fq == 0) { if (isq) ssq[(size_t)row * 16 + tile * 4 + wc] = ss; else sskv[(size_t)row * 8 + (tile - 4) * 4 + wc] = ss; } }
        } else if (tile < 10 || (tile >= 20 && tile < 24) || (tile >= 28 && tile < 32) || tile >= 36 && tile < 40) {
            const int gcol = tile < 10 ? (tile - 6) * 256 : tile < 24 ? 1024 + (tile - 20) * 256 : tile < 32 ? 2048 + (tile - 28) * 256 : 3072 + (tile - 36) * 256;
            EPI_LOOP_BEGIN
#pragma unroll
                for (int j = 0; j < 4; ++j) { v0[j] = silu_f(v0[j]); v1[j] = silu_f(v1[j]); }
                *(u32x4*)(G + (size_t)row * 4096 + gcol + ct) = pack8(v0, v1);
            EPI_LOOP_END
        } else if (tile < 15) {
            const bool isq = tile < 14; bf16* dst = isq ? bq : bk; const int ld = isq ? 1024 : 256, tcol = isq ? (tile - 10) * 256 : 0; const float sc = isq ? QS_DSA : 1.0f;
            EPI_LOOP_BEGIN
                if (wc == 0) rope8(v0, v1, csd + (size_t)row * 16 + 4 * fq);
                v0 = v0 * sc; v1 = v1 * sc;
                *(u32x4*)(dst + (size_t)row * ld + tcol + ct) = pack8(v0, v1);
            EPI_LOOP_END
        } else if (tile == 15) {
            EPI_LOOP_BEGIN
                const int b = row >> 12, t = row & 4095, d0 = wc * 32 + 8 * fq; bf16* p = vtd + ((size_t)(b * 2 + bj) * 128 + d0) * S + t;
#pragma unroll
                for (int j = 0; j < 4; ++j) { p[(size_t)j * S] = f2bf(v0[j]); p[(size_t)(j + 4) * S] = f2bf(v1[j]); }
            EPI_LOOP_END
        } else if (tile < 20) {
            EPI_LOOP_BEGIN
                if ((wc & 1) == 0 && fq < 2) rope8(v0, v1, csi + (size_t)row * 8 + 4 * fq);
                v0 = v0 * 0.125f; v1 = v1 * 0.125f;
                *(u32x4*)(qi + (size_t)row * 1024 + (tile - 16) * 256 + ct) = pack8(v0, v1);
            EPI_LOOP_END
        } else if (tile < 28) {
            EPI_LOOP_BEGIN
                float* p = cu + (size_t)row * 1024 + (tile - 24) * 256 + ct; *(f32x4*)p = v0; *(f32x4*)(p + 4) = v1;
            EPI_LOOP_END
        } else if (tile < 36) {
            EPI_LOOP_BEGIN
                v0 = v0 * QS_MEM; v1 = v1 * QS_MEM;
                *(u32x4*)(dq + (size_t)row * 1024 + (tile - 32) * 256 + ct) = pack8(v0, v1);
            EPI_LOOP_END
        } else {
            EPI_LOOP_BEGIN
                if (ct < 64) { rope8(v0, v1, csm + (size_t)row * 32 + (ct >> 1)); const u32x4 w = pack8(v0, v1);
#pragma unroll
                    for (int hd = 0; hd < 8; ++hd) *(u32x4*)(km + ((size_t)row * 8 + hd) * 192 + 128 + ct) = w; }
                else if (ct < 128) { const int dp = ct - 64; if (dp < 16) rope8(v0, v1, csi + (size_t)row * 8 + (dp >> 1)); *(u32x4*)(ki + (size_t)row * 64 + dp) = pack8(v0, v1); }
                else if (ct < 144) { float* p = wi + (size_t)row * 16 + (ct - 128); *(f32x4*)p = v0 * 0.25f; *(f32x4*)(p + 4) = v1 * 0.25f; }
            EPI_LOOP_END
        }
    }
};
struct EpiMemKV {
    static constexpr bool PERM = true, AFTER_DRAIN = false;
    unsigned char* ws;
    DI void operator()(const f32x4 (&acc)[2][2][4][2], const Unit& u, int wr, int wc, int fr, int fq) const {
        asm volatile("" : "+v"(fr), "+v"(fq));
        bf16 *kmem = (bf16*)(ws + WS_KMEM), *vtmem = (bf16*)(ws + WS_VTMEM);
        const int tile = u.pn, rbase = u.pm * 256 + wr * 64 + fr, ctb = wc * 32 + 8 * fq;
        if (tile < 4) {
            EPI_LOOP_BEGIN
                *(u32x4*)(kmem + (size_t)row * 1024 + tile * 256 + ct) = pack8(v0, v1);
            EPI_LOOP_END
        } else {
            EPI_LOOP_BEGIN
                const int b = row >> 8, mm = row & 255; bf16* p = vtmem + ((size_t)(b * 4 + (tile - 4)) * 256 + ct) * 256 + mm;
#pragma unroll
                for (int j = 0; j < 4; ++j) { p[(size_t)j * 256] = f2bf(v0[j]); p[(size_t)(j + 4) * 256] = f2bf(v1[j]); }
            EPI_LOOP_END
        }
    }
};
struct EpiUQ {
    static constexpr bool PERM = true, AFTER_DRAIN = false;
    unsigned char* ws;
    DI void operator()(const f32x4 (&acc)[2][2][4][2], const Unit& u, int wr, int wc, int fr, int fq) const {
        asm volatile("" : "+v"(fr), "+v"(fq));
        bf16* qm = (bf16*)(ws + WS_QM); const float* ssq = (const float*)(ws + WS_SSQ); const f32x2* csm = (const f32x2*)(ws + WS_CSM);
        const int tile = u.pn, rbase = u.pm * 256 + wr * 64 + fr, ctb = wc * 32 + 8 * fq;
        float rs[2][4];
#pragma unroll
        for (int ai = 0; ai < 2; ++ai)
#pragma unroll
            for (int m = 0; m < 4; ++m) { const float* p = ssq + (size_t)(rbase + ai * 128 + m * 16) * 16; const f32x4 a = *(const f32x4*)p, b = *(const f32x4*)(p + 4), c = *(const f32x4*)(p + 8), d = *(const f32x4*)(p + 12);
                const float s = ((a[0] + a[1]) + (a[2] + a[3])) + ((b[0] + b[1]) + (b[2] + b[3])) + ((c[0] + c[1]) + (c[2] + c[3])) + ((d[0] + d[1]) + (d[2] + d[3]));
                rs[ai][m] = rsqrtf(s * (1.0f / 1024.0f) + RMS_EPS) * QS_MLA; }
        if (tile < 4) {
            EPI_LOOP_BEGIN
                const int head = tile * 2 + bj, d0 = wc * 32 + 8 * fq; v0 = v0 * rs[ai][m]; v1 = v1 * rs[ai][m];
                *(u32x4*)(qm + ((size_t)row * 8 + head) * 192 + d0) = pack8(v0, v1);
            EPI_LOOP_END
        } else {
            EPI_LOOP_BEGIN
                const int head = (tile - 4) * 4 + (ct >> 6), dp = ct & 63;
                rope8(v0, v1, csm + (size_t)row * 32 + (dp >> 1)); v0 = v0 * rs[ai][m]; v1 = v1 * rs[ai][m];
                *(u32x4*)(qm + ((size_t)row * 8 + head) * 192 + 128 + dp) = pack8(v0, v1);
            EPI_LOOP_END
        }
    }
};
struct EpiUKV {
    static constexpr bool PERM = true, AFTER_DRAIN = false;
    unsigned char* ws;
    DI void operator()(const f32x4 (&acc)[2][2][4][2], const Unit& u, int wr, int wc, int fr, int fq) const {
        asm volatile("" : "+v"(fr), "+v"(fq));
        bf16 *km = (bf16*)(ws + WS_KM), *vtm = (bf16*)(ws + WS_VTM); const float* sskv = (const float*)(ws + WS_SSKV);
        const int head = u.pn, rbase = u.pm * 256 + wr * 64 + fr, ctb = wc * 32 + 8 * fq;
        float rs[2][4];
#pragma unroll
        for (int ai = 0; ai < 2; ++ai)
#pragma unroll
            for (int m = 0; m < 4; ++m) { const float* p = sskv + (size_t)(rbase + ai * 128 + m * 16) * 8; const f32x4 a = *(const f32x4*)p, b = *(const f32x4*)(p + 4);
                const float s = ((a[0] + a[1]) + (a[2] + a[3])) + ((b[0] + b[1]) + (b[2] + b[3]));
                rs[ai][m] = rsqrtf(s * (1.0f / 512.0f) + RMS_EPS); }
        EPI_LOOP_BEGIN
            v0 = v0 * rs[ai][m]; v1 = v1 * rs[ai][m]; const int d0 = wc * 32 + 8 * fq;
            if (bj == 0) *(u32x4*)(km + ((size_t)row * 8 + head) * 192 + d0) = pack8(v0, v1);
            else { const int b = row >> 12, t = row & 4095; bf16* p = vtm + ((size_t)(b * 8 + head) * 128 + d0) * S + t;
#pragma unroll
                for (int j = 0; j < 4; ++j) { p[(size_t)j * S] = f2bf(v0[j]); p[(size_t)(j + 4) * S] = f2bf(v1[j]); } }
        EPI_LOOP_END
    }
};
struct EpiO {
    static constexpr bool PERM = true, AFTER_DRAIN = false;
    const float* xin; const float* g; const float* bb; unsigned char* ws;
    DI void operator()(const f32x4 (&acc)[2][2][4][2], const Unit& u, int wr, int wc, int fr, int fq) const {
        asm volatile("" : "+v"(fr), "+v"(fq));
        float* z = (float*)(ws + WS_Z); const f32x2* st = (const f32x2*)(ws + WS_XN);
        const int rbase = u.pm * 256 + wr * 64 + fr, ctb = u.pn * 256 + wc * 32 + 8 * fq;
        if (xin) {
            EPI_LOOP_BEGIN
                const size_t o = (size_t)row * D + ct; const f32x4 r0 = *(const f32x4*)(xin + o), r1 = *(const f32x4*)(xin + o + 4);
                *(f32x4*)(z + o) = r0 * ALPHA + v0; *(f32x4*)(z + o + 4) = r1 * ALPHA + v1;
            EPI_LOOP_END
        } else {
            f32x4 g0[2], g1[2], b0[2], b1[2];
#pragma unroll
            for (int bj = 0; bj < 2; ++bj) { const int c = ctb + bj * 128; g0[bj] = *(const f32x4*)(g + c) * ALPHA; g1[bj] = *(const f32x4*)(g + c + 4) * ALPHA; b0[bj] = *(const f32x4*)(bb + c) * ALPHA; b1[bj] = *(const f32x4*)(bb + c + 4) * ALPHA; }
#pragma unroll
            for (int ai = 0; ai < 2; ++ai)
#pragma unroll
                for (int m = 0; m < 4; ++m) { const int row = rbase + ai * 128 + m * 16; const f32x2 ms = st[row];
#pragma unroll
                    for (int bj = 0; bj < 2; ++bj) { const size_t o = (size_t)row * D + ctb + bj * 128; const f32x4 z0 = *(const f32x4*)(z + o), z1 = *(const f32x4*)(z + o + 4);
                        *(f32x4*)(z + o) = (z0 - ms.x) * ms.y * g0[bj] + b0[bj] + acc[ai][bj][m][0]; *(f32x4*)(z + o + 4) = (z1 - ms.x) * ms.y * g1[bj] + b1[bj] + acc[ai][bj][m][1]; } }
        }
    }
};
template <int DQK> struct AttnCfg { static constexpr int CPR = DQK / 8, KROW = DQK * 2, KBYTES = 64 * KROW, NKC = DQK / 64; };
template <int DQK> DI int attn_kswz(int rho) { return (DQK == 192) ? ((rho >> 1) & 7) : (rho & 15); }
template <int DQK, int MODE, int NDB>
DI void attn_unit(LAS unsigned char* lds, int tid, int wid, int lane,
                  const bf16* Qw, int qstride, const bf16* Kb, int kstride, const bf16* VTb, int vtstride, int nkt, int qpos0,
                  const unsigned* maskrow0, bf16* Ow, const bf16* Gw, int ostride) {
    typedef AttnCfg<DQK> C;
    constexpr bool PIPE = (DQK != 256);
    constexpr int NBUF = PIPE ? 3 : 2;
    constexpr int VBYTES = 32 * NDB * 128, KOFF0 = 0, VOFF0 = NBUF * C::KBYTES;
    const int r = lane & 31, h = lane >> 5, grp = wid >> 2;
    bf16x8 qf[DQK / 16];
    { const unsigned qoff = (unsigned)(r * qstride + 8 * h) * 2u;
#pragma unroll
      for (int ks = 0; ks < DQK / 16; ++ks) qf[ks] = *(const bf16x8*)((const char*)Qw + qoff + 32 * ks); }
    f32x16 o[NDB];
#pragma unroll
    for (int db = 0; db < NDB; ++db)
#pragma unroll
        for (int i = 0; i < 16; ++i) o[db][i] = 0.f;
    float mrun = -1e30f, lrun = 0.f;
    unsigned ksrc[C::NKC], vsrc0;
#pragma unroll
    for (int q = 0; q < C::NKC; ++q) { const int L = (8 * q + wid) * 64 + lane, rho = L / C::CPR, cp = L % C::CPR, r5 = rho & 31;
        const int key = (rho & 32) + (r5 & 19) + ((r5 & 4) << 1) + ((r5 & 8) >> 1);
        ksrc[q] = (unsigned)(key * kstride) * 2u + (unsigned)((cp ^ attn_kswz<DQK>(rho)) * 16); }
    { const int L = wid * 64 + lane, d = L >> 3, cp = L & 7; vsrc0 = (unsigned)(d * vtstride) * 2u + (unsigned)((cp ^ ((d >> 1) & 7)) * 16); }
#define ATTN_DMAK(kt_, buf_) do { const int kc_ = (kt_) < nkt ? (kt_) : nkt - 1; const char* kb_ = (const char*)Kb + (size_t)kc_ * (size_t)(128 * kstride); \
        _Pragma("unroll") for (int q = 0; q < C::NKC; ++q) __builtin_amdgcn_global_load_lds((const unsigned*)(kb_ + ksrc[q]), (LAS unsigned*)(lds + KOFF0 + (buf_) * C::KBYTES + (8 * q + wid) * 1024), 16, 0, 0); } while (0)
#define ATTN_DMAV(kt_, buf_) do { const int kc_ = (kt_) < nkt ? (kt_) : nkt - 1; const char* vb_ = (const char*)VTb + (size_t)kc_ * 128; \
        _Pragma("unroll") for (int q = 0; q < NDB / 2; ++q) __builtin_amdgcn_global_load_lds((const unsigned*)(vb_ + (size_t)q * (size_t)(128 * vtstride) + vsrc0), (LAS unsigned*)(lds + VOFF0 + (buf_) * VBYTES + (8 * q + wid) * 1024), 16, 0, 0); } while (0)
#define ATTN_SYNC() do { asm volatile("s_waitcnt vmcnt(0)" ::: "memory"); __builtin_amdgcn_s_barrier(); asm volatile("" ::: "memory"); } while (0)
#define ATTN_SYNCN(n_) do { asm volatile("s_waitcnt vmcnt(%0)" :: "n"(n_) : "memory"); __builtin_amdgcn_s_barrier(); asm volatile("" ::: "memory"); } while (0)
    constexpr int NDMA = C::NKC + NDB / 2;
    const int krow = 32 * grp + r, kswz = attn_kswz<DQK>(krow);
    int klow[4];
    if (DQK == 192) {
#pragma unroll
        for (int c = 0; c < 4; ++c) klow[c] = ((2 * c + h) ^ kswz) * 16;
    }
    int vsw[2];
#pragma unroll
    for (int s2 = 0; s2 < 2; ++s2) vsw[s2] = r * 128 + (((4 * grp + 2 * s2 + h) ^ ((r >> 1) & 7)) * 16);
#define ATTN_KOFF(ks_) (DQK == 192 ? klow[(ks_) & 3] + ((ks_) >> 2) * 128 : (((2 * (ks_) + h) ^ kswz) * 16))
#define ATTN_QK(dst, buf_) do { const LAS unsigned char* kp_ = lds + KOFF0 + (buf_) * C::KBYTES + krow * C::KROW; constexpr int NKS = DQK / 16, KBATCH = 4; \
        _Pragma("unroll") for (int i = 0; i < 16; ++i) dst[i] = 0.f; \
        _Pragma("unroll") for (int kb = 0; kb < NKS; kb += KBATCH) { bf16x8 kf[KBATCH]; \
            _Pragma("unroll") for (int ks = 0; ks < KBATCH; ++ks) if (kb + ks < NKS) kf[ks] = *(const LAS bf16x8*)(kp_ + ATTN_KOFF(kb + ks)); \
            __builtin_amdgcn_sched_barrier(0); \
            _Pragma("unroll") for (int ks = 0; ks < KBATCH; ++ks) if (kb + ks < NKS) dst = MFMA32(kf[ks], qf[kb + ks], dst); \
            __builtin_amdgcn_sched_barrier(0); } } while (0)
#define ATTN_DMAV1(vbp_, buf_, q_) __builtin_amdgcn_global_load_lds((const unsigned*)((vbp_) + (size_t)(q_) * (size_t)(128 * vtstride) + vsrc0), (LAS unsigned*)(lds + VOFF0 + (buf_) * VBYTES + (8 * (q_) + wid) * 1024), 16, 0, 0)
    static_assert(!PIPE || (DQK / 64 == C::NKC && NDB == 4), "one K piece per QK batch, two V pieces");
    f32x16 s, sn;
    constexpr int MTOFF = 106496;
    unsigned mw[8];
    if (MODE == 2) {
#pragma unroll
        for (int i = 0; i < 8; ++i) mw[i] = maskrow0[tid + 512 * i];
    }
    __syncthreads();
    if (MODE == 2) {
#pragma unroll
        for (int i = 0; i < 8; ++i) { const int idx = tid + 512 * i, row = idx >> 7, w = idx & 127; *(LAS unsigned*)(lds + MTOFF + (row * 129 + w) * 4) = mw[i]; }
        LDS_WAIT();
    }
    if (PIPE) { ATTN_DMAK(0, 0); ATTN_DMAK(1, 1); ATTN_DMAV(0, 0); ATTN_DMAK(2, 2); ATTN_DMAV(1, 1); ATTN_SYNCN(2 * NDMA); ATTN_QK(s, 0); }
    else { ATTN_DMAK(0, 0); ATTN_DMAV(0, 0); }
    int c0 = 0;
    if (__builtin_amdgcn_readfirstlane(wid) >= 4) __builtin_amdgcn_s_setprio(1);
    auto tile_step = [&](f32x16& s, f32x16& sn, const int kt) __attribute__((always_inline)) {
        const int c1 = c0 == 2 ? 0 : c0 + 1, c2 = c1 == 2 ? 0 : c1 + 1, vb = PIPE ? c0 : (kt & 1);
        const int kck = kt + 3 < nkt ? kt + 3 : nkt - 1, kcv = kt + 2 < nkt ? kt + 2 : nkt - 1;
        const char* kbp = (const char*)Kb + (size_t)kck * (size_t)(128 * kstride); const char* vbp = (const char*)VTb + (size_t)kcv * 128;
        if (PIPE) ATTN_SYNCN(NDMA);
        else { ATTN_SYNC(); ATTN_DMAK(kt + 1, (kt + 1) & 1); ATTN_DMAV(kt + 1, (kt + 1) & 1); ATTN_QK(s, kt & 1); }
        constexpr bool VEARLY = (DQK != 256);
        bf16x8 vf[NDB][2];
        const LAS unsigned char* vq2[2];
#pragma unroll
        for (int s2 = 0; s2 < 2; ++s2) { vq2[s2] = lds + VOFF0 + vb * VBYTES + vsw[s2]; asm volatile("" : "+v"(vq2[s2])); }
#define ATTN_VFRAG(db_, s2_) (*(const LAS bf16x8*)(vq2[s2_] + (db_) * 4096))
        constexpr bool VLATE = (DQK == 192);
        if (VEARLY) {
            if (!VLATE) {
#pragma unroll
                for (int db = 0; db < NDB; ++db)
#pragma unroll
                    for (int s2 = 0; s2 < 2; ++s2) vf[db][s2] = ATTN_VFRAG(db, s2);
                __builtin_amdgcn_sched_barrier(0);
            }
            if (PIPE) { ATTN_DMAV1(vbp, c2, 0); __builtin_amdgcn_sched_barrier(0); }
        }
        constexpr int NKS = DQK / 16, KW = (DQK == 192) ? 2 : 4, SL0 = (NKS - 8) / 2;
        const LAS unsigned char* kpn = lds + KOFF0 + c1 * C::KBYTES + krow * C::KROW;
        const LAS unsigned char* kq4[4];
        if (DQK == 192) {
#pragma unroll
            for (int c = 0; c < 4; ++c) { kq4[c] = kpn + klow[c]; asm volatile("" : "+v"(kq4[c])); }
        }
#define ATTN_KFRAG(ks_) (*(const LAS bf16x8*)(DQK == 192 ? kq4[(ks_) & 3] + ((ks_) >> 2) * 128 : kpn + ATTN_KOFF(ks_)))
        bf16x8 kf[PIPE ? NKS : 1];
        if (PIPE) {
#pragma unroll
            for (int ks = 0; ks < KW; ++ks) kf[ks] = ATTN_KFRAG(ks);
            __builtin_amdgcn_sched_barrier(0);
        }
        const int key0 = 64 * kt + 32 * grp;
        const bool need_mask = (MODE == 2) || (MODE == 1 && key0 + 31 > qpos0);
        unsigned vmask = 0xffffffffu;
        if (need_mask) {
            if (MODE == 1) { const int lim = qpos0 + r - key0; vmask = lim >= 31 ? 0xffffffffu : (lim < 0 ? 0u : ((2u << lim) - 1u)); }
            else vmask = *(const LAS unsigned*)(lds + MTOFF + (r * 129 + 2 * kt + grp) * 4);
            vmask >>= 8 * h;
        }
        float mx = max3_asm(s[0], s[1], s[2]);
#pragma unroll
        for (int i = 3; i < 15; i += 2) mx = max3_asm(mx, s[i], s[i + 1]);
        mx = xhalf_max_asm(max_asm(mx, s[15]));
        if (__any(mx > mrun + 8.0f)) { const float mn = fmaxf(mrun, mx), alpha = ex2(mrun - mn); mrun = mn; lrun *= alpha;
#pragma unroll
            for (int db = 0; db < NDB; ++db)
#pragma unroll
                for (int i = 0; i < 16; ++i) o[db][i] *= alpha; }
        bf16x8 pf[2];
        if (PIPE) {
            float ps0 = 0.f; unsigned pw[8];
            f32x16 zero16;
#pragma unroll
            for (int i = 0; i < 16; ++i) zero16[i] = 0.f;
#define ATTN_SLOT(KS_, M_) if ((KS_) < NKS) { constexpr int ks = (KS_) < NKS ? (KS_) : 0; \
                if (ks + KW < NKS) kf[(ks + KW) % NKS] = ATTN_KFRAG((ks + KW) % NKS); \
                if (ks == 0) sn = MFMA32(kf[0], qf[0], zero16); else sn = MFMA32(kf[ks], qf[ks], sn); \
                constexpr int j_ = ks - SL0; \
                if (j_ >= 0 && j_ < 8) { constexpr int e0_ = 2 * (j_ & 7), e1_ = e0_ + 1; unsigned m0_ = 0, m1_ = 0; \
                    if (M_) { asm("v_bfe_i32 %0, %1, %2, 1" : "=v"(m0_) : "v"(vmask), "n"((e0_ & 7) + 16 * (e0_ >> 3))); asm("v_bfe_i32 %0, %1, %2, 1" : "=v"(m1_) : "v"(vmask), "n"((e1_ & 7) + 16 * (e1_ >> 3))); } \
                    float p0_ = ex2(s[e0_] - mr_), p1_ = ex2(s[e1_] - mr_); \
                    if (M_) { p0_ = __builtin_bit_cast(float, __builtin_bit_cast(unsigned, p0_) & m0_); p1_ = __builtin_bit_cast(float, __builtin_bit_cast(unsigned, p1_) & m1_); } \
                    ps0 += p0_; ps0 += p1_; pw[j_ & 7] = pk2(p0_, p1_); } \
                if ((ks & 3) == 3) __builtin_amdgcn_global_load_lds((const unsigned*)(kbp + ksrc[ks >> 2]), (LAS unsigned*)(lds + KOFF0 + c0 * C::KBYTES + (8 * (ks >> 2) + wid) * 1024), 16, 0, 0); \
                __builtin_amdgcn_sched_barrier(0); }
#define ATTN_BLOCKB(M_) do { float mr_ = mrun; asm volatile("" : "+v"(mr_));     \
            ATTN_SLOT(0, M_) ATTN_SLOT(1, M_) ATTN_SLOT(2, M_) ATTN_SLOT(3, M_) ATTN_SLOT(4, M_) ATTN_SLOT(5, M_) ATTN_SLOT(6, M_) ATTN_SLOT(7, M_) ATTN_SLOT(8, M_) ATTN_SLOT(9, M_) ATTN_SLOT(10, M_) ATTN_SLOT(11, M_) } while (0)
            if (need_mask) ATTN_BLOCKB(true); else ATTN_BLOCKB(false);
#undef ATTN_BLOCKB
#undef ATTN_SLOT
            if (VLATE) { vf[0][0] = ATTN_VFRAG(0, 0); vf[0][1] = ATTN_VFRAG(0, 1); vf[1][0] = ATTN_VFRAG(1, 0); vf[1][1] = ATTN_VFRAG(1, 1); vf[2][0] = ATTN_VFRAG(2, 0); vf[2][1] = ATTN_VFRAG(2, 1); vf[3][0] = ATTN_VFRAG(3, 0); vf[3][1] = ATTN_VFRAG(3, 1); __builtin_amdgcn_sched_barrier(0); }
            lrun += ps0;
            ATTN_DMAV1(vbp, c2, 1); __builtin_amdgcn_sched_barrier(0);
            pf[0] = __builtin_bit_cast(bf16x8, ((u32x4){pw[0], pw[1], pw[2], pw[3]})); pf[1] = __builtin_bit_cast(bf16x8, ((u32x4){pw[4], pw[5], pw[6], pw[7]}));
        } else {
            float ps = 0.f; float pv[16];
            if (need_mask) {
#pragma unroll
                for (int i = 0; i < 16; ++i) { const int kl = (i & 7) + 16 * (i >> 3); const unsigned mi = (unsigned)__builtin_amdgcn_sbfe((int)vmask, kl, 1);
                    const float p = __builtin_bit_cast(float, __builtin_bit_cast(unsigned, ex2(s[i] - mrun)) & mi); pv[i] = p; ps += p; }
            } else {
#pragma unroll
                for (int i = 0; i < 16; ++i) { const float p = ex2(s[i] - mrun); pv[i] = p; ps += p; }
            }
            lrun += ps;
#pragma unroll
            for (int s2 = 0; s2 < 2; ++s2) { u32x4 w; w.x = pk2(pv[8 * s2], pv[8 * s2 + 1]); w.y = pk2(pv[8 * s2 + 2], pv[8 * s2 + 3]); w.z = pk2(pv[8 * s2 + 4], pv[8 * s2 + 5]); w.w = pk2(pv[8 * s2 + 6], pv[8 * s2 + 7]); pf[s2] = __builtin_bit_cast(bf16x8, w); }
        }
#pragma unroll
        for (int db = 0; db < NDB; ++db) {
            if (!VEARLY) { vf[0][0] = ATTN_VFRAG(db, 0); vf[0][1] = ATTN_VFRAG(db, 1); o[db] = MFMA32(vf[0][0], pf[0], o[db]); o[db] = MFMA32(vf[0][1], pf[1], o[db]); }
            else {
#pragma unroll
                for (int s2 = 0; s2 < 2; ++s2) o[db] = MFMA32(vf[db][s2], pf[s2], o[db]); } }
#undef ATTN_VFRAG
#undef ATTN_KFRAG
        if (PIPE) c0 = c1;
    };
    for (int kt = 0; kt < nkt; kt += 2) { tile_step(s, sn, kt); if (kt + 1 < nkt) tile_step(sn, s, kt + 1); }
    __builtin_amdgcn_s_setprio(0);
    asm volatile("s_waitcnt vmcnt(0)" ::: "memory");
#undef ATTN_DMAK
#undef ATTN_DMAV
#undef ATTN_SYNC
#undef ATTN_SYNCN
#undef ATTN_QK
#undef ATTN_KOFF
#undef ATTN_DMAV1
    const float lt = xhalf_sum(lrun);
    int ln = lane; asm volatile("" : "+v"(ln)); const int re = ln & 31, he = ln >> 5;
    constexpr int CPRW = NDB * 4, RPI = 64 / CPRW;
    constexpr bool GPRE = (NDB == 4);
    u32x4 gpre[GPRE ? 32 / RPI : 1];
    if (GPRE && grp == 0) {
#pragma unroll
        for (int it = 0; it < 32 / RPI; ++it) { const int row = it * RPI + ln / CPRW, ch = ln % CPRW; gpre[it] = *(const u32x4*)((const char*)Gw + (unsigned)(row * ostride) * 2u + (unsigned)ch * 16u); }
    }
    __syncthreads();
    LAS float* mb = (LAS float*)lds + (wid & 3) * ((NDB * 16 + 2) * 64);
    if (grp == 1) {
#pragma unroll
        for (int db = 0; db < NDB; ++db)
#pragma unroll
            for (int i = 0; i < 16; ++i) mb[(db * 16 + i) * 64 + lane] = o[db][i];
        mb[(NDB * 16) * 64 + lane] = mrun; mb[(NDB * 16 + 1) * 64 + lane] = lt;
    }
    __syncthreads();
    if (grp == 0) {
        const float m2 = mb[(NDB * 16) * 64 + lane], l2 = mb[(NDB * 16 + 1) * 64 + lane];
        const float mm = fmaxf(mrun, m2), a1 = ex2(mrun - mm), a2 = ex2(m2 - mm);
        const float inv = frcp(lt * a1 + l2 * a2);
        const float c1 = a1 * inv, c2 = a2 * inv;
        LAS unsigned char* stg = lds + 4 * ((NDB * 16 + 2) * 256) + (wid & 3) * (32 * 272);
#pragma unroll
        for (int db = 0; db < NDB; ++db)
#pragma unroll
            for (int g4 = 0; g4 < 4; ++g4) {
                const float y0 = o[db][4 * g4 + 0] * c1 + mb[(db * 16 + 4 * g4 + 0) * 64 + lane] * c2, y1 = o[db][4 * g4 + 1] * c1 + mb[(db * 16 + 4 * g4 + 1) * 64 + lane] * c2;
                const float y2 = o[db][4 * g4 + 2] * c1 + mb[(db * 16 + 4 * g4 + 2) * 64 + lane] * c2, y3 = o[db][4 * g4 + 3] * c1 + mb[(db * 16 + 4 * g4 + 3) * 64 + lane] * c2;
                *(LAS u32x2*)(stg + re * 272 + (32 * db + 8 * g4 + 4 * he) * 2) = (u32x2){pk2(y0, y1), pk2(y2, y3)}; }
        LDS_WAIT(); asm volatile("" ::: "memory");
#pragma unroll
        for (int it = 0; it < 32 / RPI; ++it) { const int row = it * RPI + ln / CPRW, ch = ln % CPRW; const unsigned off = (unsigned)(row * ostride) * 2u + (unsigned)ch * 16u;
            const u32x4 yv = *(const LAS u32x4*)(stg + row * 272 + ch * 16); u32x4 gv; if (GPRE) gv = gpre[it]; else gv = *(const u32x4*)((const char*)Gw + off);
            *(u32x4*)((char*)Ow + off) = (u32x4){pk2(bflo(yv.x) * bflo(gv.x), bfhi(yv.x) * bfhi(gv.x)), pk2(bflo(yv.y) * bflo(gv.y), bfhi(yv.y) * bfhi(gv.y)),
                                                 pk2(bflo(yv.z) * bflo(gv.z), bfhi(yv.z) * bfhi(gv.z)), pk2(bflo(yv.w) * bflo(gv.w), bfhi(yv.w) * bfhi(gv.w))}; }
    }
}

DI void mla_phase(const Frame& F) {
    const bf16* qm = wsp<bf16>(F, WS_QM); const bf16* km = wsp<bf16>(F, WS_KM); const bf16* vtm = wsp<bf16>(F, WS_VTM); const bf16* G = wsp<bf16>(F, WS_G); bf16* mix = wsp<bf16>(F, WS_MIX);
    const int wq = F.wave & 3;
    for (int j0 = F.bid; j0 < 256; j0 += F.G) {
        const int j = (F.G == 256) ? ((j0 & 7) * 32 + (j0 >> 3)) : j0;
        const int bh = j >> 4, b = bh >> 3, head = bh & 7, p = j & 15;
        for (int k = 0; k < 2; ++k) { const int qb = k ? p : 31 - p, q0 = 128 * qb, row0 = b * S + q0 + 32 * wq;
            attn_unit<192, 1, 4>(F.lds, F.tid, F.wave, F.lane, qm + ((size_t)row0 * 8 + head) * 192, 1536, km + ((size_t)(b * S) * 8 + head) * 192, 1536,
                              vtm + (size_t)(b * 8 + head) * 128 * S, S, 2 * qb + 2, q0 + 32 * wq, nullptr, mix + (size_t)row0 * 4096 + head * 128, G + (size_t)row0 * 4096 + head * 128, 4096); }
    }
}
DI void dsa_phase(const Frame& F) {
    const bf16* bq = wsp<bf16>(F, WS_BQ); const bf16* bk = wsp<bf16>(F, WS_BK); const bf16* vtd = wsp<bf16>(F, WS_VTD); const bf16* G = wsp<bf16>(F, WS_G); bf16* mix = wsp<bf16>(F, WS_MIX);
    const unsigned* mask = wsp<unsigned>(F, WS_MASK);
    const int wq = F.wave & 3;
    for (int j0 = F.bid; j0 < 256; j0 += F.G) {
        const int j = (F.G == 256) ? ((j0 & 7) * 32 + (j0 >> 3)) : j0;
        const int bn = j >> 6, b = bn >> 1, n = bn & 1, p = j & 63, hh = 4 * n + wq;
        for (int k = 0; k < 2; ++k) { const int qb = k ? p : 127 - p, q0 = 32 * qb, row0 = b * S + q0;
            attn_unit<128, 2, 4>(F.lds, F.tid, F.wave, F.lane, bq + (size_t)row0 * 1024 + hh * 128, 1024, bk + (size_t)(b * S) * 256 + n * 128, 256,
                              vtd + (size_t)(b * 2 + n) * 128 * S, S, qb / 2 + 1, q0, mask + (size_t)row0 * 128, mix + (size_t)row0 * 4096 + 1024 + hh * 128, G + (size_t)row0 * 4096 + 1024 + hh * 128, 4096); }
    }
}
DI void mem_unit(LAS unsigned char* lds, int tid, int wid, int lane, const bf16* Qw, const bf16* Kb, const bf16* VTb, bf16* Ow, const bf16* Gw) {
    constexpr int DQK = 256, CPR = 32, KROW = 512, KBYTES = 64 * KROW, VBYTES = 256 * 128, VOFF0 = 2 * KBYTES, qstride = 1024, kstride = 1024, vtstride = 256, ostride = 4096, nkt = 4;
    const int r = lane & 31, h = lane >> 5, grp = wid >> 2;
    bf16x8 qf[16];
    { const unsigned qoff = (unsigned)(r * qstride + 8 * h) * 2u;
#pragma unroll
      for (int ks = 0; ks < 16; ++ks) qf[ks] = *(const bf16x8*)((const char*)Qw + qoff + 32 * ks); }
    f32x16 o[4];
#pragma unroll
    for (int db = 0; db < 4; ++db)
#pragma unroll
        for (int i = 0; i < 16; ++i) o[db][i] = 0.f;
    float mrun = -1e30f, lrun = 0.f;
    unsigned ksrc[4], vsrc[4];
#pragma unroll
    for (int q = 0; q < 4; ++q) { const int L = (8 * q + wid) * 64 + lane, rho = L / CPR, cp = L % CPR, r5 = rho & 31;
        const int key = (rho & 32) + (r5 & 19) + ((r5 & 4) << 1) + ((r5 & 8) >> 1);
        ksrc[q] = (unsigned)(key * kstride) * 2u + (unsigned)((cp ^ (rho & 15)) * 16);
        const int d = L >> 3, cv = L & 7; vsrc[q] = (unsigned)(d * vtstride) * 2u + (unsigned)((cv ^ ((d >> 1) & 7)) * 16); }
#define MEM_DMA(kt_, buf_) do { const int kc_ = (kt_) < nkt ? (kt_) : nkt - 1; const char* kb_ = (const char*)Kb + (size_t)kc_ * (size_t)(128 * kstride); const char* vb_ = (const char*)VTb + (size_t)kc_ * 128; \
        _Pragma("unroll") for (int q = 0; q < 4; ++q) { __builtin_amdgcn_global_load_lds((const unsigned*)(kb_ + ksrc[q]), (LAS unsigned*)(lds + (buf_) * KBYTES + (8 * q + wid) * 1024), 16, 0, 0); \
            __builtin_amdgcn_global_load_lds((const unsigned*)(vb_ + vsrc[q]), (LAS unsigned*)(lds + VOFF0 + (buf_) * VBYTES + (8 * q + wid) * 1024), 16, 0, 0); } } while (0)
    __syncthreads();
    MEM_DMA(0, 0);
    for (int kt = 0; kt < nkt; ++kt) {
        asm volatile("s_waitcnt vmcnt(0)" ::: "memory"); __builtin_amdgcn_s_barrier(); asm volatile("" ::: "memory");
        MEM_DMA(kt + 1, (kt + 1) & 1);
#pragma unroll 1
        for (int sub = 0; sub < 2; ++sub) {
            const int krow = 32 * sub + r, kswz = krow & 15;
            const LAS unsigned char* kp = lds + (kt & 1) * KBYTES + krow * KROW;
            f32x16 s;
#pragma unroll
            for (int i = 0; i < 16; ++i) s[i] = 0.f;
#pragma unroll
            for (int kb = 0; kb < 16; kb += 4) { bf16x8 kf[4];
#pragma unroll
                for (int ks = 0; ks < 4; ++ks) kf[ks] = *(const LAS bf16x8*)(kp + (((2 * (kb + ks) + h) ^ kswz) * 16));
                __builtin_amdgcn_sched_barrier(0);
#pragma unroll
                for (int ks = 0; ks < 4; ++ks) s = MFMA32(kf[ks], qf[kb + ks], s);
                __builtin_amdgcn_sched_barrier(0); }
            float mx = s[0];
#pragma unroll
            for (int i = 1; i < 16; ++i) mx = fmaxf(mx, s[i]);
            mx = xhalf_max(mx);
            if (__any(mx > mrun + 8.0f)) { const float mn = fmaxf(mrun, mx), alpha = ex2(mrun - mn); mrun = mn; lrun *= alpha;
#pragma unroll
                for (int db = 0; db < 4; ++db)
#pragma unroll
                    for (int i = 0; i < 16; ++i) o[db][i] *= alpha; }
            float ps = 0.f; float pv[16];
#pragma unroll
            for (int i = 0; i < 16; ++i) { const float p = ex2(s[i] - mrun); pv[i] = p; ps += p; }
            lrun += ps;
            bf16x8 pf[2];
#pragma unroll
            for (int s2 = 0; s2 < 2; ++s2) { u32x4 w; w.x = pk2(pv[8 * s2], pv[8 * s2 + 1]); w.y = pk2(pv[8 * s2 + 2], pv[8 * s2 + 3]); w.z = pk2(pv[8 * s2 + 4], pv[8 * s2 + 5]); w.w = pk2(pv[8 * s2 + 6], pv[8 * s2 + 7]); pf[s2] = __builtin_bit_cast(bf16x8, w); }
#pragma unroll
            for (int db = 0; db < 4; ++db) { const int d = 128 * grp + 32 * db + r; const LAS unsigned char* vp = lds + VOFF0 + (kt & 1) * VBYTES + d * 128; const int vsw = (d >> 1) & 7;
                const bf16x8 v0 = *(const LAS bf16x8*)(vp + (((4 * sub + h) ^ vsw) * 16)), v1 = *(const LAS bf16x8*)(vp + (((4 * sub + 2 + h) ^ vsw) * 16));
                o[db] = MFMA32(v0, pf[0], o[db]); o[db] = MFMA32(v1, pf[1], o[db]); }
        }
    }
#undef MEM_DMA
    asm volatile("s_waitcnt vmcnt(0)" ::: "memory");
    __syncthreads();
    {
        int ln = lane; asm volatile("" : "+v"(ln)); const int re = ln & 31, he = ln >> 5;
        const float inv = frcp(xhalf_sum(lrun));
        LAS unsigned char* stg = lds + wid * (32 * 272);
#pragma unroll
        for (int db = 0; db < 4; ++db)
#pragma unroll
            for (int g4 = 0; g4 < 4; ++g4)
                *(LAS u32x2*)(stg + re * 272 + (32 * db + 8 * g4 + 4 * he) * 2) = (u32x2){pk2(o[db][4 * g4] * inv, o[db][4 * g4 + 1] * inv), pk2(o[db][4 * g4 + 2] * inv, o[db][4 * g4 + 3] * inv)};
        LDS_WAIT(); asm volatile("" ::: "memory");
#pragma unroll
        for (int it = 0; it < 8; ++it) { const int row = it * 4 + (ln >> 4), ch = ln & 15; const unsigned off = (unsigned)(row * ostride) * 2u + (unsigned)(128 * grp) * 2u + (unsigned)ch * 16u;
            const u32x4 yv = *(const LAS u32x4*)(stg + row * 272 + ch * 16); const u32x4 gv = *(const u32x4*)((const char*)Gw + off);
            *(u32x4*)((char*)Ow + off) = (u32x4){pk2(bflo(yv.x) * bflo(gv.x), bfhi(yv.x) * bfhi(gv.x)), pk2(bflo(yv.y) * bflo(gv.y), bfhi(yv.y) * bfhi(gv.y)),
                                                 pk2(bflo(yv.z) * bflo(gv.z), bfhi(yv.z) * bfhi(gv.z)), pk2(bflo(yv.w) * bflo(gv.w), bfhi(yv.w) * bfhi(gv.w))}; }
    }
}
DI void mem_phase(const Frame& F) {
    const bf16* dq = wsp<bf16>(F, WS_DQ); const bf16* kmem = wsp<bf16>(F, WS_KMEM); const bf16* vtmem = wsp<bf16>(F, WS_VTMEM); const bf16* G = wsp<bf16>(F, WS_G); bf16* mix = wsp<bf16>(F, WS_MIX);
    const int wq = F.wave & 3;
    for (int j = F.bid; j < 256; j += F.G) {
        const int bh = j >> 5, b = bh >> 2, head = bh & 3, qb = j & 31, row0 = b * S + 128 * qb + 32 * wq;
        mem_unit(F.lds, F.tid, F.wave, F.lane, dq + (size_t)row0 * 1024 + head * 256, kmem + (size_t)(b * 256) * 1024 + head * 256, vtmem + (size_t)(b * 4 + head) * 256 * 256,
                 mix + (size_t)row0 * 4096 + 3072 + head * 256, G + (size_t)row0 * 4096 + 3072 + head * 256);
    }
}

DI void select_row(const Frame& F, int row);
DI void idx_item(const Frame& F, int b, int p) {
    const bf16* qi = wsp<bf16>(F, WS_QI); const bf16* ki = wsp<bf16>(F, WS_KI); const float* wi = wsp<float>(F, WS_WI); float* sc = wsp<float>(F, WS_SC);
    const int lane = F.lane, r = lane & 31, h = lane >> 5, tA = 16 * p + 2 * F.wave, tB = 16 * (255 - p) + 2 * F.wave;
    const int aq = (r >> 2) & 1, ah = (r & 3) + 4 * (r >> 3);
    bf16x8 afA[4], afB[4];
#pragma unroll
    for (int ks = 0; ks < 4; ++ks) { afA[ks] = *(const bf16x8*)(qi + ((size_t)(b * S + tA + aq) * 16 + ah) * 64 + 16 * ks + 8 * h); afB[ks] = *(const bf16x8*)(qi + ((size_t)(b * S + tB + aq) * 16 + ah) * 64 + 16 * ks + 8 * h); }
    float wlA[16], wlB[16];
    { const float* wa = wi + (size_t)(b * S + tA + h) * 16; const float* wb = wi + (size_t)(b * S + tB + h) * 16;
#pragma unroll
      for (int i = 0; i < 4; ++i) { const f32x4 x = *(const f32x4*)(wa + 4 * i), y = *(const f32x4*)(wb + 4 * i);
          wlA[4 * i] = x[0]; wlA[4 * i + 1] = x[1]; wlA[4 * i + 2] = x[2]; wlA[4 * i + 3] = x[3]; wlB[4 * i] = y[0]; wlB[4 * i + 1] = y[1]; wlB[4 * i + 2] = y[2]; wlB[4 * i + 3] = y[3]; } }
    float* orowA = sc + ((size_t)(b * S + tA + h)) * S + r; float* orowB = sc + ((size_t)(b * S + tB + h)) * S + r;
    const int nktA = (16 * p + 15) / 32 + 1, nktB = (16 * (255 - p) + 15) / 32 + 1;
    LAS unsigned char* lds = F.lds; constexpr int CHB = 256 * 144;
    const char* kbase = (const char*)(ki + (size_t)(b * S) * 64);
    const int nch = (nktB + 7) >> 3;
    u32x4 stg[4];
#define IDX_GLOAD(c_) do { int tl_ = F.tid; asm volatile("" : "+v"(tl_)); const char* cb_ = kbase + (size_t)(c_) * 32768; _Pragma("unroll") for (int i_ = 0; i_ < 4; ++i_) stg[i_] = *(const u32x4*)(cb_ + (unsigned)(tl_ + 512 * i_) * 16u); } while (0)
#define IDX_LSTORE(buf_) do { int tl_ = F.tid; asm volatile("" : "+v"(tl_)); _Pragma("unroll") for (int i_ = 0; i_ < 4; ++i_) { const int c_ = tl_ + 512 * i_; *(LAS u32x4*)(lds + (buf_) * CHB + (c_ >> 3) * 144 + (c_ & 7) * 16) = stg[i_]; } } while (0)
#define IDX_MMA(af_, wl_, orow_, kt_) do { f32x16 a; _Pragma("unroll") for (int i = 0; i < 16; ++i) a[i] = 0.f; _Pragma("unroll") for (int ks = 0; ks < 4; ++ks) a = MFMA32(af_[ks], kf[ks], a); \
          float s0_ = 0.f, s1_ = 0.f; _Pragma("unroll") for (int i = 0; i < 16; i += 2) { s0_ += wl_[i] * fmaxf(a[i], 0.f); s1_ += wl_[i + 1] * fmaxf(a[i + 1], 0.f); } orow_[32 * (kt_)] = s0_ + s1_; } while (0)
    __syncthreads();
    IDX_GLOAD(0); IDX_LSTORE(0);
    __syncthreads();
    for (int c = 0; c < nch; ++c) {
        if (c + 1 < nch) IDX_GLOAD(c + 1);
        const LAS unsigned char* kb = lds + (c & 1) * CHB + r * 144 + 16 * h;
        for (int t = 0; t < 8; ++t) { const int kt = 8 * c + t; if (kt >= nktB) break;
            bf16x8 kf[4];
#pragma unroll
            for (int ks = 0; ks < 4; ++ks) kf[ks] = *(const LAS bf16x8*)(kb + t * (32 * 144) + 32 * ks);
            IDX_MMA(afB, wlB, orowB, kt);
            if (kt < nktA) IDX_MMA(afA, wlA, orowA, kt);
        }
        if (c + 1 < nch) IDX_LSTORE((c + 1) & 1);
        __syncthreads();
    }
#undef IDX_GLOAD
#undef IDX_LSTORE
#undef IDX_MMA
    asm volatile("s_waitcnt vmcnt(0)" ::: "memory");
    for (int q = 0; q < 4; ++q) select_row(F, b * S + ((q & 2) ? tB : tA) + (q & 1));
}
DI void idx_phase(const Frame& F) {
    for (int j = F.bid; j < 256; j += F.G) idx_item(F, j >> 7, j & 127);
}
DI float wave_max(float v) {
#pragma unroll
    for (int o = 1; o < 64; o <<= 1) v = fmaxf(v, __shfl_xor(v, o));
    return v;
}
DI void select_row(const Frame& F, int row) {
    const float* sc = wsp<float>(F, WS_SC); unsigned* mask = wsp<unsigned>(F, WS_MASK);
    const int lane = F.lane;
    {
        const int t = row & (S - 1), n = t + 1, ng = (n + 511) >> 9;
        const float* srow = sc + (size_t)row * S;
        float u[64];
        { const float* p0 = srow + lane; asm volatile("" : "+v"(p0));
#pragma unroll
          for (int e = 0; e < 32; ++e) u[e] = p0[64 * e]; }
        if (ng > 4) { const float* p1 = srow + 2048 + lane; asm volatile("" : "+v"(p1));
#pragma unroll
          for (int e = 0; e < 32; ++e) u[32 + e] = p1[64 * e]; }
        float vmax = -__builtin_inff(), vmin = __builtin_inff();
#pragma unroll
        for (int g = 0; g < 8; ++g) {
            if (g < ng) {
#pragma unroll
                for (int k = 0; k < 8; ++k) { const int e = 8 * g + k, key = 64 * e + lane; const bool ok = key <= t; const float rv = u[e]; u[e] = ok ? rv : -__builtin_inff(); vmax = fmaxf(vmax, u[e]); vmin = fminf(vmin, ok ? rv : __builtin_inff()); }
            } else {
#pragma unroll
                for (int k = 0; k < 8; ++k) u[8 * g + k] = -__builtin_inff();
            }
        }
        float thr = -__builtin_inff();
        if (n > 256) {
            float lo = -wave_max(-vmin), hi = wave_max(vmax);
            { const unsigned hb = __builtin_bit_cast(unsigned, hi); hi = __builtin_bit_cast(float, (hi > 0.f) ? hb + 1u : (hi < 0.f ? hb - 1u : 1u)); }
            thr = lo;
            for (int it = 0; it < 64; ++it) {
                const float mid = lo + 0.5f * (hi - lo);
                if (!(mid > lo) || !(mid < hi)) break;
                int cnt = 0;
#pragma unroll
                for (int g = 0; g < 8; ++g) {
                    if (g < ng) {
                        unsigned long long bb[8];
#pragma unroll
                        for (int k = 0; k < 8; ++k) bb[k] = __ballot(u[8 * g + k] >= mid);
                        __builtin_amdgcn_sched_barrier(0);
#pragma unroll
                        for (int k = 0; k < 8; ++k) cnt += __popcll(bb[k]);
                        __builtin_amdgcn_sched_barrier(0);
                    }
                }
                if (cnt >= 256) { lo = mid; thr = mid; } else hi = mid;
                if (cnt == 256) break;
            }
        }
        unsigned mlo = 0u, mhi = 0u;
#pragma unroll
        for (int g = 0; g < 8; ++g) {
            if (g < ng) {
#pragma unroll
                for (int k = 0; k < 8; ++k) { const int e = 8 * g + k; const unsigned long long bal = __ballot(u[e] >= thr && u[e] > -__builtin_inff()); if (lane == e) { mlo = (unsigned)bal; mhi = (unsigned)(bal >> 32); } }
            }
        }
        *(u32x2*)(mask + (size_t)row * 128 + 2 * lane) = (u32x2){mlo, mhi};
    }
}
DI void lru_load_raw(const float* cu, int tid, int b, int ch, int n, f32x4 (&raw)[5]) {
#pragma unroll
    for (int i = 0; i < 5; ++i) { const int c = tid + 512 * i, row = c >> 4, part = c & 15, tr = 128 * ch - 3 + row;
        raw[i] = (f32x4){0.f, 0.f, 0.f, 0.f}; if (c < 131 * 16 && tr >= 0) raw[i] = *(const f32x4*)(cu + (size_t)(b * S + tr) * 1024 + 64 * n + 4 * part); }
}
template <bool FINAL>
DI void lru_unit(const Frame& F, int layer, int b, int ch, int n, f32x4 (&raw)[5], bool has_next, int nb, int nch, bool load_cw) {
    LAS unsigned char* lds = F.lds;
    LAS float* U32 = (LAS float*)lds;
    LAS unsigned char* Ub = lds + 32768;
    LAS float* LA = (LAS float*)(lds + 51200);
    LAS float* IG = (LAS float*)(lds + 83968);
    LAS f32x2* SUM = (LAS f32x2*)(lds + 116736);
    LAS f32x2* PRE = (LAS f32x2*)(lds + 116736 + 4096);
    const float* cu = wsp<float>(F, WS_CU); const int tid = F.tid, lane = F.lane, w = F.wave, t0 = 128 * ch;
    const int gr_ = lane & 31, gh_ = lane >> 5, gt_ = w & 1;
    const bf16* WTg = wsp<bf16>(F, (gt_ ? WS_WX : WS_WA) + (size_t)layer * SZ_WG) + (size_t)n * 4096;
    bf16x8 bfr[2][4]; float bsv[2], splv[2];
#pragma unroll
    for (int et = 0; et < 2; ++et) { const int e = 32 * et + gr_;
#pragma unroll
        for (int ks = 0; ks < 4; ++ks) bfr[et][ks] = *(const bf16x8*)(WTg + (size_t)e * 64 + 16 * ks + 8 * gh_);
        bsv[et] = (gt_ ? inp<float>(F, I_BX) : inp<float>(F, I_BA))[(size_t)layer * 1024 + 64 * n + e];
        splv[et] = inp<float>(F, I_LAM)[(size_t)layer * 1024 + 64 * n + e]; }
    __syncthreads();
    {
        LAS unsigned char* RAW = lds + 51200; LAS float* CW = (LAS float*)(lds + 124928);
#pragma unroll
        for (int i = 0; i < 5; ++i) { const int c = tid + 512 * i; if (c < 131 * 16) *(LAS f32x4*)(RAW + (c >> 4) * 272 + (c & 15) * 16) = raw[i]; }
        if (load_cw && tid < 80) { const int j = tid >> 4, part = tid & 15;
            const float* src = (j < 4) ? inp<float>(F, I_CONVW) + ((size_t)layer * 4 + j) * 1024 + 64 * n + 4 * part : inp<float>(F, I_CONVB) + (size_t)layer * 1024 + 64 * n + 4 * part;
            *(LAS f32x4*)(CW + j * 64 + 4 * part) = *(const f32x4*)src; }
        if (has_next) lru_load_raw(cu, tid, nb, nch, n, raw);
    }
    __syncthreads();
    {
        const LAS unsigned char* RAW = lds + 51200; const LAS float* CW = (const LAS float*)(lds + 124928);
        const int t = tid >> 2, cg = (tid & 3) * 16;
        f32x4 acc4[4];
#pragma unroll
        for (int q = 0; q < 4; ++q) acc4[q] = *(const LAS f32x4*)(CW + 256 + cg + 4 * q);
#pragma unroll
        for (int j = 0; j < 4; ++j)
#pragma unroll
            for (int q = 0; q < 4; ++q) acc4[q] += *(const LAS f32x4*)(RAW + (t + j) * 272 + (cg + 4 * q) * 4) * *(const LAS f32x4*)(CW + j * 64 + cg + 4 * q);
#pragma unroll
        for (int q = 0; q < 4; ++q) *(LAS f32x4*)(U32 + t * 64 + cg + 4 * q) = acc4[q];
        *(LAS u32x4*)(Ub + t * 144 + cg * 2) = pack8(acc4[0], acc4[1]); *(LAS u32x4*)(Ub + t * 144 + cg * 2 + 16) = pack8(acc4[2], acc4[3]);
    }
    __syncthreads();
    {
        const int r = lane & 31, h = lane >> 5, rt = w >> 1, gt = w & 1;
        bf16x8 af[4];
#pragma unroll
        for (int ks = 0; ks < 4; ++ks) af[ks] = *(const LAS bf16x8*)(Ub + (32 * rt + r) * 144 + (16 * ks + 8 * h) * 2);
#pragma unroll
        for (int et = 0; et < 2; ++et) { const int e = 32 * et + r;
            f32x16 a;
#pragma unroll
            for (int i = 0; i < 16; ++i) a[i] = 0.f;
#pragma unroll
            for (int ks = 0; ks < 4; ++ks) a = MFMA32(af[ks], bfr[et][ks], a);
            const float bs = bsv[et];
            float spl = 0.f; if (gt == 0) spl = -8.0f * log1pf(expf(-splv[et]));
#pragma unroll
            for (int i = 0; i < 16; ++i) { const int tok = 32 * rt + (i & 3) + 8 * (i >> 2) + 4 * h; const float sg = frcp(1.0f + __expf(-(a[i] + bs)));
                if (gt == 0) LA[tok * 64 + e] = sg * spl; else IG[tok * 64 + e] = sg; } }
    }
    __syncthreads();
    float hloc[16], acum[16]; float hl = 0.f, ac = 1.f;
#pragma unroll
    for (int tt = 0; tt < 16; ++tt) { const int tok = 16 * w + tt; const float la = LA[tok * 64 + lane]; const float a = ex2(la * LOG2E); const float y2 = 2.0f * la;
        const float em = (y2 > -0.25f) ? -y2 * (1.0f + y2 * (0.5f + y2 * (0.16666667f + y2 * (0.041666668f + y2 * (0.0083333338f + y2 * 0.0013888889f))))) : 1.0f - a * a;
        const float mult = __builtin_sqrtf(em);
        const float xin = mult * IG[tok * 64 + lane] * U32[tok * 64 + lane]; hl = a * hl + xin; ac *= a; hloc[tt] = hl; acum[tt] = ac; }
    SUM[w * 64 + lane] = (f32x2){ac, hl};
    const f32x2* lsum = wsp<f32x2>(F, WS_LSUM); const int c = 64 * n + lane;
    if (FINAL) {
        float A = 1.f, H = 0.f;
#pragma unroll
        for (int q = 0; q < 4; ++q) { const int j = 4 * w + q; if (j < ch) { const f32x2 sj = lsum[((size_t)(b * 32 + j)) * 1024 + c]; H = sj.x * H + sj.y; A *= sj.x; } }
        PRE[w * 64 + lane] = (f32x2){A, H};
    }
    __syncthreads();
    float cin = 0.f;
    if (FINAL) {
#pragma unroll
        for (int q = 0; q < 8; ++q) { const f32x2 pq = PRE[q * 64 + lane]; cin = pq.x * cin + pq.y; }
    }
    float cw = cin, atot = 1.f, aw = 1.f;
#pragma unroll
    for (int q = 0; q < 8; ++q) { const f32x2 sq = SUM[q * 64 + lane]; if (q < w) { cw = sq.x * cw + sq.y; aw *= sq.x; } atot *= sq.x; }
    if (FINAL) {
        const bf16* G = wsp<bf16>(F, WS_G); bf16* mix = wsp<bf16>(F, WS_MIX);
#pragma unroll
        for (int tt = 0; tt < 16; ++tt) { const size_t o = (size_t)(b * S + t0 + 16 * w + tt) * 4096 + 2048 + c; const float hv = hloc[tt] + acum[tt] * cw; mix[o] = f2bf(hv * bf2f(G[o])); }
    } else {
        unsigned* hl32 = wsp<unsigned>(F, WS_HL);
#pragma unroll
        for (int tt = 0; tt < 16; ++tt) hl32[(size_t)(b * S + t0 + 16 * w + tt) * 1024 + c] = pk2(hloc[tt] + acum[tt] * cw, acum[tt] * aw);
        if (w == 7) { const f32x2 s7 = SUM[7 * 64 + lane]; wsp<f32x2>(F, WS_LSUM)[((size_t)(b * 32 + ch)) * 1024 + c] = (f32x2){atot, s7.x * cw + s7.y}; }
    }
}
DI void lru_final_phase(const Frame& F) {
    const f32x2* lsum = wsp<f32x2>(F, WS_LSUM); const unsigned* hl32 = wsp<unsigned>(F, WS_HL); const bf16* G = wsp<bf16>(F, WS_G); bf16* mix = wsp<bf16>(F, WS_MIX);
    LAS float* car = (LAS float*)F.lds;
    for (int u = F.bid; u < 256; u += F.G) {
        const int b = u >> 7, ch = (u >> 2) & 31, cq = u & 3;
        __syncthreads();
        if (F.tid < 256) { const int c = 256 * cq + F.tid; float H = 0.f;
            for (int j = 0; j < ch; ++j) { const f32x2 sj = lsum[((size_t)(b * 32 + j)) * 1024 + c]; H = sj.x * H + sj.y; }
            car[F.tid] = H; }
        __syncthreads();
        const int cg = F.tid & 31, tl = F.tid >> 5, c0 = 256 * cq + 8 * cg;
        float cr[8];
#pragma unroll
        for (int k = 0; k < 8; ++k) cr[k] = car[8 * cg + k];
#pragma unroll
        for (int i = 0; i < 8; ++i) { const size_t row = (size_t)(b * S + 128 * ch + tl + 16 * i);
            const u32x4 p0 = *(const u32x4*)(hl32 + row * 1024 + c0), p1 = *(const u32x4*)(hl32 + row * 1024 + c0 + 4); const u32x4 g = *(const u32x4*)(G + row * 4096 + 2048 + c0);
            float y[8];
            y[0] = (bflo(p0.x) + bfhi(p0.x) * cr[0]) * bflo(g.x); y[1] = (bflo(p0.y) + bfhi(p0.y) * cr[1]) * bfhi(g.x); y[2] = (bflo(p0.z) + bfhi(p0.z) * cr[2]) * bflo(g.y); y[3] = (bflo(p0.w) + bfhi(p0.w) * cr[3]) * bfhi(g.y);
            y[4] = (bflo(p1.x) + bfhi(p1.x) * cr[4]) * bflo(g.z); y[5] = (bflo(p1.y) + bfhi(p1.y) * cr[5]) * bfhi(g.z); y[6] = (bflo(p1.z) + bfhi(p1.z) * cr[6]) * bflo(g.w); y[7] = (bflo(p1.w) + bfhi(p1.w) * cr[7]) * bfhi(g.w);
            *(u32x4*)(mix + row * 4096 + 2048 + c0) = (u32x4){pk2(y[0], y[1]), pk2(y[2], y[3]), pk2(y[4], y[5]), pk2(y[6], y[7])}; }
    }
}
template <bool FINAL> DI void lru_phase(const Frame& F, int layer) {
    int u0, ustep, uend;
    if (F.G == 256) { if (F.bid < 192) { u0 = F.bid; ustep = 192; uend = 576; } else { u0 = 576 + (F.bid - 192); ustep = 64; uend = 1024; } }
    else { u0 = F.bid; ustep = F.G; uend = 1024; }
    f32x4 raw[5]; int nprev = -1;
    if (u0 < uend) lru_load_raw(wsp<float>(F, WS_CU), F.tid, u0 >> 9, (u0 >> 4) & 31, u0 & 15, raw);
    for (int u = u0; u < uend; u += ustep) { const int un = u + ustep, n = u & 15;
        lru_unit<FINAL>(F, layer, u >> 9, (u >> 4) & 31, n, raw, un < uend && (un & 15) == n, un >> 9, (un >> 4) & 31, n != nprev);
        if (un < uend && (un & 15) != n) lru_load_raw(wsp<float>(F, WS_CU), F.tid, un >> 9, (un >> 4) & 31, un & 15, raw);
        nprev = n; }
}

DI float wave_sum(float v) {
#pragma unroll
    for (int o = 1; o < 64; o <<= 1) v += __shfl_xor(v, o);
    return v;
}
DI void ln_phase(const Frame& F, int layer, bool last) {
    const float* z = wsp<float>(F, WS_Z); bf16* xb = wsp<bf16>(F, WS_XB); f32x2* st = wsp<f32x2>(F, WS_XN);
    const float* g = inp<float>(F, I_LNG) + (size_t)layer * D; const float* bb = inp<float>(F, I_LNB) + (size_t)layer * D;
    const int lane = F.lane;
    for (int row = F.bid * NWAVES + F.wave; row < M; row += F.G * NWAVES) {
        const f32x4* zr = (const f32x4*)(z + (size_t)row * D) + lane;
        f32x4 v[16]; float s = 0.f;
#pragma unroll
        for (int j = 0; j < 16; ++j) { v[j] = zr[64 * j]; s += (v[j][0] + v[j][1]) + (v[j][2] + v[j][3]); }
        const float mean = wave_sum(s) * (1.0f / D); float s2 = 0.f;
#pragma unroll
        for (int j = 0; j < 16; ++j) { v[j] = v[j] - mean; s2 += (v[j][0] * v[j][0] + v[j][1] * v[j][1]) + (v[j][2] * v[j][2] + v[j][3] * v[j][3]); }
        const float rstd = 1.0f / sqrtf(wave_sum(s2) * (1.0f / D) + LN_EPS);
        if (!last && lane == 0) st[row] = (f32x2){mean, rstd};
#pragma unroll
        for (int j = 0; j < 16; ++j) { const int col = 4 * (lane + 64 * j); const f32x4 gg = *(const f32x4*)(g + col), b4 = *(const f32x4*)(bb + col);
            const f32x4 y = v[j] * rstd * gg + b4;
            if (last) *(f32x4*)(F.out + (size_t)row * D + col) = y;
            else *(u32x2*)(xb + (size_t)row * D + col) = (u32x2){pk2(y[0], y[1]), pk2(y[2], y[3])}; }
    }
}

constexpr int NPH = 1 + 5 * DEPTH;
struct Args { const void* in[20]; float* out; unsigned char* ws; int ph_lo, ph_hi; };
static_assert(sizeof(Args) == 20 * 8 + 8 + 8 + 8, "Args has no padding bytes");

DI Frame make_frame(LAS unsigned char* lds, float* out, unsigned char* ws) {
    Frame F; F.lds = lds;
    int t = threadIdx.x; asm volatile("" : "+v"(t)); F.tid = t; F.lane = t & 63; F.wave = __builtin_amdgcn_readfirstlane(t >> 6);
    int b = blockIdx.x, g = gridDim.x; asm volatile("" : "+s"(b), "+s"(g)); F.bid = b; F.G = g;
    F.out = out; F.ws = ws;
    return F;
}
__global__ void __launch_bounds__(NTHR, 2) hybrid_fwd(Args args) {
    extern __shared__ __attribute__((aligned(16))) unsigned char lds_raw[];
    LAS unsigned char* lds = (LAS unsigned char*)lds_raw;
    volatile LAS unsigned* MISC = (volatile LAS unsigned*)(lds + MISC_OFF);
    for (int u = threadIdx.x; u < (LDS_BYTES - LDSCTL_OFF) / 4; u += NTHR) ((LAS unsigned*)(lds + LDSCTL_OFF))[u] = 0u;
    __syncthreads();
    if (threadIdx.x == 0) { LAS unsigned long long* tb = (LAS unsigned long long*)(lds + PTR_OFF);
#define PUT(k) tb[k] = (unsigned long long)args.in[k];
        PUT(0) PUT(1) PUT(2) PUT(3) PUT(4) PUT(5) PUT(6) PUT(7) PUT(8) PUT(9) PUT(10) PUT(11) PUT(12) PUT(13) PUT(14) PUT(15) PUT(16) PUT(17) PUT(18) PUT(19)
#undef PUT
    }
    __syncthreads();
    XcdBarrier bar; bar.bar = (unsigned*)(args.ws + WS_CTL) + CW_BAR; bar.x = 0; bar.st = nullptr;
    if (MK_N_LAUNCHES == 1) bar = xcd_barrier_post((unsigned*)(args.ws + WS_CTL) + CW_BAR, MISC + 8);
#define GRID_BAR() do { if (MK_N_LAUNCHES == 1) xcd_barrier(bar); } while (0)
#define FRAME() const Frame F = make_frame(lds, args.out, args.ws)
    const int lo = args.ph_lo, hi = args.ph_hi;
#define IN(k) (lo <= (k) && (k) < hi)
#define BOTH(k) (IN(k) && IN((k) + 1))

    if (EN(0) && IN(0)) REPS(0) { FRAME(); p0_prologue(F); }
    if (BOTH(0)) GRID_BAR();

    for (int l = 0; l < DEPTH; ++l) {
        const int base = 1 + 5 * l;
        if (IN(base)) {
            const int GA = (l + 1 < DEPTH) ? (int)gridDim.x - 32 : (int)gridDim.x;
            if ((int)blockIdx.x < GA) {
            if (EN(1)) REPS(1) { FRAME(); pg8::Gemm g{wsp<bf16>(F, WS_XB), wsp<bf16>(F, WS_WIN + (size_t)l * SZ_WIN), D, D, D}; pg8::TileOrder So; So.init(M / 256, NT_IN, GA, F.bid);
              EpiA E{F.ws};
              pg8::gemm_phase<EpiA, pg8::TileOrder, true, true>(F.lds, g, So, E); }
            if (EN(2)) REPS(2) { FRAME(); const int r5 = (M / 256) * NT_IN - 5 * GA;
              pg8::Gemm g{wsp<bf16>(F, WS_MEMB), wsp<bf16>(F, WS_WMKV + (size_t)l * SZ_WMKV), D, D, D}; pg8::TileOrder So; So.init(2, 8, GA, (F.bid + GA - r5) % GA);
              EpiMemKV E{F.ws};
              pg8::gemm_phase<EpiMemKV, pg8::TileOrder, true, true>(F.lds, g, So, E); }
            } else if (EN(14)) { FRAME(); if (l == 0) { conv_layer(F, 0, GA, I_IN, I_IN + I_O + I_UQ + I_UKV); conv_layer(F, 0, GA, I_IN + I_O + I_UQ + I_UKV + 2 * I_MK, I_LAYER); } conv_layer(F, l + 1, GA, 0, I_LAYER); }
        }
        if (BOTH(base)) GRID_BAR();
        if (IN(base + 1)) {
            if (EN(3)) REPS(3) { FRAME(); pg8::Gemm g{wsp<bf16>(F, WS_CQ), wsp<bf16>(F, WS_WUQ + (size_t)l * SZ_WUQ), 1024, 1024, 1024}; pg8::TileOrder So; So.init(M / 256, 6, F.G, F.bid);
              EpiUQ E{F.ws};
              pg8::gemm_phase<EpiUQ, pg8::TileOrder, true, true>(F.lds, g, So, E); }
            if (EN(4)) REPS(4) { FRAME(); pg8::Gemm g{wsp<bf16>(F, WS_CKV), wsp<bf16>(F, WS_WUKV + (size_t)l * SZ_WUKV), 512, 512, 512}; pg8::TileOrder So; So.init(M / 256, 8, F.G, F.bid);
              EpiUKV E{F.ws};
              pg8::gemm_phase<EpiUKV, pg8::TileOrder, true, true>(F.lds, g, So, E); }
            if (EN(5)) REPS(5) { FRAME(); idx_phase(F); }
            if (EN(6)) REPS(6) { FRAME(); mem_phase(F); }
            if (EN(7)) REPS(7) { FRAME(); lru_phase<false>(F, l); }
        }
        if (BOTH(base + 1)) GRID_BAR();
        if (IN(base + 2)) { if (EN(8)) REPS(8) { FRAME(); mla_phase(F); } if (EN(11)) REPS(11) { FRAME(); dsa_phase(F); } if (EN(10)) REPS(10) { FRAME(); lru_final_phase(F); } }
        if (BOTH(base + 2)) GRID_BAR();
        if (EN(12) && IN(base + 3)) REPS(12) {
            FRAME(); pg8::Gemm g{wsp<bf16>(F, WS_MIX), wsp<bf16>(F, WS_WO + (size_t)l * SZ_WO), D, D, D}; pg8::TileOrder So; So.init(M / 256, D / 256, F.G, F.bid);
            EpiO E{l == 0 ? inp<float>(F, I_X) : nullptr, inp<float>(F, I_LNG) + (size_t)(l > 0 ? l - 1 : 0) * D, inp<float>(F, I_LNB) + (size_t)(l > 0 ? l - 1 : 0) * D, F.ws};
            pg8::gemm_phase<EpiO, pg8::TileOrder, true, true>(F.lds, g, So, E);
        }
        if (BOTH(base + 3)) GRID_BAR();
        if (EN(13) && IN(base + 4)) REPS(13) { FRAME(); ln_phase(F, l, l == DEPTH - 1); }
        if (BOTH(base + 4)) GRID_BAR();
    }
#undef IN
#undef BOTH
}

extern "C" void kernel_launch(void* const* d_in, const int* in_sizes, int n_in, void* d_out, int out_size, void* d_ws, size_t ws_size, hipStream_t stream) {
    static int grid = 0;
    if (grid == 0) {
        if (n_in != 20 || out_size != M * D || ws_size < WS_END) { fprintf(stderr, "kernel_launch: unexpected shapes (n_in %d, out %d, ws %zu, need %zu)\n", n_in, out_size, ws_size, (size_t)WS_END); grid = -1; return; }
        int dev = 0, cus = 0, per_cu = 0;
        if (hipGetDevice(&dev) != hipSuccess || hipDeviceGetAttribute(&cus, hipDeviceAttributeMultiprocessorCount, dev) != hipSuccess) { grid = -1; return; }
        if (hipFuncSetAttribute((const void*)hybrid_fwd, hipFuncAttributeMaxDynamicSharedMemorySize, LDS_BYTES) != hipSuccess) { fprintf(stderr, "kernel_launch: hipFuncSetAttribute failed\n"); grid = -1; return; }
        if (hipOccupancyMaxActiveBlocksPerMultiprocessor(&per_cu, (const void*)hybrid_fwd, NTHR, LDS_BYTES) != hipSuccess || per_cu < 1) fprintf(stderr, "kernel_launch: occupancy query reports %d\n", per_cu);
        (void)hipGetLastError();
        grid = cus;
    }
    if (grid < 0) return;
    if (hipMemsetAsync((char*)d_ws + WS_CTL, 0, CTL_ZERO_BYTES, stream) != hipSuccess) return;
    Args a{};
    for (int i = 0; i < 20; ++i) a.in[i] = d_in[i];
    a.out = (float*)d_out; a.ws = (unsigned char*)d_ws;
#if MK_N_LAUNCHES == 1
    a.ph_lo = 0; a.ph_hi = NPH;
    hipLaunchKernelGGL(hybrid_fwd, dim3(grid), dim3(NTHR), LDS_BYTES, stream, a);
#else
    for (int p = 0; p < NPH; ++p) { a.ph_lo = p; a.ph_hi = p + 1; hipLaunchKernelGGL(hybrid_fwd, dim3(grid), dim3(NTHR), LDS_BYTES, stream, a); }
#endif
}
```

```cpp
#include <hip/hip_runtime.h>
#include <cstdio>
#include <cstdint>

#ifndef MK_N_LAUNCHES
#define MK_N_LAUNCHES 1
#endif

#ifndef EN_MASK
#define EN_MASK 0xFFFF
#endif
#define EN(k) (((EN_MASK) >> (k)) & 1)
#ifndef REP_MASK
#define REP_MASK 0
#endif
#define REPS(k) for (int rep_ = 0; rep_ < ((((REP_MASK) >> (k)) & 1) ? 2 : 1); ++rep_)
#define DI __device__ __forceinline__
#define LAS __attribute__((address_space(3)))
#define GAS __attribute__((address_space(1)))
typedef unsigned short bf16;
typedef unsigned short bf16_t;
typedef short bf16x8 __attribute__((ext_vector_type(8)));
typedef short s16x4 __attribute__((ext_vector_type(4)));
typedef float f32x4 __attribute__((ext_vector_type(4)));
typedef float f32x2 __attribute__((ext_vector_type(2)));
typedef float f32x16 __attribute__((ext_vector_type(16)));
typedef unsigned u32x4 __attribute__((ext_vector_type(4)));
typedef unsigned u32x2 __attribute__((ext_vector_type(2)));
typedef __bf16 bf16v2 __attribute__((ext_vector_type(2)));
#define MFMA32(a, b, c) __builtin_amdgcn_mfma_f32_32x32x16_bf16((a), (b), (c), 0, 0, 0)

DI unsigned pk2(float lo, float hi) { f32x2 v = {lo, hi}; bf16v2 b = __builtin_convertvector(v, bf16v2); return __builtin_bit_cast(unsigned, b); }
DI bf16 f2bf(float f) { return (bf16)(pk2(f, 0.f) & 0xffffu); }
DI float bf2f(unsigned short b) { return __builtin_bit_cast(float, ((unsigned)b) << 16); }
DI float bflo(unsigned w) { return __builtin_bit_cast(float, w << 16); }
DI float bfhi(unsigned w) { return __builtin_bit_cast(float, w & 0xffff0000u); }
DI u32x4 pack8(f32x4 a, f32x4 b) { u32x4 w; w.x = pk2(a[0], a[1]); w.y = pk2(a[2], a[3]); w.z = pk2(b[0], b[1]); w.w = pk2(b[2], b[3]); return w; }
DI float frcp(float x) { return __builtin_amdgcn_rcpf(x); }
DI float silu_f(float x) { return x * frcp(1.0f + __expf(-x)); }
DI float ex2(float x) { return __builtin_amdgcn_exp2f(x); }
DI float xhalf_max(float v) { const unsigned b = __builtin_bit_cast(unsigned, v); auto r = __builtin_amdgcn_permlane32_swap(b, b, false, false); return fmaxf(__builtin_bit_cast(float, (unsigned)r[0]), __builtin_bit_cast(float, (unsigned)r[1])); }
template <int V> struct IC { static constexpr int value = V; constexpr operator int() const { return V; } };
DI float xhalf_sum(float v) { const unsigned b = __builtin_bit_cast(unsigned, v); auto r = __builtin_amdgcn_permlane32_swap(b, b, false, false); return __builtin_bit_cast(float, (unsigned)r[0]) + __builtin_bit_cast(float, (unsigned)r[1]); }

namespace pg8 {
#define PG8_LAS __attribute__((address_space(3)))
constexpr int BM = 256, BK = 64, HALF = 128, HTB = HALF * BK * 2  , STAGE_BYTES = 8 * HTB, NXCD = 8, WGM = 8;

__host__ __device__ __forceinline__ int lds_byte(int r, int c) { const int st = (r >> 4) * 2 + (c >> 5), rr = r & 15, cc = c & 31, ob = rr * 64 + cc * 2; return st * 1024 + (ob ^ (((ob >> 9) & 1) << 5)); }
__host__ __device__ __forceinline__ void stage_rc(int b, int& R, int& C) { const int st = b / 1024, sb = b % 1024, swz = sb ^ (((sb >> 9) & 1) << 5); R = (st >> 1) * 16 + swz / 64; C = (st & 1) * 32 + (swz % 64) / 2; }
__host__ __device__ __forceinline__ int perm32(int rho) { const int n = rho >> 4, i = rho & 15; return 8 * (i >> 2) + 4 * n + (i & 3); }

struct Unit { int pm, pn; };
struct Gemm { const bf16_t* A; const bf16_t* Bt; int K, lda, ldb; };

struct TileOrder {
    int nM, nN, nwg, G, c;
    __device__ __forceinline__ void init(int nM_, int nN_, int G_, int c_) { nM = nM_; nN = nN_; nwg = nM * nN; G = G_; c = c_; }
    __device__ __forceinline__ bool next(int i, Unit& u) const {
        const long L = (long)i * G + c; if (L >= nwg) return false;
        int wgid = (int)L; { const int q = nwg / NXCD, r = nwg % NXCD, xcd = wgid % NXCD, off = wgid / NXCD; wgid = (xcd < r ? xcd * (q + 1) : r * (q + 1) + (xcd - r) * q) + off; }
        const int nig = WGM * nN, gid = wgid / nig, fm = gid * WGM, gsz = (nM - fm) < WGM ? (nM - fm) : WGM;
        u.pm = fm + ((wgid % nig) % gsz); u.pn = (wgid % nig) / gsz; return true;
    }
    __device__ __forceinline__ void a_ready(const Unit&) const {}
    __device__ __forceinline__ void done(const Unit&) const {}
};
template <class Epi, class Sched, bool ALIGN_EPI = false, bool SP2 = false>
__device__ __forceinline__ void gemm_phase(PG8_LAS unsigned char* lds, const Gemm g, const Sched& S, const Epi& E) {
    int tid_ = threadIdx.x; asm volatile("" : "+v"(tid_));
    const int tid = tid_, wid = __builtin_amdgcn_readfirstlane(tid >> 6), lane = tid & 63, wr = wid >> 2, wc = wid & 3, fr = lane & 15, fq = lane >> 4;
    const int K = g.K, nt = K / BK;
    unsigned voffA[2], voffB[2];
#pragma unroll
    for (int i = 0; i < 2; ++i) { int R, C; stage_rc(tid * 16 + i * 8192, R, C); const int Rb = Epi::PERM ? ((R & ~31) + perm32(R & 31)) : R;
        voffA[i] = (unsigned)(R * g.lda + C) * 2u; voffB[i] = (unsigned)(Rb * g.ldb + C) * 2u; }
    const size_t kstep = (size_t)(BK * 2);
    const size_t hstepA = (size_t)HALF * g.lda * 2, hstepB = (size_t)HALF * g.ldb * 2;
    const size_t tstepA = 2 * hstepA, tstepB = 2 * hstepB;
    const unsigned ldsw = (unsigned)wid * 1024u;
    const int aoff = lds_byte(wr * 64 + fr, fq * 8), boff = lds_byte(wc * 32 + fr, fq * 8);
#define PG8_SA(b, h) (((b) * 2 + (h)) * HTB)
#define PG8_SB(b, h) ((4 + (b) * 2 + (h)) * HTB)
#define PG8_STAGE(bufoff, gbase, voff) do { _Pragma("unroll") for (int _i = 0; _i < 2; ++_i) \
        __builtin_amdgcn_global_load_lds((const unsigned*)((const char*)(gbase) + (voff)[_i]), (PG8_LAS unsigned*)(lds + (bufoff) + ldsw + _i * 8192), 16, 0, 0); } while (0)
#define PG8_LDA(dst, b, h) do { _Pragma("unroll") for (int m = 0; m < 4; ++m) _Pragma("unroll") for (int k = 0; k < 2; ++k) dst[m][k] = *(const PG8_LAS bf16x8*)(lds + PG8_SA(b, h) + aoff + m * 2048 + k * 1024); } while (0)
#define PG8_LDB(dst, b, h) do { _Pragma("unroll") for (int n = 0; n < 2; ++n) _Pragma("unroll") for (int k = 0; k < 2; ++k) dst[n][k] = *(const PG8_LAS bf16x8*)(lds + PG8_SB(b, h) + boff + n * 2048 + k * 1024); } while (0)
#define PG8_MMA(ai, bj, At, Bt) do { __builtin_amdgcn_s_setprio(1); _Pragma("unroll") for (int m = 0; m < 4; ++m) _Pragma("unroll") for (int n = 0; n < 2; ++n) _Pragma("unroll") for (int k = 0; k < 2; ++k) \
        acc[ai][bj][m][n] = __builtin_amdgcn_mfma_f32_16x16x32_bf16(Bt[n][k], At[m][k], acc[ai][bj][m][n], 0, 0, 0); __builtin_amdgcn_s_setprio(0); } while (0)
#define PG8_WAIT_V(n) asm volatile("s_waitcnt vmcnt(" #n ")" ::: "memory")
#define PG8_WAIT_L(n) asm volatile("s_waitcnt lgkmcnt(" #n ")" ::: "memory")
#define PG8_BAR __builtin_amdgcn_s_barrier()
#define PG8_SCHED __builtin_amdgcn_sched_barrier(0)
    Unit cur, nxt; int ui = 0;
    if (!S.next(0, cur)) return;
    f32x4 acc[2][2][4][2];
#pragma unroll
    for (int a = 0; a < 2; ++a)
#pragma unroll
        for (int b = 0; b < 2; ++b)
#pragma unroll
            for (int m = 0; m < 4; ++m)
#pragma unroll
                for (int n = 0; n < 2; ++n) acc[a][b][m][n] = (f32x4){0.f, 0.f, 0.f, 0.f};
    bf16x8 At[4][2], B0[2][2], B1[2][2];
    const char* cA = (const char*)g.A + (size_t)cur.pm * tstepA; const char* cB = (const char*)g.Bt + (size_t)cur.pn * tstepB;
    S.a_ready(cur);
    if constexpr (SP2) {
        PG8_STAGE(PG8_SB(0, 0), cB, voffB); PG8_STAGE(PG8_SB(0, 1), cB + hstepB, voffB); PG8_STAGE(PG8_SA(0, 0), cA, voffA); PG8_STAGE(PG8_SA(0, 1), cA + hstepA, voffA);
        if (wr == 1) PG8_BAR;
        PG8_WAIT_V(2); PG8_BAR;
        PG8_STAGE(PG8_SB(1, 0), cB + kstep, voffB); PG8_STAGE(PG8_SA(1, 0), cA + kstep, voffA); PG8_STAGE(PG8_SB(1, 1), cB + hstepB + kstep, voffB);
        PG8_WAIT_V(6); PG8_BAR;
    } else {
        PG8_STAGE(PG8_SB(0, 0), cB, voffB); PG8_STAGE(PG8_SA(0, 0), cA, voffA); PG8_STAGE(PG8_SB(0, 1), cB + hstepB, voffB); PG8_STAGE(PG8_SA(0, 1), cA + hstepA, voffA);
        if (wr == 1) PG8_BAR;
        PG8_WAIT_V(4); PG8_BAR;
        PG8_STAGE(PG8_SB(1, 0), cB + kstep, voffB); PG8_STAGE(PG8_SA(1, 0), cA + kstep, voffA); PG8_STAGE(PG8_SB(1, 1), cB + hstepB + kstep, voffB);
        PG8_WAIT_V(6); PG8_BAR;
    }
    for (;;) {
        const bool has_next = S.next(ui + 1, nxt);
        const char* nA = has_next ? (const char*)g.A + (size_t)nxt.pm * tstepA : cA; const char* nB = has_next ? (const char*)g.Bt + (size_t)nxt.pn * tstepB : cB;
        for (int t = 0; t < nt; t += 2) {
            const bool last = (t == nt - 2);
            const char* a1 = cA + (size_t)(t + 1) * kstep;
            const char* a2 = last ? nA : cA + (size_t)(t + 2) * kstep; const char* b2 = last ? nB : cB + (size_t)(t + 2) * kstep;
            const char* a3 = a2 + kstep; const char* b3 = b2 + kstep;
            if (last && has_next) S.a_ready(nxt);
            if constexpr (SP2) {
            PG8_LDB(B0, 0, 0); PG8_LDB(B1, 0, 1); PG8_SCHED; PG8_LDA(At, 0, 0); PG8_STAGE(PG8_SA(1, 1), a1 + hstepA, voffA);
            PG8_WAIT_V(8); PG8_WAIT_L(0); PG8_BAR; PG8_MMA(0, 0, At, B0); PG8_MMA(0, 1, At, B1); PG8_BAR; PG8_SCHED;
            PG8_LDA(At, 0, 1); PG8_STAGE(PG8_SB(0, 0), b2, voffB); PG8_STAGE(PG8_SB(0, 1), b2 + hstepB, voffB); PG8_STAGE(PG8_SA(0, 0), a2, voffA);
            PG8_WAIT_V(8); PG8_WAIT_L(0); PG8_BAR; PG8_MMA(1, 0, At, B0); PG8_MMA(1, 1, At, B1); PG8_BAR; PG8_SCHED;
            PG8_LDB(B0, 1, 0); PG8_LDB(B1, 1, 1); PG8_SCHED; PG8_LDA(At, 1, 0); PG8_STAGE(PG8_SA(0, 1), a2 + hstepA, voffA);
            PG8_WAIT_V(8); PG8_WAIT_L(0); PG8_BAR; PG8_MMA(0, 0, At, B0); PG8_MMA(0, 1, At, B1); PG8_BAR; PG8_SCHED;
            PG8_LDA(At, 1, 1); PG8_STAGE(PG8_SB(1, 0), b3, voffB); PG8_STAGE(PG8_SB(1, 1), b3 + hstepB, voffB); PG8_STAGE(PG8_SA(1, 0), a3, voffA);
            PG8_WAIT_V(8); PG8_WAIT_L(0); PG8_BAR; PG8_MMA(1, 0, At, B0); PG8_MMA(1, 1, At, B1); PG8_BAR; PG8_SCHED;
            } else {
            PG8_LDB(B0, 0, 0); PG8_SCHED; PG8_LDA(At, 0, 0); PG8_STAGE(PG8_SA(1, 1), a1 + hstepA, voffA);
            PG8_WAIT_L(8); PG8_BAR; PG8_WAIT_L(0); PG8_MMA(0, 0, At, B0); PG8_BAR; PG8_SCHED;
            PG8_LDB(B1, 0, 1); PG8_STAGE(PG8_SB(0, 0), b2, voffB);
            PG8_BAR; PG8_WAIT_L(0); PG8_MMA(0, 1, At, B1); PG8_BAR;
            PG8_LDA(At, 0, 1); PG8_STAGE(PG8_SA(0, 0), a2, voffA);
            PG8_BAR; PG8_WAIT_L(0); PG8_MMA(1, 0, At, B0); PG8_BAR; PG8_SCHED;
            PG8_STAGE(PG8_SB(0, 1), b2 + hstepB, voffB);
            PG8_WAIT_V(6); PG8_BAR; PG8_MMA(1, 1, At, B1); PG8_BAR;
            PG8_LDB(B0, 1, 0); PG8_SCHED; PG8_LDA(At, 1, 0); PG8_STAGE(PG8_SA(0, 1), a2 + hstepA, voffA);
            PG8_WAIT_L(8); PG8_BAR; PG8_WAIT_L(0); PG8_MMA(0, 0, At, B0); PG8_BAR; PG8_SCHED;
            PG8_LDB(B1, 1, 1); PG8_STAGE(PG8_SB(1, 0), b3, voffB);
            PG8_BAR; PG8_WAIT_L(0); PG8_MMA(0, 1, At, B1); PG8_BAR;
            PG8_LDA(At, 1, 1); PG8_STAGE(PG8_SA(1, 0), a3, voffA);
            PG8_BAR; PG8_WAIT_L(0); PG8_MMA(1, 0, At, B0); PG8_BAR; PG8_SCHED;
            PG8_STAGE(PG8_SB(1, 1), b3 + hstepB, voffB);
            PG8_WAIT_V(6); PG8_BAR; PG8_MMA(1, 1, At, B1); PG8_BAR;
            }
        }
        if constexpr (ALIGN_EPI) { if (wr == 0) PG8_BAR; }
        if constexpr (!Epi::AFTER_DRAIN) { E(acc, cur, wr, wc, fr, fq); S.done(cur); }
        if (!has_next) break;
#pragma unroll
        for (int a = 0; a < 2; ++a)
#pragma unroll
            for (int b = 0; b < 2; ++b)
#pragma unroll
                for (int m = 0; m < 4; ++m)
#pragma unroll
                    for (int n = 0; n < 2; ++n) acc[a][b][m][n] = (f32x4){0.f, 0.f, 0.f, 0.f};
        cur = nxt; cA = nA; cB = nB; ++ui;
        if constexpr (ALIGN_EPI) { if (wr == 1) PG8_BAR; }
    }
    PG8_WAIT_V(0);
    if constexpr (!ALIGN_EPI) { if (wr == 0) PG8_BAR; }
    PG8_BAR;
    if constexpr (Epi::AFTER_DRAIN) { E.fused(acc, cur, wr, wc, fr, fq, lds, wid, lane); S.done(cur); }
#undef PG8_SA
#undef PG8_SB
#undef PG8_STAGE
#undef PG8_LDA
#undef PG8_LDB
#undef PG8_MMA
#undef PG8_WAIT_V
#undef PG8_WAIT_L
#undef PG8_BAR
#undef PG8_SCHED
}
}


constexpr int NB = 2, S = 4096, M = NB * S, D = 4096, DEPTH = 4, NMEM = 256;
constexpr int DIN = 10384, NT_IN = 41, NPAD = NT_IN * 256;
constexpr float LN_EPS = 1e-5f, RMS_EPS = 1e-6f;
constexpr float ALPHA = 1.681792830507429f;
constexpr float LOG2E = 1.4426950408889634f;
constexpr float QS_MLA = 0.07216878364870322f * LOG2E;
constexpr float QS_DSA = 0.08838834764831845f * LOG2E;
constexpr float QS_MEM = 0.0625f * LOG2E;
constexpr int NWAVES = 8, NTHR = 512;

constexpr size_t MiB = 1u << 20;
constexpr size_t WS_CTL = 0, CTL_ZERO_BYTES = 1 * MiB;
constexpr size_t SZ_WIN = (size_t)NPAD * D * 2, SZ_WO = (size_t)D * D * 2, SZ_WUQ = (size_t)1536 * 1024 * 2, SZ_WUKV = (size_t)2048 * 512 * 2,
                 SZ_WMKV = (size_t)2048 * 4096 * 2, SZ_WG = (size_t)16 * 64 * 64 * 2;
constexpr size_t WS_WIN = 1 * MiB;
constexpr size_t WS_WO = WS_WIN + DEPTH * SZ_WIN;
constexpr size_t WS_WUQ = WS_WO + DEPTH * SZ_WO;
constexpr size_t WS_WUKV = WS_WUQ + DEPTH * SZ_WUQ;
constexpr size_t WS_WMKV = WS_WUKV + DEPTH * SZ_WUKV;
constexpr size_t WS_WA = WS_WMKV + DEPTH * SZ_WMKV;
constexpr size_t WS_WX = WS_WA + DEPTH * SZ_WG;
constexpr size_t WS_ACT = ((WS_WX + DEPTH * SZ_WG + MiB - 1) / MiB) * MiB;
constexpr size_t WS_XB = WS_ACT;
constexpr size_t WS_XN = WS_XB + (size_t)M * D * 2;
constexpr size_t WS_HL = WS_XN + MiB;
constexpr size_t WS_Z = WS_XN + (size_t)M * D * 4;
constexpr size_t WS_MEMB = WS_Z + (size_t)M * D * 4;
constexpr size_t WS_CQ = WS_MEMB + (size_t)512 * D * 2;
constexpr size_t WS_CKV = WS_CQ + (size_t)M * 1024 * 2;
constexpr size_t WS_G = WS_CKV + (size_t)M * 512 * 2;
constexpr size_t WS_BQ = WS_G + (size_t)M * 4096 * 2;
constexpr size_t WS_BK = WS_BQ + (size_t)M * 1024 * 2;
constexpr size_t WS_VTD = WS_BK + (size_t)M * 256 * 2;
constexpr size_t WS_QI = WS_VTD + (size_t)M * 256 * 2;
constexpr size_t WS_KI = WS_QI + (size_t)M * 1024 * 2;
constexpr size_t WS_WI = WS_KI + (size_t)M * 64 * 2;
constexpr size_t WS_CU = WS_WI + (size_t)M * 16 * 4;
constexpr size_t WS_DQ = WS_CU + (size_t)M * 1024 * 4;
constexpr size_t WS_SMALL = WS_DQ + (size_t)M * 1024 * 2;
constexpr size_t WS_SSQ = WS_SMALL + (size_t)M * 256 * 4;
constexpr size_t WS_SSKV = WS_SSQ + (size_t)M * 16 * 4;
constexpr size_t WS_QM = WS_SSKV + (size_t)M * 8 * 4;
constexpr size_t WS_KM = WS_QM + (size_t)M * 1536 * 2;
constexpr size_t WS_VTM = WS_KM + (size_t)M * 1536 * 2;
constexpr size_t WS_SC = WS_VTM + (size_t)M * 1024 * 2;
constexpr size_t WS_MASK = WS_SC + (size_t)NB * S * S * 4;
constexpr size_t WS_MIX = WS_MASK + (size_t)M * 128 * 4;
constexpr size_t WS_LSUM = WS_MIX + (size_t)M * 4096 * 2;
constexpr size_t WS_KMEM = WS_LSUM + (size_t)NB * 32 * 1024 * 8;
constexpr size_t WS_VTMEM = WS_KMEM + (size_t)512 * 1024 * 2;
constexpr size_t WS_CSM = WS_VTMEM + (size_t)512 * 1024 * 2;
constexpr size_t WS_CSD = WS_CSM + (size_t)M * 32 * 8;
constexpr size_t WS_CSI = WS_CSD + (size_t)M * 16 * 8;
constexpr size_t WS_END = WS_CSI + (size_t)M * 8 * 8;
constexpr int CW_BAR = 4096;

constexpr int RING_BYTES = 131072;
constexpr int LDSCTL_OFF = RING_BYTES, MISC_OFF = LDSCTL_OFF + 320;
constexpr int LDS_BYTES = 147456;

#define LDS_WAIT() asm volatile("s_waitcnt lgkmcnt(0)" ::: "memory")
#define VM_WAIT() asm volatile("s_waitcnt vmcnt(0)" ::: "memory")

#define XB_TMO      128
#define XB_XCNT(j)  (256  + 64 * (j))
#define XB_XSUB(j)  (1280 + 64 * (j))
#define XB_XGEN(j)  (2304 + 64 * (j))
#define XB_TOP      3328
#define XB_TOPGEN   3392
#define XCD_BAR_WORDS 3456
#define XB_SPIN_CAP (1u << 18)

__device__ __forceinline__ unsigned xb_ld(unsigned* p)              { return __hip_atomic_load(p, __ATOMIC_RELAXED, __HIP_MEMORY_SCOPE_AGENT); }
__device__ __forceinline__ unsigned xb_add(unsigned* p, unsigned v) { return __hip_atomic_fetch_add(p, v, __ATOMIC_RELAXED, __HIP_MEMORY_SCOPE_AGENT); }
__device__ __forceinline__ unsigned xb_xcc_id() { return (unsigned)__builtin_amdgcn_s_getreg((3 << 11) | 20) & 0xFu; }
#define XB_SPIN(cond, bar) do { unsigned _sp = 0; while (cond) { __builtin_amdgcn_s_sleep(1); \
    if ((++_sp & 255u) == 0u) { if (xb_ld(&(bar)[XB_TMO])) break; if (_sp > XB_SPIN_CAP) { atomicAdd(&(bar)[XB_TMO], 1u); break; } } } } while (0)

struct XcdBarrier {
    unsigned* bar; unsigned x;
    volatile LAS unsigned* st;
};

__device__ __forceinline__ XcdBarrier xcd_barrier_post(unsigned* bar, volatile LAS unsigned* st) {
    XcdBarrier b; b.bar = bar; b.x = xb_xcc_id(); b.st = st;
    if (threadIdx.x == 0) (void)xb_add(&bar[XB_XCNT(b.x)], 1u);
    return b;
}
__device__ __forceinline__ void xcd_barrier_complete(unsigned* bar, unsigned x, unsigned& nloc, unsigned& nx) {
    const unsigned G = gridDim.x * gridDim.y * gridDim.z;
    unsigned sum, cnt, mine, sp = 0u;
    for (;;) {
        sum = 0u; cnt = 0u; mine = 0u;
#pragma unroll
        for (unsigned j = 0; j < 16; ++j) { const unsigned c = xb_ld(&bar[XB_XCNT(j)]); sum += c; cnt += (c > 0u) ? 1u : 0u; mine = (j == x) ? c : mine; }
        if (sum == G) break;
        __builtin_amdgcn_s_sleep(1);
        if ((++sp & 255u) == 0u) { if (xb_ld(&bar[XB_TMO])) break; if (sp > XB_SPIN_CAP) { atomicAdd(&bar[XB_TMO], 1u); break; } }
    }
    nloc = mine > 0u ? mine : 1u; nx = cnt > 0u ? cnt : 1u;
}

__device__ __forceinline__ void xcd_barrier(const XcdBarrier& b) {
    asm volatile("s_waitcnt vmcnt(0)" ::: "memory");
    __syncthreads();
    if (threadIdx.x == 0) {
        unsigned* bar = b.bar;
        __builtin_amdgcn_s_waitcnt(0);
        unsigned nloc = b.st[0], nx = b.st[1];
        if (nloc == 0u) { xcd_barrier_complete(bar, b.x, nloc, nx); b.st[0] = nloc; b.st[1] = nx; }
        const unsigned old = xb_add(&bar[XB_XSUB(b.x)], 1u);
        const unsigned gen = old / nloc;
        if (old + 1u == (gen + 1u) * nloc) {
            __builtin_amdgcn_fence(__ATOMIC_RELEASE, "agent");
            asm volatile("s_waitcnt vmcnt(0)" ::: "memory");
            const unsigned og = xb_add(&bar[XB_TOP], 1u);
            const unsigned tg = og / nx;
            if (og + 1u == (tg + 1u) * nx) xb_add(&bar[XB_TOPGEN], 1u);
            else XB_SPIN(xb_ld(&bar[XB_TOPGEN]) == tg, bar);
            __builtin_amdgcn_fence(__ATOMIC_ACQUIRE, "agent");
            xb_add(&bar[XB_XGEN(b.x)], 1u);
            asm volatile("s_waitcnt vmcnt(0)" ::: "memory");
        } else {
            XB_SPIN(xb_ld(&bar[XB_XGEN(b.x)]) == gen, bar);
            __builtin_amdgcn_fence(__ATOMIC_ACQUIRE, "agent");
            asm volatile("s_waitcnt vmcnt(0)" ::: "memory");
        }
    }
    __syncthreads();

}

struct Frame {
    LAS unsigned char* lds;
    int tid, lane, wave, G, bid;
    float* out; unsigned char* ws;
};
constexpr int PTR_OFF = LDSCTL_OFF + 1024;
enum { I_X = 0, I_MEM, I_POS, I_WIN, I_GCQ, I_GCKV, I_WUQ, I_WUKV, I_CONVW, I_CONVB, I_WA, I_BA, I_WX, I_BX, I_LAM, I_WMK, I_WMV, I_WO, I_LNG, I_LNB };
template <class T> DI const T* inp(const Frame& F, int k) {
    const unsigned long long v = ((const LAS unsigned long long*)(F.lds + PTR_OFF))[k];
    const unsigned lo = __builtin_amdgcn_readfirstlane((unsigned)v), hi = __builtin_amdgcn_readfirstlane((unsigned)(v >> 32));
    return (const T*)(const GAS T*)(((unsigned long long)hi << 32) | lo);
}
template <class T> DI T* wsp(const Frame& F, size_t off) { return (T*)(F.ws + off); }

DI int ropeperm(int dp, int half) { const int i = dp >> 1; return (dp & 1) ? half + i : i; }
DI int win_src(int nc) {
    const int t = nc >> 8, j = nc & 255;
    if (t < 4) return t * 256 + j;
    if (t < 6) return 1024 + (t - 4) * 256 + j;
    if (t < 10) return 1600 + (t - 6) * 256 + j;
    if (t < 14) { const int c = (t - 10) * 256 + j, hd = c >> 7, dp = c & 127; return 2624 + hd * 128 + (dp < 32 ? ropeperm(dp, 16) : dp); }
    if (t == 14) { const int hd = j >> 7, dp = j & 127; return 3648 + hd * 128 + (dp < 32 ? ropeperm(dp, 16) : dp); }
    if (t == 15) return 3904 + j;
    if (t < 20) { const int c = (t - 16) * 256 + j, hd = c >> 6, dp = c & 63; return 4160 + hd * 64 + (dp < 16 ? ropeperm(dp, 8) : dp); }
    if (t < 24) return 5264 + (t - 20) * 256 + j;
    if (t < 28) return 6288 + (t - 24) * 256 + j;
    if (t < 32) return 7312 + (t - 28) * 256 + j;
    if (t < 36) return 8336 + (t - 32) * 256 + j;
    if (t < 40) return 9360 + (t - 36) * 256 + j;
    if (j < 64) return 1536 + ropeperm(j, 32);
    if (j < 128) { const int dp = j - 64; return 5184 + (dp < 16 ? ropeperm(dp, 8) : dp); }
    if (j < 144) return 5248 + (j - 128);
    return -1;
}
DI int wuq_src(int nc) {
    if (nc < 1024) return (nc >> 7) * 192 + (nc & 127);
    const int r = nc - 1024; return (r >> 6) * 192 + 128 + ropeperm(r & 63, 32);
}
template <int MAP> DI int conv_src(int n) { return (MAP == 1) ? win_src(n) : (MAP == 2) ? wuq_src(n) : n; }
template <int MAP> DI void conv_item(const float* W, int ldw, const float* kscale, bf16* WT, int ldk, int k0, int n0, LAS unsigned char* scr, int lane) {
    const int nq = lane & 15, kq = lane >> 4;
    const int sc0 = conv_src<MAP>(n0 + 4 * nq), sc1 = conv_src<MAP>(n0 + 4 * nq + 1), sc2 = conv_src<MAP>(n0 + 4 * nq + 2), sc3 = conv_src<MAP>(n0 + 4 * nq + 3);
    const bool contig = (sc0 >= 0) && (sc3 == sc0 + 3) && (sc1 == sc0 + 1) && (sc2 == sc0 + 2);
    f32x4 v[16];
    if (contig) {
#pragma unroll
        for (int i = 0; i < 16; ++i) v[i] = __builtin_nontemporal_load((const f32x4*)(W + (size_t)(k0 + 4 * i + kq) * ldw + sc0));
    } else {
#pragma unroll
        for (int i = 0; i < 16; ++i) { const float* wr = W + (size_t)(k0 + 4 * i + kq) * ldw;
            v[i][0] = sc0 >= 0 ? wr[sc0] : 0.f; v[i][1] = sc1 >= 0 ? wr[sc1] : 0.f; v[i][2] = sc2 >= 0 ? wr[sc2] : 0.f; v[i][3] = sc3 >= 0 ? wr[sc3] : 0.f; }
    }
    if (kscale) {
#pragma unroll
        for (int i = 0; i < 16; ++i) v[i] = v[i] * kscale[k0 + 4 * i + kq];
    }
#pragma unroll
    for (int i = 0; i < 16; ++i) { const int k = 4 * i + kq; *(LAS f32x4*)(scr + k * 256 + 16 * (nq ^ ((k >> 3) & 7))) = v[i]; }
    LDS_WAIT(); asm volatile("" ::: "memory");
#pragma unroll
    for (int j = 0; j < 8; ++j) { const int c = lane + 64 * j, n = c >> 3, kc = c & 7;
        const LAS unsigned char* p = scr + 16 * ((n >> 2) ^ kc) + 4 * (n & 3) + (8 * kc) * 256;
        u32x4 o; o.x = pk2(*(const LAS float*)(p), *(const LAS float*)(p + 256)); o.y = pk2(*(const LAS float*)(p + 512), *(const LAS float*)(p + 768));
        o.z = pk2(*(const LAS float*)(p + 1024), *(const LAS float*)(p + 1280)); o.w = pk2(*(const LAS float*)(p + 1536), *(const LAS float*)(p + 1792));
        __builtin_nontemporal_store(o, (u32x4*)(WT + (size_t)(n0 + n) * ldk + k0 + 8 * kc)); }
    LDS_WAIT(); asm volatile("" ::: "memory");
}
constexpr int I_IN = (D / 64) * (NPAD / 64), I_O = (D / 64) * (D / 64), I_UQ = (1024 / 64) * (1536 / 64), I_UKV = (512 / 64) * (2048 / 64), I_MK = (D / 64) * (1024 / 64), I_G = 16;
constexpr int I_LAYER = I_IN + I_O + I_UQ + I_UKV + 2 * I_MK + 2 * I_G;
DI void conv_layer_item(const Frame& F, int l, int r, LAS unsigned char* scr) {
    if (r < I_IN) { const int nb = NPAD / 64; conv_item<1>(inp<float>(F, I_WIN) + (size_t)l * D * DIN, DIN, nullptr, wsp<bf16>(F, WS_WIN + l * SZ_WIN), D, 64 * (r / nb), 64 * (r % nb), scr, F.lane); return; } r -= I_IN;
    if (r < I_O) { const int nb = D / 64; conv_item<0>(inp<float>(F, I_WO) + (size_t)l * D * D, D, nullptr, wsp<bf16>(F, WS_WO + l * SZ_WO), D, 64 * (r / nb), 64 * (r % nb), scr, F.lane); return; } r -= I_O;
    if (r < I_UQ) { const int nb = 1536 / 64; conv_item<2>(inp<float>(F, I_WUQ) + (size_t)l * 1024 * 1536, 1536, inp<float>(F, I_GCQ) + l * 1024, wsp<bf16>(F, WS_WUQ + l * SZ_WUQ), 1024, 64 * (r / nb), 64 * (r % nb), scr, F.lane); return; } r -= I_UQ;
    if (r < I_UKV) { const int nb = 2048 / 64; conv_item<0>(inp<float>(F, I_WUKV) + (size_t)l * 512 * 2048, 2048, inp<float>(F, I_GCKV) + l * 512, wsp<bf16>(F, WS_WUKV + l * SZ_WUKV), 512, 64 * (r / nb), 64 * (r % nb), scr, F.lane); return; } r -= I_UKV;
    if (r < I_MK) { const int nb = 1024 / 64; conv_item<0>(inp<float>(F, I_WMK) + (size_t)l * D * 1024, 1024, nullptr, wsp<bf16>(F, WS_WMKV + l * SZ_WMKV), D, 64 * (r / nb), 64 * (r % nb), scr, F.lane); return; } r -= I_MK;
    if (r < I_MK) { const int nb = 1024 / 64; conv_item<0>(inp<float>(F, I_WMV) + (size_t)l * D * 1024, 1024, nullptr, wsp<bf16>(F, WS_WMKV + l * SZ_WMKV) + (size_t)1024 * D, D, 64 * (r / nb), 64 * (r % nb), scr, F.lane); return; } r -= I_MK;
    if (r < I_G) { conv_item<0>(inp<float>(F, I_WA) + ((size_t)l * 16 + r) * 4096, 64, nullptr, wsp<bf16>(F, WS_WA + l * SZ_WG) + r * 4096, 64, 0, 0, scr, F.lane); return; } r -= I_G;
    conv_item<0>(inp<float>(F, I_WX) + ((size_t)l * 16 + r) * 4096, 64, nullptr, wsp<bf16>(F, WS_WX + l * SZ_WG) + r * 4096, 64, 0, 0, scr, F.lane);
}
DI void conv_layer(const Frame& F, int l, int wg_lo, int it_lo, int it_hi) {
    if (F.bid < wg_lo) return;
    LAS unsigned char* scr = F.lds + F.wave * 16384;
    const int gw = (F.bid - wg_lo) * NWAVES + F.wave, NGW = (F.G - wg_lo) * NWAVES;
    for (int it = it_lo + gw; it < it_hi; it += NGW) conv_layer_item(F, l, it, scr);
}
DI void rope_entry(int pos, int i, int rot, float& c, float& s) {
    const double e = -((double)(2 * i) / (double)rot) * 13.122363377404329;
    const float inv = (float)exp(e);
    const float ang = (float)pos * inv;
    const double a = (double)ang; const double n = rint(a * 0.15915494309189535); const double r = a - n * 6.283185307179586;
    const float rf = (float)r; c = cosf(rf); s = sinf(rf);
}
DI void p0_prologue(const Frame& F) {
    conv_layer(F, 0, 0, 0, I_IN);
    conv_layer(F, 0, 0, I_IN + I_O + I_UQ + I_UKV, I_IN + I_O + I_UQ + I_UKV + 2 * I_MK);
    const int gw = F.bid * NWAVES + F.wave, NGW = F.G * NWAVES; (void)gw; (void)NGW;
    const size_t gt = (size_t)F.bid * NTHR + F.tid, NGT = (size_t)F.G * NTHR;
    { bf16* xb = wsp<bf16>(F, WS_XB); const float* xin = inp<float>(F, I_X); for (size_t i = gt; i < (size_t)M * D / 8; i += NGT) { const f32x4 a = *(const f32x4*)(xin + i * 8), b = *(const f32x4*)(xin + i * 8 + 4); *(u32x4*)(xb + i * 8) = pack8(a, b); } }
    { bf16* mb = wsp<bf16>(F, WS_MEMB); const float* min_ = inp<float>(F, I_MEM); for (size_t i = gt; i < (size_t)512 * D / 8; i += NGT) { const f32x4 a = *(const f32x4*)(min_ + i * 8), b = *(const f32x4*)(min_ + i * 8 + 4); *(u32x4*)(mb + i * 8) = pack8(a, b); } }
    { f32x2* csm = wsp<f32x2>(F, WS_CSM); f32x2* csd = wsp<f32x2>(F, WS_CSD); f32x2* csi = wsp<f32x2>(F, WS_CSI);
      for (size_t i = gt; i < (size_t)M * 56; i += NGT) { const int row = (int)(i / 56), e = (int)(i % 56); const int p = inp<int>(F, I_POS)[row]; float c, s;
          if (e < 32) { rope_entry(p, e, 64, c, s); csm[(size_t)row * 32 + e] = (f32x2){c, s}; }
          else if (e < 48) { rope_entry(p, e - 32, 32, c, s); csd[(size_t)row * 16 + e - 32] = (f32x2){c, s}; }
          else { rope_entry(p, e - 48, 16, c, s); csi[(size_t)row * 8 + e - 48] = (f32x2){c, s}; } } }
}

using pg8::Unit;
DI void rope8(f32x4& v0, f32x4& v1, const f32x2* cs) {
    const f32x4 a = *(const f32x4*)cs, b = *(const f32x4*)(cs + 2);
    float x1, x2;
    x1 = v0[0]; x2 = v0[1]; v0[0] = x1 * a[0] - x2 * a[1]; v0[1] = x2 * a[0] + x1 * a[1];
    x1 = v0[2]; x2 = v0[3]; v0[2] = x1 * a[2] - x2 * a[3]; v0[3] = x2 * a[2] + x1 * a[3];
    x1 = v1[0]; x2 = v1[1]; v1[0] = x1 * b[0] - x2 * b[1]; v1[1] = x2 * b[0] + x1 * b[1];
    x1 = v1[2]; x2 = v1[3]; v1[2] = x1 * b[2] - x2 * b[3]; v1[3] = x2 * b[2] + x1 * b[3];
}
#define EPI_LOOP_BEGIN _Pragma("unroll") for (int ai = 0; ai < 2; ++ai) _Pragma("unroll") for (int m = 0; m < 4; ++m) { const int row = rbase + ai * 128 + m * 16; _Pragma("unroll") for (int bj = 0; bj < 2; ++bj) { \
        f32x4 v0 = acc[ai][bj][m][0], v1 = acc[ai][bj][m][1]; const int ct = ctb + bj * 128; (void)ct; (void)row;
#define EPI_LOOP_END } }

struct EpiA {
    static constexpr bool PERM = true, AFTER_DRAIN = false;
    unsigned char* ws;
    DI void operator()(const f32x4 (&acc)[2][2][4][2], const Unit& u, int wr, int wc, int fr, int fq) const {
        asm volatile("" : "+v"(fr), "+v"(fq));
        bf16 *cq = (bf16*)(ws + WS_CQ), *ckv = (bf16*)(ws + WS_CKV), *G = (bf16*)(ws + WS_G), *bq = (bf16*)(ws + WS_BQ), *bk = (bf16*)(ws + WS_BK), *vtd = (bf16*)(ws + WS_VTD), *qi = (bf16*)(ws + WS_QI), *dq = (bf16*)(ws + WS_DQ),
             *km = (bf16*)(ws + WS_KM), *ki = (bf16*)(ws + WS_KI); float *cu = (float*)(ws + WS_CU), *wi = (float*)(ws + WS_WI), *ssq = (float*)(ws + WS_SSQ), *sskv = (float*)(ws + WS_SSKV);
        const f32x2 *csm = (const f32x2*)(ws + WS_CSM), *csd = (const f32x2*)(ws + WS_CSD), *csi = (const f32x2*)(ws + WS_CSI);
        const int tile = u.pn, rbase = u.pm * 256 + wr * 64 + fr, ctb = wc * 32 + 8 * fq;
        if (tile < 6) {
            const bool isq = tile < 4; bf16* dst = isq ? cq : ckv; const int ld = isq ? 1024 : 512, tcol = isq ? tile * 256 : (tile - 4) * 256;
#pragma unroll
            for (int ai = 0; ai < 2; ++ai)
#pragma unroll
                for (int m = 0; m < 4; ++m) { const int row = rbase + ai * 128 + m * 16; float ss = 0.f;
#pragma unroll
                    for (int bj = 0; bj < 2; ++bj) { const f32x4 v0 = acc[ai][bj][m][0], v1 = acc[ai][bj][m][1];
                        *(u32x4*)(dst + (size_t)row * ld + tcol + ctb + bj * 128) = pack8(v0, v1);
                        ss += (v0[0] * v0[0] + v0[1] * v0[1]) + (v0[2] * v0[2] + v0[3] * v0[3]) + (v1[0] * v1[0] + v1[1] * v1[1]) + (v1[2] * v1[2] + v1[3] * v1[3]); }
                    ss += __shfl_xor(ss, 16); ss += __shfl_xor(ss, 32);
                    if (fq == 0) { if (isq) ssq[(size_t)row * 16 + tile * 4 + wc] = ss; else sskv[(size_t)row * 8 + (tile - 4) * 4 + wc] = ss; } }
        } else if (tile < 10 || (tile >= 20 && tile < 24) || (tile >= 28 && tile < 32) || tile >= 36 && tile < 40) {
            const int gcol = tile < 10 ? (tile - 6) * 256 : tile < 24 ? 1024 + (tile - 20) * 256 : tile < 32 ? 2048 + (tile - 28) * 256 : 3072 + (tile - 36) * 256;
            EPI_LOOP_BEGIN
#pragma unroll
                for (int j = 0; j < 4; ++j) { v0[j] = silu_f(v0[j]); v1[j] = silu_f(v1[j]); }
                *(u32x4*)(G + (size_t)row * 4096 + gcol + ct) = pack8(v0, v1);
            EPI_LOOP_END
        } else if (tile < 15) {
            const bool isq = tile < 14; bf16* dst = isq ? bq : bk; const int ld = isq ? 1024 : 256, tcol = isq ? (tile - 10) * 256 : 0; const float sc = isq ? QS_DSA : 1.0f;
            EPI_LOOP_BEGIN
                if (wc == 0) rope8(v0, v1, csd + (size_t)row * 16 + 4 * fq);
                v0 = v0 * sc; v1 = v1 * sc;
                *(u32x4*)(dst + (size_t)row * ld + tcol + ct) = pack8(v0, v1);
            EPI_LOOP_END
        } else if (tile == 15) {
            EPI_LOOP_BEGIN
                const int b = row >> 12, t = row & 4095, d0 = wc * 32 + 8 * fq; bf16* p = vtd + ((size_t)(b * 2 + bj) * 128 + d0) * S + t;
#pragma unroll
                for (int j = 0; j < 4; ++j) { p[(size_t)j * S] = f2bf(v0[j]); p[(size_t)(j + 4) * S] = f2bf(v1[j]); }
            EPI_LOOP_END
        } else if (tile < 20) {
            EPI_LOOP_BEGIN
                if ((wc & 1) == 0 && fq < 2) rope8(v0, v1, csi + (size_t)row * 8 + 4 * fq);
                v0 = v0 * 0.125f; v1 = v1 * 0.125f;
                *(u32x4*)(qi + (size_t)row * 1024 + (tile - 16) * 256 + ct) = pack8(v0, v1);
            EPI_LOOP_END
        } else if (tile < 28) {
            EPI_LOOP_BEGIN
                float* p = cu + (size_t)row * 1024 + (tile - 24) * 256 + ct; *(f32x4*)p = v0; *(f32x4*)(p + 4) = v1;
            EPI_LOOP_END
        } else if (tile < 36) {
            EPI_LOOP_BEGIN
                v0 = v0 * QS_MEM; v1 = v1 * QS_MEM;
                *(u32x4*)(dq + (size_t)row * 1024 + (tile - 32) * 256 + ct) = pack8(v0, v1);
            EPI_LOOP_END
        } else {
            EPI_LOOP_BEGIN
                if (ct < 64) { rope8(v0, v1, csm + (size_t)row * 32 + (ct >> 1)); const u32x4 w = pack8(v0, v1);
#pragma unroll
                    for (int hd = 0; hd < 8; ++hd) *(u32x4*)(km + ((size_t)row * 8 + hd) * 192 + 128 + ct) = w; }
                else if (ct < 128) { const int dp = ct - 64; if (dp < 16) rope8(v0, v1, csi + (size_t)row * 8 + (dp >> 1)); *(u32x4*)(ki + (size_t)row * 64 + dp) = pack8(v0, v1); }
                else if (ct < 144) { float* p = wi + (size_t)row * 16 + (ct - 128); *(f32x4*)p = v0 * 0.25f; *(f32x4*)(p + 4) = v1 * 0.25f; }
            EPI_LOOP_END
        }
    }
};
struct EpiMemKV {
    static constexpr bool PERM = true, AFTER_DRAIN = false;
    unsigned char* ws;
    DI void operator()(const f32x4 (&acc)[2][2][4][2], const Unit& u, int wr, int wc, int fr, int fq) const {
        asm volatile("" : "+v"(fr), "+v"(fq));
        bf16 *kmem = (bf16*)(ws + WS_KMEM), *vtmem = (bf16*)(ws + WS_VTMEM);
        const int tile = u.pn, rbase = u.pm * 256 + wr * 64 + fr, ctb = wc * 32 + 8 * fq;
        if (tile < 4) {
            EPI_LOOP_BEGIN
                *(u32x4*)(kmem + (size_t)row * 1024 + tile * 256 + ct) = pack8(v0, v1);
            EPI_LOOP_END
        } else {
            EPI_LOOP_BEGIN
                const int b = row >> 8, mm = row & 255; bf16* p = vtmem + ((size_t)(b * 4 + (tile - 4)) * 256 + ct) * 256 + mm;
#pragma unroll
                for (int j = 0; j < 4; ++j) { p[(size_t)j * 256] = f2bf(v0[j]); p[(size_t)(j + 4) * 256] = f2bf(v1[j]); }
            EPI_LOOP_END
        }
    }
};
struct EpiUQ {
    static constexpr bool PERM = true, AFTER_DRAIN = false;
    unsigned char* ws;
    DI void operator()(const f32x4 (&acc)[2][2][4][2], const Unit& u, int wr, int wc, int fr, int fq) const {
        asm volatile("" : "+v"(fr), "+v"(fq));
        bf16* qm = (bf16*)(ws + WS_QM); const float* ssq = (const float*)(ws + WS_SSQ); const f32x2* csm = (const f32x2*)(ws + WS_CSM);
        const int tile = u.pn, rbase = u.pm * 256 + wr * 64 + fr, ctb = wc * 32 + 8 * fq;
        float rs[2][4];
#pragma unroll
        for (int ai = 0; ai < 2; ++ai)
#pragma unroll
            for (int m = 0; m < 4; ++m) { const float* p = ssq + (size_t)(rbase + ai * 128 + m * 16) * 16; const f32x4 a = *(const f32x4*)p, b = *(const f32x4*)(p + 4), c = *(const f32x4*)(p + 8), d = *(const f32x4*)(p + 12);
                const float s = ((a[0] + a[1]) + (a[2] + a[3])) + ((b[0] + b[1]) + (b[2] + b[3])) + ((c[0] + c[1]) + (c[2] + c[3])) + ((d[0] + d[1]) + (d[2] + d[3]));
                rs[ai][m] = rsqrtf(s * (1.0f / 1024.0f) + RMS_EPS) * QS_MLA; }
        if (tile < 4) {
            EPI_LOOP_BEGIN
                const int head = tile * 2 + bj, d0 = wc * 32 + 8 * fq; v0 = v0 * rs[ai][m]; v1 = v1 * rs[ai][m];
                *(u32x4*)(qm + ((size_t)row * 8 + head) * 192 + d0) = pack8(v0, v1);
            EPI_LOOP_END
        } else {
            EPI_LOOP_BEGIN
                const int head = (tile - 4) * 4 + (ct >> 6), dp = ct & 63;
                rope8(v0, v1, csm + (size_t)row * 32 + (dp >> 1)); v0 = v0 * rs[ai][m]; v1 = v1 * rs[ai][m];
                *(u32x4*)(qm + ((size_t)row * 8 + head) * 192 + 128 + dp) = pack8(v0, v1);
            EPI_LOOP_END
        }
    }
};
struct EpiUKV {
    static constexpr bool PERM = true, AFTER_DRAIN = false;
    unsigned char* ws;
    DI void operator()(const f32x4 (&acc)[2][2][4][2], const Unit& u, int wr, int wc, int fr, int fq) const {
        asm volatile("" : "+v"(fr), "+v"(fq));
        bf16 *km = (bf16*)(ws + WS_KM), *vtm = (bf16*)(ws + WS_VTM); const float* sskv = (const float*)(ws + WS_SSKV);
        const int head = u.pn, rbase = u.pm * 256 + wr * 64 + fr, ctb = wc * 32 + 8 * fq;
        float rs[2][4];
#pragma unroll
        for (int ai = 0; ai < 2; ++ai)
#pragma unroll
            for (int m = 0; m < 4; ++m) { const float* p = sskv + (size_t)(rbase + ai * 128 + m * 16) * 8; const f32x4 a = *(const f32x4*)p, b = *(const f32x4*)(p + 4);
                const float s = ((a[0] + a[1]) + (a[2] + a[3])) + ((b[0] + b[1]) + (b[2] + b[3]));
                rs[ai][m] = rsqrtf(s * (1.0f / 512.0f) + RMS_EPS); }
        EPI_LOOP_BEGIN
            v0 = v0 * rs[ai][m]; v1 = v1 * rs[ai][m]; const int d0 = wc * 32 + 8 * fq;
            if (bj == 0) *(u32x4*)(km + ((size_t)row * 8 + head) * 192 + d0) = pack8(v0, v1);
            else { const int b = row >> 12, t = row & 4095; bf16* p = vtm + ((size_t)(b * 8 + head) * 128 + d0) * S + t;
#pragma unroll
                for (int j = 0; j < 4; ++j) { p[(size_t)j * S] = f2bf(v0[j]); p[(size_t)(j + 4) * S] = f2bf(v1[j]); } }
        EPI_LOOP_END
    }
};
struct EpiO {
    static constexpr bool PERM = true, AFTER_DRAIN = false;
    const float* xin; const float* g; const float* bb; unsigned char* ws;
    DI void operator()(const f32x4 (&acc)[2][2][4][2], const Unit& u, int wr, int wc, int fr, int fq) const {
        asm volatile("" : "+v"(fr), "+v"(fq));
        float* z = (float*)(ws + WS_Z); const f32x2* st = (const f32x2*)(ws + WS_XN);
        const int rbase = u.pm * 256 + wr * 64 + fr, ctb = u.pn * 256 + wc * 32 + 8 * fq;
        if (xin) {
            EPI_LOOP_BEGIN
                const size_t o = (size_t)row * D + ct; const f32x4 r0 = *(const f32x4*)(xin + o), r1 = *(const f32x4*)(xin + o + 4);
                *(f32x4*)(z + o) = r0 * ALPHA + v0; *(f32x4*)(z + o + 4) = r1 * ALPHA + v1;
            EPI_LOOP_END
        } else {
            f32x4 g0[2], g1[2], b0[2], b1[2];
#pragma unroll
            for (int bj = 0; bj < 2; ++bj) { const int c = ctb + bj * 128; g0[bj] = *(const f32x4*)(g + c) * ALPHA; g1[bj] = *(const f32x4*)(g + c + 4) * ALPHA; b0[bj] = *(const f32x4*)(bb + c) * ALPHA; b1[bj] = *(const f32x4*)(bb + c + 4) * ALPHA; }
#pragma unroll
            for (int ai = 0; ai < 2; ++ai)
#pragma unroll
                for (int m = 0; m < 4; ++m) { const int row = rbase + ai * 128 + m * 16; const f32x2 ms = st[row];
#pragma unroll
                    for (int bj = 0; bj < 2; ++bj) { const size_t o = (size_t)row * D + ctb + bj * 128; const f32x4 z0 = *(const f32x4*)(z + o), z1 = *(const f32x4*)(z + o + 4);
                        *(f32x4*)(z + o) = (z0 - ms.x) * ms.y * g0[bj] + b0[bj] + acc[ai][bj][m][0]; *(f32x4*)(z + o + 4) = (z1 - ms.x) * ms.y * g1[bj] + b1[bj] + acc[ai][bj][m][1]; } }
        }
    }
};
template <int DQK> struct AttnCfg { static constexpr int CPR = DQK / 8, KROW = DQK * 2, KBYTES = 64 * KROW, NKC = DQK / 64; };
template <int DQK> DI int attn_kswz(int rho) { return (DQK == 192) ? ((rho >> 1) & 7) : (rho & 15); }
template <int DQK, int MODE, int NDB>
DI void attn_unit(LAS unsigned char* lds, int tid, int wid, int lane,
                  const bf16* Qw, int qstride, const bf16* Kb, int kstride, const bf16* VTb, int vtstride, int nkt, int qpos0,
                  const unsigned* maskrow0, bf16* Ow, const bf16* Gw, int ostride) {
    typedef AttnCfg<DQK> C;
    constexpr bool PIPE = (DQK != 256);
    constexpr int NBUF = PIPE ? 3 : 2;
    constexpr int VBYTES = 32 * NDB * 128, KOFF0 = 0, VOFF0 = NBUF * C::KBYTES;
    const int r = lane & 31, h = lane >> 5, grp = wid >> 2;
    bf16x8 qf[DQK / 16];
    { const unsigned qoff = (unsigned)(r * qstride + 8 * h) * 2u;
#pragma unroll
      for (int ks = 0; ks < DQK / 16; ++ks) qf[ks] = *(const bf16x8*)((const char*)Qw + qoff + 32 * ks); }
    f32x16 o[NDB];
#pragma unroll
    for (int db = 0; db < NDB; ++db)
#pragma unroll
        for (int i = 0; i < 16; ++i) o[db][i] = 0.f;
    float mrun = -1e30f, lrun = 0.f;
    unsigned ksrc[C::NKC], vsrc0;
#pragma unroll
    for (int q = 0; q < C::NKC; ++q) { const int L = (8 * q + wid) * 64 + lane, rho = L / C::CPR, cp = L % C::CPR, r5 = rho & 31;
        const int key = (rho & 32) + (r5 & 19) + ((r5 & 4) << 1) + ((r5 & 8) >> 1);
        ksrc[q] = (unsigned)(key * kstride) * 2u + (unsigned)((cp ^ attn_kswz<DQK>(rho)) * 16); }
    { const int L = wid * 64 + lane, d = L >> 3, cp = L & 7; vsrc0 = (unsigned)(d * vtstride) * 2u + (unsigned)((cp ^ ((d >> 1) & 7)) * 16); }
#define ATTN_DMAK(kt_, buf_) do { const int kc_ = (kt_) < nkt ? (kt_) : nkt - 1; const char* kb_ = (const char*)Kb + (size_t)kc_ * (size_t)(128 * kstride); \
        _Pragma("unroll") for (int q = 0; q < C::NKC; ++q) __builtin_amdgcn_global_load_lds((const unsigned*)(kb_ + ksrc[q]), (LAS unsigned*)(lds + KOFF0 + (buf_) * C::KBYTES + (8 * q + wid) * 1024), 16, 0, 0); } while (0)
#define ATTN_DMAV(kt_, buf_) do { const int kc_ = (kt_) < nkt ? (kt_) : nkt - 1; const char* vb_ = (const char*)VTb + (size_t)kc_ * 128; \
        _Pragma("unroll") for (int q = 0; q < NDB / 2; ++q) __builtin_amdgcn_global_load_lds((const unsigned*)(vb_ + (size_t)q * (size_t)(128 * vtstride) + vsrc0), (LAS unsigned*)(lds + VOFF0 + (buf_) * VBYTES + (8 * q + wid) * 1024), 16, 0, 0); } while (0)
#define ATTN_SYNC() do { asm volatile("s_waitcnt vmcnt(0)" ::: "memory"); __builtin_amdgcn_s_barrier(); asm volatile("" ::: "memory"); } while (0)
#define ATTN_SYNCN(n_) do { asm volatile("s_waitcnt vmcnt(%0)" :: "n"(n_) : "memory"); __builtin_amdgcn_s_barrier(); asm volatile("" ::: "memory"); } while (0)
    constexpr int NDMA = C::NKC + NDB / 2;
    const int krow = 32 * grp + r, kswz = attn_kswz<DQK>(krow);
    int klow[4];
    if (DQK == 192) {
#pragma unroll
        for (int c = 0; c < 4; ++c) klow[c] = ((2 * c + h) ^ kswz) * 16;
    }
#define ATTN_KOFF(ks_) (DQK == 192 ? klow[(ks_) & 3] + ((ks_) >> 2) * 128 : (((2 * (ks_) + h) ^ kswz) * 16))
#define ATTN_QK(dst, buf_) do { const LAS unsigned char* kp_ = lds + KOFF0 + (buf_) * C::KBYTES + krow * C::KROW; constexpr int NKS = DQK / 16, KBATCH = 4; \
        _Pragma("unroll") for (int i = 0; i < 16; ++i) dst[i] = 0.f; \
        _Pragma("unroll") for (int kb = 0; kb < NKS; kb += KBATCH) { bf16x8 kf[KBATCH]; \
            _Pragma("unroll") for (int ks = 0; ks < KBATCH; ++ks) if (kb + ks < NKS) kf[ks] = *(const LAS bf16x8*)(kp_ + ATTN_KOFF(kb + ks)); \
            __builtin_amdgcn_sched_barrier(0); \
            _Pragma("unroll") for (int ks = 0; ks < KBATCH; ++ks) if (kb + ks < NKS) dst = MFMA32(kf[ks], qf[kb + ks], dst); \
            __builtin_amdgcn_sched_barrier(0); } } while (0)
#define ATTN_DMAV1(vbp_, buf_, q_) __builtin_amdgcn_global_load_lds((const unsigned*)((vbp_) + (size_t)(q_) * (size_t)(128 * vtstride) + vsrc0), (LAS unsigned*)(lds + VOFF0 + (buf_) * VBYTES + (8 * (q_) + wid) * 1024), 16, 0, 0)
    static_assert(!PIPE || (DQK / 64 == C::NKC && NDB == 4), "one K piece per QK batch, two V pieces");
    f32x16 s, sn;
    constexpr int MTOFF = 106496;
    unsigned mw[8];
    if (MODE == 2) {
#pragma unroll
        for (int i = 0; i < 8; ++i) mw[i] = maskrow0[tid + 512 * i];
    }
    __syncthreads();
    if (MODE == 2) {
#pragma unroll
        for (int i = 0; i < 8; ++i) { const int idx = tid + 512 * i, row = idx >> 7, w = idx & 127; *(LAS unsigned*)(lds + MTOFF + (row * 129 + w) * 4) = mw[i]; }
        LDS_WAIT();
    }
    if (PIPE) { ATTN_DMAK(0, 0); ATTN_DMAK(1, 1); ATTN_DMAV(0, 0); ATTN_DMAK(2, 2); ATTN_DMAV(1, 1); ATTN_SYNCN(2 * NDMA); ATTN_QK(s, 0); }
    else { ATTN_DMAK(0, 0); ATTN_DMAV(0, 0); }
    if (__builtin_amdgcn_readfirstlane(wid) >= 4) __builtin_amdgcn_s_setprio(1);
    auto tile_step = [&](f32x16& s, f32x16& sn, const int kt, auto c0c) __attribute__((always_inline)) {
        const int c0 = (int)c0c;
        const int c1 = c0 == 2 ? 0 : c0 + 1, c2 = c1 == 2 ? 0 : c1 + 1, vb = PIPE ? c0 : (kt & 1);
        const int kck = kt + 3 < nkt ? kt + 3 : nkt - 1, kcv = kt + 2 < nkt ? kt + 2 : nkt - 1;
        const char* kbp = (const char*)Kb + (size_t)kck * (size_t)(128 * kstride); const char* vbp = (const char*)VTb + (size_t)kcv * 128;
        if (PIPE) ATTN_SYNCN(NDMA);
        else { ATTN_SYNC(); ATTN_DMAK(kt + 1, (kt + 1) & 1); ATTN_DMAV(kt + 1, (kt + 1) & 1); ATTN_QK(s, kt & 1); }
        constexpr bool VEARLY = (DQK != 256);
        bf16x8 vf[NDB][2];
#define ATTN_VFRAG(db_, s2_) (*(const LAS bf16x8*)(lds + VOFF0 + vb * VBYTES + (32 * (db_) + r) * 128 + (((4 * grp + 2 * (s2_) + h) ^ (((32 * (db_) + r) >> 1) & 7)) * 16)))
        constexpr bool VLATE = (DQK == 192);
        if (VEARLY) {
            if (!VLATE) {
#pragma unroll
                for (int db = 0; db < NDB; ++db)
#pragma unroll
                    for (int s2 = 0; s2 < 2; ++s2) vf[db][s2] = ATTN_VFRAG(db, s2);
                __builtin_amdgcn_sched_barrier(0);
            }
            if (PIPE) { ATTN_DMAV1(vbp, c2, 0); __builtin_amdgcn_sched_barrier(0); }
        }
        constexpr int NKS = DQK / 16, KW = (DQK == 192) ? 2 : 4, SL0 = (NKS - 8) / 2;
        const LAS unsigned char* kpn = lds + KOFF0 + c1 * C::KBYTES + krow * C::KROW;
#define ATTN_KFRAG(ks_) (*(const LAS bf16x8*)(kpn + ATTN_KOFF(ks_)))
        bf16x8 kf[PIPE ? NKS : 1];
        if (PIPE) {
#pragma unroll
            for (int ks = 0; ks < KW; ++ks) kf[ks] = ATTN_KFRAG(ks);
            __builtin_amdgcn_sched_barrier(0);
        }
        const int key0 = 64 * kt + 32 * grp;
        const bool need_mask = (MODE == 2) || (MODE == 1 && key0 + 31 > qpos0);
        unsigned vmask = 0xffffffffu;
        if (need_mask) {
            if (MODE == 1) { const int lim = qpos0 + r - key0; vmask = lim >= 31 ? 0xffffffffu : (lim < 0 ? 0u : ((2u << lim) - 1u)); }
            else vmask = *(const LAS unsigned*)(lds + MTOFF + (r * 129 + 2 * kt + grp) * 4);
            vmask >>= 8 * h;
        }
        float mx = s[0];
#pragma unroll
        for (int i = 1; i < 16; ++i) mx = fmaxf(mx, s[i]);
        mx = xhalf_max(mx);
        if (__any(mx > mrun + 8.0f)) { const float mn = fmaxf(mrun, mx), alpha = ex2(mrun - mn); mrun = mn; lrun *= alpha;
#pragma unroll
            for (int db = 0; db < NDB; ++db)
#pragma unroll
                for (int i = 0; i < 16; ++i) o[db][i] *= alpha; }
        bf16x8 pf[2];
        if (PIPE) {
            float ps0 = 0.f, ps1 = 0.f; unsigned pw[8];
            f32x16 zero16;
#pragma unroll
            for (int i = 0; i < 16; ++i) zero16[i] = 0.f;
#define ATTN_SLOT(KS_, M_) if ((KS_) < NKS) { constexpr int ks = (KS_) < NKS ? (KS_) : 0; \
                if (ks + KW < NKS) kf[(ks + KW) % NKS] = ATTN_KFRAG((ks + KW) % NKS); \
                if (ks == 0) sn = MFMA32(kf[0], qf[0], zero16); else sn = MFMA32(kf[ks], qf[ks], sn); \
                constexpr int j_ = ks - SL0; \
                if (j_ >= 0 && j_ < 8) { constexpr int e0_ = 2 * (j_ & 7), e1_ = e0_ + 1; float p0_ = ex2(s[e0_] - mr_), p1_ = ex2(s[e1_] - mr_); \
                    if (M_) { unsigned m0_, m1_; asm("v_bfe_i32 %0, %1, %2, 1" : "=v"(m0_) : "v"(vmask), "n"((e0_ & 7) + 16 * (e0_ >> 3))); asm("v_bfe_i32 %0, %1, %2, 1" : "=v"(m1_) : "v"(vmask), "n"((e1_ & 7) + 16 * (e1_ >> 3))); \
                              asm("v_and_b32 %0, %0, %1" : "+v"(p0_) : "v"(m0_)); asm("v_and_b32 %0, %0, %1" : "+v"(p1_) : "v"(m1_)); } \
                    asm("v_add_f32 %0, %0, %1" : "+v"(ps0) : "v"(p0_)); asm("v_add_f32 %0, %0, %1" : "+v"(ps1) : "v"(p1_)); pw[j_ & 7] = pk2(p0_, p1_); } \
                if ((ks & 3) == 3) __builtin_amdgcn_global_load_lds((const unsigned*)(kbp + ksrc[ks >> 2]), (LAS unsigned*)(lds + KOFF0 + c0 * C::KBYTES + (8 * (ks >> 2) + wid) * 1024), 16, 0, 0); \
                __builtin_amdgcn_sched_barrier(0); }
#define ATTN_BLOCKB(M_) do { float mr_ = mrun; asm volatile("" : "+v"(mr_));     \
            ATTN_SLOT(0, M_) ATTN_SLOT(1, M_) ATTN_SLOT(2, M_) ATTN_SLOT(3, M_) ATTN_SLOT(4, M_) ATTN_SLOT(5, M_) ATTN_SLOT(6, M_) ATTN_SLOT(7, M_) ATTN_SLOT(8, M_) ATTN_SLOT(9, M_) ATTN_SLOT(10, M_) ATTN_SLOT(11, M_) } while (0)
            if (need_mask) ATTN_BLOCKB(true); else ATTN_BLOCKB(false);
#undef ATTN_BLOCKB
#undef ATTN_SLOT
            if (VLATE) { vf[0][0] = ATTN_VFRAG(0, 0); vf[0][1] = ATTN_VFRAG(0, 1); vf[1][0] = ATTN_VFRAG(1, 0); vf[1][1] = ATTN_VFRAG(1, 1); vf[2][0] = ATTN_VFRAG(2, 0); vf[2][1] = ATTN_VFRAG(2, 1); vf[3][0] = ATTN_VFRAG(3, 0); vf[3][1] = ATTN_VFRAG(3, 1); __builtin_amdgcn_sched_barrier(0); }
            lrun += ps0 + ps1;
            ATTN_DMAV1(vbp, c2, 1); __builtin_amdgcn_sched_barrier(0);
            pf[0] = __builtin_bit_cast(bf16x8, ((u32x4){pw[0], pw[1], pw[2], pw[3]})); pf[1] = __builtin_bit_cast(bf16x8, ((u32x4){pw[4], pw[5], pw[6], pw[7]}));
        } else {
            float ps = 0.f; float pv[16];
            if (need_mask) {
#pragma unroll
                for (int i = 0; i < 16; ++i) { const int kl = (i & 7) + 16 * (i >> 3); const unsigned mi = (unsigned)__builtin_amdgcn_sbfe((int)vmask, kl, 1);
                    const float p = __builtin_bit_cast(float, __builtin_bit_cast(unsigned, ex2(s[i] - mrun)) & mi); pv[i] = p; ps += p; }
            } else {
#pragma unroll
                for (int i = 0; i < 16; ++i) { const float p = ex2(s[i] - mrun); pv[i] = p; ps += p; }
            }
            lrun += ps;
#pragma unroll
            for (int s2 = 0; s2 < 2; ++s2) { u32x4 w; w.x = pk2(pv[8 * s2], pv[8 * s2 + 1]); w.y = pk2(pv[8 * s2 + 2], pv[8 * s2 + 3]); w.z = pk2(pv[8 * s2 + 4], pv[8 * s2 + 5]); w.w = pk2(pv[8 * s2 + 6], pv[8 * s2 + 7]); pf[s2] = __builtin_bit_cast(bf16x8, w); }
        }
#pragma unroll
        for (int db = 0; db < NDB; ++db) {
            if (!VEARLY) { vf[0][0] = ATTN_VFRAG(db, 0); vf[0][1] = ATTN_VFRAG(db, 1); o[db] = MFMA32(vf[0][0], pf[0], o[db]); o[db] = MFMA32(vf[0][1], pf[1], o[db]); }
            else {
#pragma unroll
                for (int s2 = 0; s2 < 2; ++s2) o[db] = MFMA32(vf[db][s2], pf[s2], o[db]); } }
#undef ATTN_VFRAG
#undef ATTN_KFRAG
    };
    if (DQK != 128) { int c0 = 0;
        for (int kt = 0; kt < nkt; kt += 2) { tile_step(s, sn, kt, c0); c0 = c0 == 2 ? 0 : c0 + 1; if (kt + 1 < nkt) { tile_step(sn, s, kt + 1, c0); c0 = c0 == 2 ? 0 : c0 + 1; } }
    } else
    for (int kt = 0; kt < nkt; kt += 6) {
        tile_step(s, sn, kt, IC<0>{}); if (kt + 1 >= nkt) break;
        tile_step(sn, s, kt + 1, IC<1>{}); if (kt + 2 >= nkt) break;
        tile_step(s, sn, kt + 2, IC<2>{}); if (kt + 3 >= nkt) break;
        tile_step(sn, s, kt + 3, IC<0>{}); if (kt + 4 >= nkt) break;
        tile_step(s, sn, kt + 4, IC<1>{}); if (kt + 5 >= nkt) break;
        tile_step(sn, s, kt + 5, IC<2>{});
    }
    __builtin_amdgcn_s_setprio(0);
    asm volatile("s_waitcnt vmcnt(0)" ::: "memory");
#undef ATTN_DMAK
#undef ATTN_DMAV
#undef ATTN_SYNC
#undef ATTN_SYNCN
#undef ATTN_QK
#undef ATTN_KOFF
#undef ATTN_DMAV1
    const float lt = xhalf_sum(lrun);
    int ln = lane; asm volatile("" : "+v"(ln)); const int re = ln & 31, he = ln >> 5;
    constexpr int CPRW = NDB * 4, RPI = 64 / CPRW;
    constexpr bool GPRE = (NDB == 4);
    u32x4 gpre[GPRE ? 32 / RPI : 1];
    if (GPRE && grp == 0) {
#pragma unroll
        for (int it = 0; it < 32 / RPI; ++it) { const int row = it * RPI + ln / CPRW, ch = ln % CPRW; gpre[it] = *(const u32x4*)((const char*)Gw + (unsigned)(row * ostride) * 2u + (unsigned)ch * 16u); }
    }
    __syncthreads();
    LAS float* mb = (LAS float*)lds + (wid & 3) * ((NDB * 16 + 2) * 64);
    if (grp == 1) {
#pragma unroll
        for (int db = 0; db < NDB; ++db)
#pragma unroll
            for (int i = 0; i < 16; ++i) mb[(db * 16 + i) * 64 + lane] = o[db][i];
        mb[(NDB * 16) * 64 + lane] = mrun; mb[(NDB * 16 + 1) * 64 + lane] = lt;
    }
    __syncthreads();
    if (grp == 0) {
        const float m2 = mb[(NDB * 16) * 64 + lane], l2 = mb[(NDB * 16 + 1) * 64 + lane];
        const float mm = fmaxf(mrun, m2), a1 = ex2(mrun - mm), a2 = ex2(m2 - mm);
        const float inv = frcp(lt * a1 + l2 * a2);
        const float c1 = a1 * inv, c2 = a2 * inv;
        LAS unsigned char* stg = lds + 4 * ((NDB * 16 + 2) * 256) + (wid & 3) * (32 * 272);
#pragma unroll
        for (int db = 0; db < NDB; ++db)
#pragma unroll
            for (int g4 = 0; g4 < 4; ++g4) {
                const float y0 = o[db][4 * g4 + 0] * c1 + mb[(db * 16 + 4 * g4 + 0) * 64 + lane] * c2, y1 = o[db][4 * g4 + 1] * c1 + mb[(db * 16 + 4 * g4 + 1) * 64 + lane] * c2;
                const float y2 = o[db][4 * g4 + 2] * c1 + mb[(db * 16 + 4 * g4 + 2) * 64 + lane] * c2, y3 = o[db][4 * g4 + 3] * c1 + mb[(db * 16 + 4 * g4 + 3) * 64 + lane] * c2;
                *(LAS u32x2*)(stg + re * 272 + (32 * db + 8 * g4 + 4 * he) * 2) = (u32x2){pk2(y0, y1), pk2(y2, y3)}; }
        LDS_WAIT(); asm volatile("" ::: "memory");
#pragma unroll
        for (int it = 0; it < 32 / RPI; ++it) { const int row = it * RPI + ln / CPRW, ch = ln % CPRW; const unsigned off = (unsigned)(row * ostride) * 2u + (unsigned)ch * 16u;
            const u32x4 yv = *(const LAS u32x4*)(stg + row * 272 + ch * 16); u32x4 gv; if (GPRE) gv = gpre[it]; else gv = *(const u32x4*)((const char*)Gw + off);
            *(u32x4*)((char*)Ow + off) = (u32x4){pk2(bflo(yv.x) * bflo(gv.x), bfhi(yv.x) * bfhi(gv.x)), pk2(bflo(yv.y) * bflo(gv.y), bfhi(yv.y) * bfhi(gv.y)),
                                                 pk2(bflo(yv.z) * bflo(gv.z), bfhi(yv.z) * bfhi(gv.z)), pk2(bflo(yv.w) * bflo(gv.w), bfhi(yv.w) * bfhi(gv.w))}; }
    }
}

DI void mla_phase(const Frame& F) {
    const bf16* qm = wsp<bf16>(F, WS_QM); const bf16* km = wsp<bf16>(F, WS_KM); const bf16* vtm = wsp<bf16>(F, WS_VTM); const bf16* G = wsp<bf16>(F, WS_G); bf16* mix = wsp<bf16>(F, WS_MIX);
    const int wq = F.wave & 3;
    for (int j0 = F.bid; j0 < 256; j0 += F.G) {
        const int j = (F.G == 256) ? ((j0 & 7) * 32 + (j0 >> 3)) : j0;
        const int bh = j >> 4, b = bh >> 3, head = bh & 7, p = j & 15;
        for (int k = 0; k < 2; ++k) { const int qb = k ? p : 31 - p, q0 = 128 * qb, row0 = b * S + q0 + 32 * wq;
            attn_unit<192, 1, 4>(F.lds, F.tid, F.wave, F.lane, qm + ((size_t)row0 * 8 + head) * 192, 1536, km + ((size_t)(b * S) * 8 + head) * 192, 1536,
                              vtm + (size_t)(b * 8 + head) * 128 * S, S, 2 * qb + 2, q0 + 32 * wq, nullptr, mix + (size_t)row0 * 4096 + head * 128, G + (size_t)row0 * 4096 + head * 128, 4096); }
    }
}
DI void dsa_phase(const Frame& F) {
    const bf16* bq = wsp<bf16>(F, WS_BQ); const bf16* bk = wsp<bf16>(F, WS_BK); const bf16* vtd = wsp<bf16>(F, WS_VTD); const bf16* G = wsp<bf16>(F, WS_G); bf16* mix = wsp<bf16>(F, WS_MIX);
    const unsigned* mask = wsp<unsigned>(F, WS_MASK);
    const int wq = F.wave & 3;
    for (int j0 = F.bid; j0 < 256; j0 += F.G) {
        const int j = (F.G == 256) ? ((j0 & 7) * 32 + (j0 >> 3)) : j0;
        const int bn = j >> 6, b = bn >> 1, n = bn & 1, p = j & 63, hh = 4 * n + wq;
        for (int k = 0; k < 2; ++k) { const int qb = k ? p : 127 - p, q0 = 32 * qb, row0 = b * S + q0;
            attn_unit<128, 2, 4>(F.lds, F.tid, F.wave, F.lane, bq + (size_t)row0 * 1024 + hh * 128, 1024, bk + (size_t)(b * S) * 256 + n * 128, 256,
                              vtd + (size_t)(b * 2 + n) * 128 * S, S, qb / 2 + 1, q0, mask + (size_t)row0 * 128, mix + (size_t)row0 * 4096 + 1024 + hh * 128, G + (size_t)row0 * 4096 + 1024 + hh * 128, 4096); }
    }
}
DI void mem_unit(LAS unsigned char* lds, int tid, int wid, int lane, const bf16* Qw, const bf16* Kb, const bf16* VTb, bf16* Ow, const bf16* Gw) {
    constexpr int DQK = 256, CPR = 32, KROW = 512, KBYTES = 64 * KROW, VBYTES = 256 * 128, VOFF0 = 2 * KBYTES, qstride = 1024, kstride = 1024, vtstride = 256, ostride = 4096, nkt = 4;
    const int r = lane & 31, h = lane >> 5, grp = wid >> 2;
    bf16x8 qf[16];
    { const unsigned qoff = (unsigned)(r * qstride + 8 * h) * 2u;
#pragma unroll
      for (int ks = 0; ks < 16; ++ks) qf[ks] = *(const bf16x8*)((const char*)Qw + qoff + 32 * ks); }
    f32x16 o[4];
#pragma unroll
    for (int db = 0; db < 4; ++db)
#pragma unroll
        for (int i = 0; i < 16; ++i) o[db][i] = 0.f;
    float mrun = -1e30f, lrun = 0.f;
    unsigned ksrc[4], vsrc[4];
#pragma unroll
    for (int q = 0; q < 4; ++q) { const int L = (8 * q + wid) * 64 + lane, rho = L / CPR, cp = L % CPR, r5 = rho & 31;
        const int key = (rho & 32) + (r5 & 19) + ((r5 & 4) << 1) + ((r5 & 8) >> 1);
        ksrc[q] = (unsigned)(key * kstride) * 2u + (unsigned)((cp ^ (rho & 15)) * 16);
        const int d = L >> 3, cv = L & 7; vsrc[q] = (unsigned)(d * vtstride) * 2u + (unsigned)((cv ^ ((d >> 1) & 7)) * 16); }
#define MEM_DMA(kt_, buf_) do { const int kc_ = (kt_) < nkt ? (kt_) : nkt - 1; const char* kb_ = (const char*)Kb + (size_t)kc_ * (size_t)(128 * kstride); const char* vb_ = (const char*)VTb + (size_t)kc_ * 128; \
        _Pragma("unroll") for (int q = 0; q < 4; ++q) { __builtin_amdgcn_global_load_lds((const unsigned*)(kb_ + ksrc[q]), (LAS unsigned*)(lds + (buf_) * KBYTES + (8 * q + wid) * 1024), 16, 0, 0); \
            __builtin_amdgcn_global_load_lds((const unsigned*)(vb_ + vsrc[q]), (LAS unsigned*)(lds + VOFF0 + (buf_) * VBYTES + (8 * q + wid) * 1024), 16, 0, 0); } } while (0)
    __syncthreads();
    MEM_DMA(0, 0);
    for (int kt = 0; kt < nkt; ++kt) {
        asm volatile("s_waitcnt vmcnt(0)" ::: "memory"); __builtin_amdgcn_s_barrier(); asm volatile("" ::: "memory");
        MEM_DMA(kt + 1, (kt + 1) & 1);
#pragma unroll 1
        for (int sub = 0; sub < 2; ++sub) {
            const int krow = 32 * sub + r, kswz = krow & 15;
            const LAS unsigned char* kp = lds + (kt & 1) * KBYTES + krow * KROW;
            f32x16 s;
#pragma unroll
            for (int i = 0; i < 16; ++i) s[i] = 0.f;
#pragma unroll
            for (int kb = 0; kb < 16; kb += 4) { bf16x8 kf[4];
#pragma unroll
                for (int ks = 0; ks < 4; ++ks) kf[ks] = *(const LAS bf16x8*)(kp + (((2 * (kb + ks) + h) ^ kswz) * 16));
                __builtin_amdgcn_sched_barrier(0);
#pragma unroll
                for (int ks = 0; ks < 4; ++ks) s = MFMA32(kf[ks], qf[kb + ks], s);
                __builtin_amdgcn_sched_barrier(0); }
            float mx = s[0];
#pragma unroll
            for (int i = 1; i < 16; ++i) mx = fmaxf(mx, s[i]);
            mx = xhalf_max(mx);
            if (__any(mx > mrun + 8.0f)) { const float mn = fmaxf(mrun, mx), alpha = ex2(mrun - mn); mrun = mn; lrun *= alpha;
#pragma unroll
                for (int db = 0; db < 4; ++db)
#pragma unroll
                    for (int i = 0; i < 16; ++i) o[db][i] *= alpha; }
            float ps = 0.f; float pv[16];
#pragma unroll
            for (int i = 0; i < 16; ++i) { const float p = ex2(s[i] - mrun); pv[i] = p; ps += p; }
            lrun += ps;
            bf16x8 pf[2];
#pragma unroll
            for (int s2 = 0; s2 < 2; ++s2) { u32x4 w; w.x = pk2(pv[8 * s2], pv[8 * s2 + 1]); w.y = pk2(pv[8 * s2 + 2], pv[8 * s2 + 3]); w.z = pk2(pv[8 * s2 + 4], pv[8 * s2 + 5]); w.w = pk2(pv[8 * s2 + 6], pv[8 * s2 + 7]); pf[s2] = __builtin_bit_cast(bf16x8, w); }
#pragma unroll
            for (int db = 0; db < 4; ++db) { const int d = 128 * grp + 32 * db + r; const LAS unsigned char* vp = lds + VOFF0 + (kt & 1) * VBYTES + d * 128; const int vsw = (d >> 1) & 7;
                const bf16x8 v0 = *(const LAS bf16x8*)(vp + (((4 * sub + h) ^ vsw) * 16)), v1 = *(const LAS bf16x8*)(vp + (((4 * sub + 2 + h) ^ vsw) * 16));
                o[db] = MFMA32(v0, pf[0], o[db]); o[db] = MFMA32(v1, pf[1], o[db]); }
        }
    }
#undef MEM_DMA
    asm volatile("s_waitcnt vmcnt(0)" ::: "memory");
    __syncthreads();
    {
        int ln = lane; asm volatile("" : "+v"(ln)); const int re = ln & 31, he = ln >> 5;
        const float inv = frcp(xhalf_sum(lrun));
        LAS unsigned char* stg = lds + wid * (32 * 272);
#pragma unroll
        for (int db = 0; db < 4; ++db)
#pragma unroll
            for (int g4 = 0; g4 < 4; ++g4)
                *(LAS u32x2*)(stg + re * 272 + (32 * db + 8 * g4 + 4 * he) * 2) = (u32x2){pk2(o[db][4 * g4] * inv, o[db][4 * g4 + 1] * inv), pk2(o[db][4 * g4 + 2] * inv, o[db][4 * g4 + 3] * inv)};
        LDS_WAIT(); asm volatile("" ::: "memory");
#pragma unroll
        for (int it = 0; it < 8; ++it) { const int row = it * 4 + (ln >> 4), ch = ln & 15; const unsigned off = (unsigned)(row * ostride) * 2u + (unsigned)(128 * grp) * 2u + (unsigned)ch * 16u;
            const u32x4 yv = *(const LAS u32x4*)(stg + row * 272 + ch * 16); const u32x4 gv = *(const u32x4*)((const char*)Gw + off);
            *(u32x4*)((char*)Ow + off) = (u32x4){pk2(bflo(yv.x) * bflo(gv.x), bfhi(yv.x) * bfhi(gv.x)), pk2(bflo(yv.y) * bflo(gv.y), bfhi(yv.y) * bfhi(gv.y)),
                                                 pk2(bflo(yv.z) * bflo(gv.z), bfhi(yv.z) * bfhi(gv.z)), pk2(bflo(yv.w) * bflo(gv.w), bfhi(yv.w) * bfhi(gv.w))}; }
    }
}
DI void mem_phase(const Frame& F) {
    const bf16* dq = wsp<bf16>(F, WS_DQ); const bf16* kmem = wsp<bf16>(F, WS_KMEM); const bf16* vtmem = wsp<bf16>(F, WS_VTMEM); const bf16* G = wsp<bf16>(F, WS_G); bf16* mix = wsp<bf16>(F, WS_MIX);
    const int wq = F.wave & 3;
    for (int j = F.bid; j < 256; j += F.G) {
        const int bh = j >> 5, b = bh >> 2, head = bh & 3, qb = j & 31, row0 = b * S + 128 * qb + 32 * wq;
        mem_unit(F.lds, F.tid, F.wave, F.lane, dq + (size_t)row0 * 1024 + head * 256, kmem + (size_t)(b * 256) * 1024 + head * 256, vtmem + (size_t)(b * 4 + head) * 256 * 256,
                 mix + (size_t)row0 * 4096 + 3072 + head * 256, G + (size_t)row0 * 4096 + 3072 + head * 256);
    }
}

DI void select_row(const Frame& F, int row);
DI void idx_item(const Frame& F, int b, int p) {
    const bf16* qi = wsp<bf16>(F, WS_QI); const bf16* ki = wsp<bf16>(F, WS_KI); const float* wi = wsp<float>(F, WS_WI); float* sc = wsp<float>(F, WS_SC);
    const int lane = F.lane, r = lane & 31, h = lane >> 5, tA = 16 * p + 2 * F.wave, tB = 16 * (255 - p) + 2 * F.wave;
    const int aq = (r >> 2) & 1, ah = (r & 3) + 4 * (r >> 3);
    bf16x8 afA[4], afB[4];
#pragma unroll
    for (int ks = 0; ks < 4; ++ks) { afA[ks] = *(const bf16x8*)(qi + ((size_t)(b * S + tA + aq) * 16 + ah) * 64 + 16 * ks + 8 * h); afB[ks] = *(const bf16x8*)(qi + ((size_t)(b * S + tB + aq) * 16 + ah) * 64 + 16 * ks + 8 * h); }
    float wlA[16], wlB[16];
    { const float* wa = wi + (size_t)(b * S + tA + h) * 16; const float* wb = wi + (size_t)(b * S + tB + h) * 16;
#pragma unroll
      for (int i = 0; i < 4; ++i) { const f32x4 x = *(const f32x4*)(wa + 4 * i), y = *(const f32x4*)(wb + 4 * i);
          wlA[4 * i] = x[0]; wlA[4 * i + 1] = x[1]; wlA[4 * i + 2] = x[2]; wlA[4 * i + 3] = x[3]; wlB[4 * i] = y[0]; wlB[4 * i + 1] = y[1]; wlB[4 * i + 2] = y[2]; wlB[4 * i + 3] = y[3]; } }
    float* orowA = sc + ((size_t)(b * S + tA + h)) * S + r; float* orowB = sc + ((size_t)(b * S + tB + h)) * S + r;
    const int nktA = (16 * p + 15) / 32 + 1, nktB = (16 * (255 - p) + 15) / 32 + 1;
    LAS unsigned char* lds = F.lds; constexpr int CHB = 256 * 144;
    const char* kbase = (const char*)(ki + (size_t)(b * S) * 64);
    const int nch = (nktB + 7) >> 3;
    u32x4 stg[4];
#define IDX_GLOAD(c_) do { int tl_ = F.tid; asm volatile("" : "+v"(tl_)); const char* cb_ = kbase + (size_t)(c_) * 32768; _Pragma("unroll") for (int i_ = 0; i_ < 4; ++i_) stg[i_] = *(const u32x4*)(cb_ + (unsigned)(tl_ + 512 * i_) * 16u); } while (0)
#define IDX_LSTORE(buf_) do { int tl_ = F.tid; asm volatile("" : "+v"(tl_)); _Pragma("unroll") for (int i_ = 0; i_ < 4; ++i_) { const int c_ = tl_ + 512 * i_; *(LAS u32x4*)(lds + (buf_) * CHB + (c_ >> 3) * 144 + (c_ & 7) * 16) = stg[i_]; } } while (0)
#define IDX_MMA(af_, wl_, orow_, kt_) do { f32x16 a; _Pragma("unroll") for (int i = 0; i < 16; ++i) a[i] = 0.f; _Pragma("unroll") for (int ks = 0; ks < 4; ++ks) a = MFMA32(af_[ks], kf[ks], a); \
          float s0_ = 0.f, s1_ = 0.f; _Pragma("unroll") for (int i = 0; i < 16; i += 2) { s0_ += wl_[i] * fmaxf(a[i], 0.f); s1_ += wl_[i + 1] * fmaxf(a[i + 1], 0.f); } orow_[32 * (kt_)] = s0_ + s1_; } while (0)
    __syncthreads();
    IDX_GLOAD(0); IDX_LSTORE(0);
    __syncthreads();
    for (int c = 0; c < nch; ++c) {
        if (c + 1 < nch) IDX_GLOAD(c + 1);
        const LAS unsigned char* kb = lds + (c & 1) * CHB + r * 144 + 16 * h;
        for (int t = 0; t < 8; ++t) { const int kt = 8 * c + t; if (kt >= nktB) break;
            bf16x8 kf[4];
#pragma unroll
            for (int ks = 0; ks < 4; ++ks) kf[ks] = *(const LAS bf16x8*)(kb + t * (32 * 144) + 32 * ks);
            IDX_MMA(afB, wlB, orowB, kt);
            if (kt < nktA) IDX_MMA(afA, wlA, orowA, kt);
        }
        if (c + 1 < nch) IDX_LSTORE((c + 1) & 1);
        __syncthreads();
    }
#undef IDX_GLOAD
#undef IDX_LSTORE
#undef IDX_MMA
    asm volatile("s_waitcnt vmcnt(0)" ::: "memory");
    for (int q = 0; q < 4; ++q) select_row(F, b * S + ((q & 2) ? tB : tA) + (q & 1));
}
DI void idx_phase(const Frame& F) {
    for (int j = F.bid; j < 256; j += F.G) idx_item(F, j >> 7, j & 127);
}
DI float wave_max(float v) {
#pragma unroll
    for (int o = 1; o < 64; o <<= 1) v = fmaxf(v, __shfl_xor(v, o));
    return v;
}
DI void select_row(const Frame& F, int row) {
    const float* sc = wsp<float>(F, WS_SC); unsigned* mask = wsp<unsigned>(F, WS_MASK);
    const int lane = F.lane;
    {
        const int t = row & (S - 1), n = t + 1, ng = (n + 511) >> 9;
        const float* srow = sc + (size_t)row * S;
        float u[64];
        { const float* p0 = srow + lane; asm volatile("" : "+v"(p0));
#pragma unroll
          for (int e = 0; e < 32; ++e) u[e] = p0[64 * e]; }
        if (ng > 4) { const float* p1 = srow + 2048 + lane; asm volatile("" : "+v"(p1));
#pragma unroll
          for (int e = 0; e < 32; ++e) u[32 + e] = p1[64 * e]; }
        float vmax = -__builtin_inff(), vmin = __builtin_inff();
#pragma unroll
        for (int g = 0; g < 8; ++g) {
            if (g < ng) {
#pragma unroll
                for (int k = 0; k < 8; ++k) { const int e = 8 * g + k, key = 64 * e + lane; const bool ok = key <= t; const float rv = u[e]; u[e] = ok ? rv : -__builtin_inff(); vmax = fmaxf(vmax, u[e]); vmin = fminf(vmin, ok ? rv : __builtin_inff()); }
            } else {
#pragma unroll
                for (int k = 0; k < 8; ++k) u[8 * g + k] = -__builtin_inff();
            }
        }
        float thr = -__builtin_inff();
        if (n > 256) {
            float lo = -wave_max(-vmin), hi = wave_max(vmax);
            { const unsigned hb = __builtin_bit_cast(unsigned, hi); hi = __builtin_bit_cast(float, (hi > 0.f) ? hb + 1u : (hi < 0.f ? hb - 1u : 1u)); }
            thr = lo;
            for (int it = 0; it < 64; ++it) {
                const float mid = lo + 0.5f * (hi - lo);
                if (!(mid > lo) || !(mid < hi)) break;
                int cnt = 0;
#pragma unroll
                for (int g = 0; g < 8; ++g) {
                    if (g < ng) {
                        unsigned long long bb[8];
#pragma unroll
                        for (int k = 0; k < 8; ++k) bb[k] = __ballot(u[8 * g + k] >= mid);
                        __builtin_amdgcn_sched_barrier(0);
#pragma unroll
                        for (int k = 0; k < 8; ++k) cnt += __popcll(bb[k]);
                        __builtin_amdgcn_sched_barrier(0);
                    }
                }
                if (cnt >= 256) { lo = mid; thr = mid; } else hi = mid;
                if (cnt == 256) break;
            }
        }
        unsigned mlo = 0u, mhi = 0u;
#pragma unroll
        for (int g = 0; g < 8; ++g) {
            if (g < ng) {
#pragma unroll
                for (int k = 0; k < 8; ++k) { const int e = 8 * g + k; const unsigned long long bal = __ballot(u[e] >= thr && u[e] > -__builtin_inff()); if (lane == e) { mlo = (unsigned)bal; mhi = (unsigned)(bal >> 32); } }
            }
        }
        *(u32x2*)(mask + (size_t)row * 128 + 2 * lane) = (u32x2){mlo, mhi};
    }
}
DI void lru_load_raw(const float* cu, int tid, int b, int ch, int n, f32x4 (&raw)[5]) {
#pragma unroll
    for (int i = 0; i < 5; ++i) { const int c = tid + 512 * i, row = c >> 4, part = c & 15, tr = 128 * ch - 3 + row;
        raw[i] = (f32x4){0.f, 0.f, 0.f, 0.f}; if (c < 131 * 16 && tr >= 0) raw[i] = *(const f32x4*)(cu + (size_t)(b * S + tr) * 1024 + 64 * n + 4 * part); }
}
template <bool FINAL>
DI void lru_unit(const Frame& F, int layer, int b, int ch, int n, f32x4 (&raw)[5], bool has_next, int nb, int nch, bool load_cw) {
    LAS unsigned char* lds = F.lds;
    LAS float* U32 = (LAS float*)lds;
    LAS unsigned char* Ub = lds + 32768;
    LAS float* LA = (LAS float*)(lds + 51200);
    LAS float* IG = (LAS float*)(lds + 83968);
    LAS f32x2* SUM = (LAS f32x2*)(lds + 116736);
    LAS f32x2* PRE = (LAS f32x2*)(lds + 116736 + 4096);
    const float* cu = wsp<float>(F, WS_CU); const int tid = F.tid, lane = F.lane, w = F.wave, t0 = 128 * ch;
    const int gr_ = lane & 31, gh_ = lane >> 5, gt_ = w & 1;
    const bf16* WTg = wsp<bf16>(F, (gt_ ? WS_WX : WS_WA) + (size_t)layer * SZ_WG) + (size_t)n * 4096;
    bf16x8 bfr[2][4]; float bsv[2], splv[2];
#pragma unroll
    for (int et = 0; et < 2; ++et) { const int e = 32 * et + gr_;
#pragma unroll
        for (int ks = 0; ks < 4; ++ks) bfr[et][ks] = *(const bf16x8*)(WTg + (size_t)e * 64 + 16 * ks + 8 * gh_);
        bsv[et] = (gt_ ? inp<float>(F, I_BX) : inp<float>(F, I_BA))[(size_t)layer * 1024 + 64 * n + e];
        splv[et] = inp<float>(F, I_LAM)[(size_t)layer * 1024 + 64 * n + e]; }
    __syncthreads();
    {
        LAS unsigned char* RAW = lds + 51200; LAS float* CW = (LAS float*)(lds + 124928);
#pragma unroll
        for (int i = 0; i < 5; ++i) { const int c = tid + 512 * i; if (c < 131 * 16) *(LAS f32x4*)(RAW + (c >> 4) * 272 + (c & 15) * 16) = raw[i]; }
        if (load_cw && tid < 80) { const int j = tid >> 4, part = tid & 15;
            const float* src = (j < 4) ? inp<float>(F, I_CONVW) + ((size_t)layer * 4 + j) * 1024 + 64 * n + 4 * part : inp<float>(F, I_CONVB) + (size_t)layer * 1024 + 64 * n + 4 * part;
            *(LAS f32x4*)(CW + j * 64 + 4 * part) = *(const f32x4*)src; }
        if (has_next) lru_load_raw(cu, tid, nb, nch, n, raw);
    }
    __syncthreads();
    {
        const LAS unsigned char* RAW = lds + 51200; const LAS float* CW = (const LAS float*)(lds + 124928);
        const int t = tid >> 2, cg = (tid & 3) * 16;
        f32x4 acc4[4];
#pragma unroll
        for (int q = 0; q < 4; ++q) acc4[q] = *(const LAS f32x4*)(CW + 256 + cg + 4 * q);
#pragma unroll
        for (int j = 0; j < 4; ++j)
#pragma unroll
            for (int q = 0; q < 4; ++q) acc4[q] += *(const LAS f32x4*)(RAW + (t + j) * 272 + (cg + 4 * q) * 4) * *(const LAS f32x4*)(CW + j * 64 + cg + 4 * q);
#pragma unroll
        for (int q = 0; q < 4; ++q) *(LAS f32x4*)(U32 + t * 64 + cg + 4 * q) = acc4[q];
        *(LAS u32x4*)(Ub + t * 144 + cg * 2) = pack8(acc4[0], acc4[1]); *(LAS u32x4*)(Ub + t * 144 + cg * 2 + 16) = pack8(acc4[2], acc4[3]);
    }
    __syncthreads();
    {
        const int r = lane & 31, h = lane >> 5, rt = w >> 1, gt = w & 1;
        bf16x8 af[4];
#pragma unroll
        for (int ks = 0; ks < 4; ++ks) af[ks] = *(const LAS bf16x8*)(Ub + (32 * rt + r) * 144 + (16 * ks + 8 * h) * 2);
#pragma unroll
        for (int et = 0; et < 2; ++et) { const int e = 32 * et + r;
            f32x16 a;
#pragma unroll
            for (int i = 0; i < 16; ++i) a[i] = 0.f;
#pragma unroll
            for (int ks = 0; ks < 4; ++ks) a = MFMA32(af[ks], bfr[et][ks], a);
            const float bs = bsv[et];
            float spl = 0.f; if (gt == 0) spl = -8.0f * log1pf(expf(-splv[et]));
#pragma unroll
            for (int i = 0; i < 16; ++i) { const int tok = 32 * rt + (i & 3) + 8 * (i >> 2) + 4 * h; const float sg = frcp(1.0f + __expf(-(a[i] + bs)));
                if (gt == 0) LA[tok * 64 + e] = sg * spl; else IG[tok * 64 + e] = sg; } }
    }
    __syncthreads();
    float hloc[16], acum[16]; float hl = 0.f, ac = 1.f;
#pragma unroll
    for (int tt = 0; tt < 16; ++tt) { const int tok = 16 * w + tt; const float la = LA[tok * 64 + lane]; const float a = ex2(la * LOG2E); const float y2 = 2.0f * la;
        const float em = (y2 > -0.25f) ? -y2 * (1.0f + y2 * (0.5f + y2 * (0.16666667f + y2 * (0.041666668f + y2 * (0.0083333338f + y2 * 0.0013888889f))))) : 1.0f - a * a;
        const float mult = __builtin_sqrtf(em);
        const float xin = mult * IG[tok * 64 + lane] * U32[tok * 64 + lane]; hl = a * hl + xin; ac *= a; hloc[tt] = hl; acum[tt] = ac; }
    SUM[w * 64 + lane] = (f32x2){ac, hl};
    const f32x2* lsum = wsp<f32x2>(F, WS_LSUM); const int c = 64 * n + lane;
    if (FINAL) {
        float A = 1.f, H = 0.f;
#pragma unroll
        for (int q = 0; q < 4; ++q) { const int j = 4 * w + q; if (j < ch) { const f32x2 sj = lsum[((size_t)(b * 32 + j)) * 1024 + c]; H = sj.x * H + sj.y; A *= sj.x; } }
        PRE[w * 64 + lane] = (f32x2){A, H};
    }
    __syncthreads();
    float cin = 0.f;
    if (FINAL) {
#pragma unroll
        for (int q = 0; q < 8; ++q) { const f32x2 pq = PRE[q * 64 + lane]; cin = pq.x * cin + pq.y; }
    }
    float cw = cin, atot = 1.f, aw = 1.f;
#pragma unroll
    for (int q = 0; q < 8; ++q) { const f32x2 sq = SUM[q * 64 + lane]; if (q < w) { cw = sq.x * cw + sq.y; aw *= sq.x; } atot *= sq.x; }
    if (FINAL) {
        const bf16* G = wsp<bf16>(F, WS_G); bf16* mix = wsp<bf16>(F, WS_MIX);
#pragma unroll
        for (int tt = 0; tt < 16; ++tt) { const size_t o = (size_t)(b * S + t0 + 16 * w + tt) * 4096 + 2048 + c; const float hv = hloc[tt] + acum[tt] * cw; mix[o] = f2bf(hv * bf2f(G[o])); }
    } else {
        unsigned* hl32 = wsp<unsigned>(F, WS_HL);
#pragma unroll
        for (int tt = 0; tt < 16; ++tt) hl32[(size_t)(b * S + t0 + 16 * w + tt) * 1024 + c] = pk2(hloc[tt] + acum[tt] * cw, acum[tt] * aw);
        if (w == 7) { const f32x2 s7 = SUM[7 * 64 + lane]; wsp<f32x2>(F, WS_LSUM)[((size_t)(b * 32 + ch)) * 1024 + c] = (f32x2){atot, s7.x * cw + s7.y}; }
    }
}
DI void lru_final_phase(const Frame& F) {
    const f32x2* lsum = wsp<f32x2>(F, WS_LSUM); const unsigned* hl32 = wsp<unsigned>(F, WS_HL); const bf16* G = wsp<bf16>(F, WS_G); bf16* mix = wsp<bf16>(F, WS_MIX);
    LAS float* car = (LAS float*)F.lds;
    for (int u = F.bid; u < 256; u += F.G) {
        const int b = u >> 7, ch = (u >> 2) & 31, cq = u & 3;
        __syncthreads();
        if (F.tid < 256) { const int c = 256 * cq + F.tid; float H = 0.f;
            for (int j = 0; j < ch; ++j) { const f32x2 sj = lsum[((size_t)(b * 32 + j)) * 1024 + c]; H = sj.x * H + sj.y; }
            car[F.tid] = H; }
        __syncthreads();
        const int cg = F.tid & 31, tl = F.tid >> 5, c0 = 256 * cq + 8 * cg;
        float cr[8];
#pragma unroll
        for (int k = 0; k < 8; ++k) cr[k] = car[8 * cg + k];
#pragma unroll
        for (int i = 0; i < 8; ++i) { const size_t row = (size_t)(b * S + 128 * ch + tl + 16 * i);
            const u32x4 p0 = *(const u32x4*)(hl32 + row * 1024 + c0), p1 = *(const u32x4*)(hl32 + row * 1024 + c0 + 4); const u32x4 g = *(const u32x4*)(G + row * 4096 + 2048 + c0);
            float y[8];
            y[0] = (bflo(p0.x) + bfhi(p0.x) * cr[0]) * bflo(g.x); y[1] = (bflo(p0.y) + bfhi(p0.y) * cr[1]) * bfhi(g.x); y[2] = (bflo(p0.z) + bfhi(p0.z) * cr[2]) * bflo(g.y); y[3] = (bflo(p0.w) + bfhi(p0.w) * cr[3]) * bfhi(g.y);
            y[4] = (bflo(p1.x) + bfhi(p1.x) * cr[4]) * bflo(g.z); y[5] = (bflo(p1.y) + bfhi(p1.y) * cr[5]) * bfhi(g.z); y[6] = (bflo(p1.z) + bfhi(p1.z) * cr[6]) * bflo(g.w); y[7] = (bflo(p1.w) + bfhi(p1.w) * cr[7]) * bfhi(g.w);
            *(u32x4*)(mix + row * 4096 + 2048 + c0) = (u32x4){pk2(y[0], y[1]), pk2(y[2], y[3]), pk2(y[4], y[5]), pk2(y[6], y[7])}; }
    }
}
template <bool FINAL> DI void lru_phase(const Frame& F, int layer) {
    int u0, ustep, uend;
    if (F.G == 256) { if (F.bid < 192) { u0 = F.bid; ustep = 192; uend = 576; } else { u0 = 576 + (F.bid - 192); ustep = 64; uend = 1024; } }
    else { u0 = F.bid; ustep = F.G; uend = 1024; }
    f32x4 raw[5]; int nprev = -1;
    if (u0 < uend) lru_load_raw(wsp<float>(F, WS_CU), F.tid, u0 >> 9, (u0 >> 4) & 31, u0 & 15, raw);
    for (int u = u0; u < uend; u += ustep) { const int un = u + ustep, n = u & 15;
        lru_unit<FINAL>(F, layer, u >> 9, (u >> 4) & 31, n, raw, un < uend && (un & 15) == n, un >> 9, (un >> 4) & 31, n != nprev);
        if (un < uend && (un & 15) != n) lru_load_raw(wsp<float>(F, WS_CU), F.tid, un >> 9, (un >> 4) & 31, un & 15, raw);
        nprev = n; }
}

DI float wave_sum(float v) {
#pragma unroll
    for (int o = 1; o < 64; o <<= 1) v += __shfl_xor(v, o);
    return v;
}
DI void ln_phase(const Frame& F, int layer, bool last) {
    const float* z = wsp<float>(F, WS_Z); bf16* xb = wsp<bf16>(F, WS_XB); f32x2* st = wsp<f32x2>(F, WS_XN);
    const float* g = inp<float>(F, I_LNG) + (size_t)layer * D; const float* bb = inp<float>(F, I_LNB) + (size_t)layer * D;
    const int lane = F.lane;
    for (int row = F.bid * NWAVES + F.wave; row < M; row += F.G * NWAVES) {
        const f32x4* zr = (const f32x4*)(z + (size_t)row * D) + lane;
        f32x4 v[16]; float s = 0.f;
#pragma unroll
        for (int j = 0; j < 16; ++j) { v[j] = zr[64 * j]; s += (v[j][0] + v[j][1]) + (v[j][2] + v[j][3]); }
        const float mean = wave_sum(s) * (1.0f / D); float s2 = 0.f;
#pragma unroll
        for (int j = 0; j < 16; ++j) { v[j] = v[j] - mean; s2 += (v[j][0] * v[j][0] + v[j][1] * v[j][1]) + (v[j][2] * v[j][2] + v[j][3] * v[j][3]); }
        const float rstd = 1.0f / sqrtf(wave_sum(s2) * (1.0f / D) + LN_EPS);
        if (!last && lane == 0) st[row] = (f32x2){mean, rstd};
#pragma unroll
        for (int j = 0; j < 16; ++j) { const int col = 4 * (lane + 64 * j); const f32x4 gg = *(const f32x4*)(g + col), b4 = *(const f32x4*)(bb + col);
            const f32x4 y = v[j] * rstd * gg + b4;
            if (last) *(f32x4*)(F.out + (size_t)row * D + col) = y;
            else *(u32x2*)(xb + (size_t)row * D + col) = (u32x2){pk2(y[0], y[1]), pk2(y[2], y[3])}; }
    }
}

constexpr int NPH = 1 + 5 * DEPTH;
struct Args { const void* in[20]; float* out; unsigned char* ws; int ph_lo, ph_hi; };
static_assert(sizeof(Args) == 20 * 8 + 8 + 8 + 8, "Args has no padding bytes");

DI Frame make_frame(LAS unsigned char* lds, float* out, unsigned char* ws) {
    Frame F; F.lds = lds;
    int t = threadIdx.x; asm volatile("" : "+v"(t)); F.tid = t; F.lane = t & 63; F.wave = __builtin_amdgcn_readfirstlane(t >> 6);
    int b = blockIdx.x, g = gridDim.x; asm volatile("" : "+s"(b), "+s"(g)); F.bid = b; F.G = g;
    F.out = out; F.ws = ws;
    return F;
}
__global__ void __launch_bounds__(NTHR, 2) hybrid_fwd(Args args) {
    extern __shared__ __attribute__((aligned(16))) unsigned char lds_raw[];
    LAS unsigned char* lds = (LAS unsigned char*)lds_raw;
    volatile LAS unsigned* MISC = (volatile LAS unsigned*)(lds + MISC_OFF);
    for (int u = threadIdx.x; u < (LDS_BYTES - LDSCTL_OFF) / 4; u += NTHR) ((LAS unsigned*)(lds + LDSCTL_OFF))[u] = 0u;
    __syncthreads();
    if (threadIdx.x == 0) { LAS unsigned long long* tb = (LAS unsigned long long*)(lds + PTR_OFF);
#define PUT(k) tb[k] = (unsigned long long)args.in[k];
        PUT(0) PUT(1) PUT(2) PUT(3) PUT(4) PUT(5) PUT(6) PUT(7) PUT(8) PUT(9) PUT(10) PUT(11) PUT(12) PUT(13) PUT(14) PUT(15) PUT(16) PUT(17) PUT(18) PUT(19)
#undef PUT
    }
    __syncthreads();
    XcdBarrier bar; bar.bar = (unsigned*)(args.ws + WS_CTL) + CW_BAR; bar.x = 0; bar.st = nullptr;
    if (MK_N_LAUNCHES == 1) bar = xcd_barrier_post((unsigned*)(args.ws + WS_CTL) + CW_BAR, MISC + 8);
#define GRID_BAR() do { if (MK_N_LAUNCHES == 1) xcd_barrier(bar); } while (0)
#define FRAME() const Frame F = make_frame(lds, args.out, args.ws)
    const int lo = args.ph_lo, hi = args.ph_hi;
#define IN(k) (lo <= (k) && (k) < hi)
#define BOTH(k) (IN(k) && IN((k) + 1))

    if (EN(0) && IN(0)) REPS(0) { FRAME(); p0_prologue(F); }
    if (BOTH(0)) GRID_BAR();

    for (int l = 0; l < DEPTH; ++l) {
        const int base = 1 + 5 * l;
        if (IN(base)) {
            const int GA = (l + 1 < DEPTH) ? (int)gridDim.x - 32 : (int)gridDim.x;
            if ((int)blockIdx.x < GA) {
            if (EN(1)) REPS(1) { FRAME(); pg8::Gemm g{wsp<bf16>(F, WS_XB), wsp<bf16>(F, WS_WIN + (size_t)l * SZ_WIN), D, D, D}; pg8::TileOrder So; So.init(M / 256, NT_IN, GA, F.bid);
              EpiA E{F.ws};
              pg8::gemm_phase<EpiA, pg8::TileOrder, true, true>(F.lds, g, So, E); }
            if (EN(2)) REPS(2) { FRAME(); const int r5 = (M / 256) * NT_IN - 5 * GA;
              pg8::Gemm g{wsp<bf16>(F, WS_MEMB), wsp<bf16>(F, WS_WMKV + (size_t)l * SZ_WMKV), D, D, D}; pg8::TileOrder So; So.init(2, 8, GA, (F.bid + GA - r5) % GA);
              EpiMemKV E{F.ws};
              pg8::gemm_phase<EpiMemKV, pg8::TileOrder, true, true>(F.lds, g, So, E); }
            } else if (EN(14)) { FRAME(); if (l == 0) { conv_layer(F, 0, GA, I_IN, I_IN + I_O + I_UQ + I_UKV); conv_layer(F, 0, GA, I_IN + I_O + I_UQ + I_UKV + 2 * I_MK, I_LAYER); } conv_layer(F, l + 1, GA, 0, I_LAYER); }
        }
        if (BOTH(base)) GRID_BAR();
        if (IN(base + 1)) {
            if (EN(3)) REPS(3) { FRAME(); pg8::Gemm g{wsp<bf16>(F, WS_CQ), wsp<bf16>(F, WS_WUQ + (size_t)l * SZ_WUQ), 1024, 1024, 1024}; pg8::TileOrder So; So.init(M / 256, 6, F.G, F.bid);
              EpiUQ E{F.ws};
              pg8::gemm_phase<EpiUQ, pg8::TileOrder, true, true>(F.lds, g, So, E); }
            if (EN(4)) REPS(4) { FRAME(); pg8::Gemm g{wsp<bf16>(F, WS_CKV), wsp<bf16>(F, WS_WUKV + (size_t)l * SZ_WUKV), 512, 512, 512}; pg8::TileOrder So; So.init(M / 256, 8, F.G, F.bid);
              EpiUKV E{F.ws};
              pg8::gemm_phase<EpiUKV, pg8::TileOrder, true, true>(F.lds, g, So, E); }
            if (EN(5)) REPS(5) { FRAME(); idx_phase(F); }
            if (EN(6)) REPS(6) { FRAME(); mem_phase(F); }
            if (EN(7)) REPS(7) { FRAME(); lru_phase<false>(F, l); }
        }
        if (BOTH(base + 1)) GRID_BAR();
        if (IN(base + 2)) { if (EN(8)) REPS(8) { FRAME(); mla_phase(F); } if (EN(11)) REPS(11) { FRAME(); dsa_phase(F); } if (EN(10)) REPS(10) { FRAME(); lru_final_phase(F); } }
        if (BOTH(base + 2)) GRID_BAR();
        if (EN(12) && IN(base + 3)) REPS(12) {
            FRAME(); pg8::Gemm g{wsp<bf16>(F, WS_MIX), wsp<bf16>(F, WS_WO + (size_t)l * SZ_WO), D, D, D}; pg8::TileOrder So; So.init(M / 256, D / 256, F.G, F.bid);
            EpiO E{l == 0 ? inp<float>(F, I_X) : nullptr, inp<float>(F, I_LNG) + (size_t)(l > 0 ? l - 1 : 0) * D, inp<float>(F, I_LNB) + (size_t)(l > 0 ? l - 1 : 0) * D, F.ws};
            pg8::gemm_phase<EpiO, pg8::TileOrder, true, true>(F.lds, g, So, E);
        }
        if (BOTH(base + 3)) GRID_BAR();
        if (EN(13) && IN(base + 4)) REPS(13) { FRAME(); ln_phase(F, l, l == DEPTH - 1); }
        if (BOTH(base + 4)) GRID_BAR();
    }
#undef IN
#undef BOTH
}

extern "C" void kernel_launch(void* const* d_in, const int* in_sizes, int n_in, void* d_out, int out_size, void* d_ws, size_t ws_size, hipStream_t stream) {
    static int grid = 0;
    if (grid == 0) {
        if (n_in != 20 || out_size != M * D || ws_size < WS_END) { fprintf(stderr, "kernel_launch: unexpected shapes (n_in %d, out %d, ws %zu, need %zu)\n", n_in, out_size, ws_size, (size_t)WS_END); grid = -1; return; }
        int dev = 0, cus = 0, per_cu = 0;
        if (hipGetDevice(&dev) != hipSuccess || hipDeviceGetAttribute(&cus, hipDeviceAttributeMultiprocessorCount, dev) != hipSuccess) { grid = -1; return; }
        if (hipFuncSetAttribute((const void*)hybrid_fwd, hipFuncAttributeMaxDynamicSharedMemorySize, LDS_BYTES) != hipSuccess) { fprintf(stderr, "kernel_launch: hipFuncSetAttribute failed\n"); grid = -1; return; }
        if (hipOccupancyMaxActiveBlocksPerMultiprocessor(&per_cu, (const void*)hybrid_fwd, NTHR, LDS_BYTES) != hipSuccess || per_cu < 1) fprintf(stderr, "kernel_launch: occupancy query reports %d\n", per_cu);
        (void)hipGetLastError();
        grid = cus;
    }
    if (grid < 0) return;
    if (hipMemsetAsync((char*)d_ws + WS_CTL, 0, CTL_ZERO_BYTES, stream) != hipSuccess) return;
    Args a{};
    for (int i = 0; i < 20; ++i) a.in[i] = d_in[i];
    a.out = (float*)d_out; a.ws = (unsigned char*)d_ws;
#if MK_N_LAUNCHES == 1
    a.ph_lo = 0; a.ph_hi = NPH;
    hipLaunchKernelGGL(hybrid_fwd, dim3(grid), dim3(NTHR), LDS_BYTES, stream, a);
#else
    for (int p = 0; p < NPH; ++p) { a.ph_lo = p; a.ph_hi = p + 1; hipLaunchKernelGGL(hybrid_fwd, dim3(grid), dim3(NTHR), LDS_BYTES, stream, a); }
#endif
}
```

```cpp
#include <hip/hip_runtime.h>
#include <cstdio>
#include <cstdint>

#ifndef MK_N_LAUNCHES
#define MK_N_LAUNCHES 1
#endif

#ifndef EN_MASK
#define EN_MASK 0xFFFF
#endif
#define EN(k) (((EN_MASK) >> (k)) & 1)
#ifndef REP_MASK
#define REP_MASK 0
#endif
#define REPS(k) for (int rep_ = 0; rep_ < ((((REP_MASK) >> (k)) & 1) ? 2 : 1); ++rep_)
#define DI __device__ __forceinline__
#define LAS __attribute__((address_space(3)))
#define GAS __attribute__((address_space(1)))
typedef unsigned short bf16;
typedef unsigned short bf16_t;
typedef short bf16x8 __attribute__((ext_vector_type(8)));
typedef short s16x4 __attribute__((ext_vector_type(4)));
typedef float f32x4 __attribute__((ext_vector_type(4)));
typedef float f32x2 __attribute__((ext_vector_type(2)));
typedef float f32x16 __attribute__((ext_vector_type(16)));
typedef unsigned u32x4 __attribute__((ext_vector_type(4)));
typedef unsigned u32x2 __attribute__((ext_vector_type(2)));
typedef __bf16 bf16v2 __attribute__((ext_vector_type(2)));
#define MFMA32(a, b, c) __builtin_amdgcn_mfma_f32_32x32x16_bf16((a), (b), (c), 0, 0, 0)

DI unsigned pk2(float lo, float hi) { f32x2 v = {lo, hi}; bf16v2 b = __builtin_convertvector(v, bf16v2); return __builtin_bit_cast(unsigned, b); }
DI bf16 f2bf(float f) { return (bf16)(pk2(f, 0.f) & 0xffffu); }
DI float bf2f(unsigned short b) { return __builtin_bit_cast(float, ((unsigned)b) << 16); }
DI float bflo(unsigned w) { return __builtin_bit_cast(float, w << 16); }
DI float bfhi(unsigned w) { return __builtin_bit_cast(float, w & 0xffff0000u); }
DI u32x4 pack8(f32x4 a, f32x4 b) { u32x4 w; w.x = pk2(a[0], a[1]); w.y = pk2(a[2], a[3]); w.z = pk2(b[0], b[1]); w.w = pk2(b[2], b[3]); return w; }
DI float frcp(float x) { return __builtin_amdgcn_rcpf(x); }
DI float silu_f(float x) { return x * frcp(1.0f + __expf(-x)); }
DI float ex2(float x) { return __builtin_amdgcn_exp2f(x); }
DI float xhalf_max(float v) { const unsigned b = __builtin_bit_cast(unsigned, v); auto r = __builtin_amdgcn_permlane32_swap(b, b, false, false); return fmaxf(__builtin_bit_cast(float, (unsigned)r[0]), __builtin_bit_cast(float, (unsigned)r[1])); }
DI float max3_asm(float a, float b, float c) { float r; asm("v_max3_f32 %0, %1, %2, %3" : "=v"(r) : "v"(a), "v"(b), "v"(c)); return r; }
DI float max_asm(float a, float b) { float r; asm("v_max_f32 %0, %1, %2" : "=v"(r) : "v"(a), "v"(b)); return r; }
DI float xhalf_max_asm(float v) { const unsigned b = __builtin_bit_cast(unsigned, v); auto r = __builtin_amdgcn_permlane32_swap(b, b, false, false); return max_asm(__builtin_bit_cast(float, (unsigned)r[0]), __builtin_bit_cast(float, (unsigned)r[1])); }
template <int V> struct IC { static constexpr int value = V; constexpr operator int() const { return V; } };
DI float xhalf_sum(float v) { const unsigned b = __builtin_bit_cast(unsigned, v); auto r = __builtin_amdgcn_permlane32_swap(b, b, false, false); return __builtin_bit_cast(float, (unsigned)r[0]) + __builtin_bit_cast(float, (unsigned)r[1]); }

namespace pg8 {
#define PG8_LAS __attribute__((address_space(3)))
constexpr int BM = 256, BK = 64, HALF = 128, HTB = HALF * BK * 2  , STAGE_BYTES = 8 * HTB, NXCD = 8, WGM = 8;

__host__ __device__ __forceinline__ int lds_byte(int r, int c) { const int st = (r >> 4) * 2 + (c >> 5), rr = r & 15, cc = c & 31, ob = rr * 64 + cc * 2; return st * 1024 + (ob ^ (((ob >> 9) & 1) << 5)); }
__host__ __device__ __forceinline__ void stage_rc(int b, int& R, int& C) { const int st = b / 1024, sb = b % 1024, swz = sb ^ (((sb >> 9) & 1) << 5); R = (st >> 1) * 16 + swz / 64; C = (st & 1) * 32 + (swz % 64) / 2; }
__host__ __device__ __forceinline__ int perm32(int rho) { const int n = rho >> 4, i = rho & 15; return 8 * (i >> 2) + 4 * n + (i & 3); }

struct Unit { int pm, pn; };
struct Gemm { const bf16_t* A; const bf16_t* Bt; int K, lda, ldb; };

struct TileOrder {
    int nM, nN, nwg, G, c;
    __device__ __forceinline__ void init(int nM_, int nN_, int G_, int c_) { nM = nM_; nN = nN_; nwg = nM * nN; G = G_; c = c_; }
    __device__ __forceinline__ bool next(int i, Unit& u) const {
        const long L = (long)i * G + c; if (L >= nwg) return false;
        int wgid = (int)L; { const int q = nwg / NXCD, r = nwg % NXCD, xcd = wgid % NXCD, off = wgid / NXCD; wgid = (xcd < r ? xcd * (q + 1) : r * (q + 1) + (xcd - r) * q) + off; }
        const int nig = WGM * nN, gid = wgid / nig, fm = gid * WGM, gsz = (nM - fm) < WGM ? (nM - fm) : WGM;
        u.pm = fm + ((wgid % nig) % gsz); u.pn = (wgid % nig) / gsz; return true;
    }
    __device__ __forceinline__ void a_ready(const Unit&) const {}
    __device__ __forceinline__ void done(const Unit&) const {}
};
template <class Epi, class Sched, bool ALIGN_EPI = false, bool SP2 = false>
__device__ __forceinline__ void gemm_phase(PG8_LAS unsigned char* lds, const Gemm g, const Sched& S, const Epi& E) {
    int tid_ = threadIdx.x; asm volatile("" : "+v"(tid_));
    const int tid = tid_, wid = __builtin_amdgcn_readfirstlane(tid >> 6), lane = tid & 63, wr = wid >> 2, wc = wid & 3, fr = lane & 15, fq = lane >> 4;
    const int K = g.K, nt = K / BK;
    unsigned voffA[2], voffB[2];
#pragma unroll
    for (int i = 0; i < 2; ++i) { int R, C; stage_rc(tid * 16 + i * 8192, R, C); const int Rb = Epi::PERM ? ((R & ~31) + perm32(R & 31)) : R;
        voffA[i] = (unsigned)(R * g.lda + C) * 2u; voffB[i] = (unsigned)(Rb * g.ldb + C) * 2u; }
    const size_t kstep = (size_t)(BK * 2);
    const size_t hstepA = (size_t)HALF * g.lda * 2, hstepB = (size_t)HALF * g.ldb * 2;
    const size_t tstepA = 2 * hstepA, tstepB = 2 * hstepB;
    const unsigned ldsw = (unsigned)wid * 1024u;
    const int aoff = lds_byte(wr * 64 + fr, fq * 8), boff = lds_byte(wc * 32 + fr, fq * 8);
#define PG8_SA(b, h) (((b) * 2 + (h)) * HTB)
#define PG8_SB(b, h) ((4 + (b) * 2 + (h)) * HTB)
#define PG8_STAGE(bufoff, gbase, voff) do { _Pragma("unroll") for (int _i = 0; _i < 2; ++_i) \
        __builtin_amdgcn_global_load_lds((const unsigned*)((const char*)(gbase) + (voff)[_i]), (PG8_LAS unsigned*)(lds + (bufoff) + ldsw + _i * 8192), 16, 0, 0); } while (0)
#define PG8_LDA(dst, b, h) do { _Pragma("unroll") for (int m = 0; m < 4; ++m) _Pragma("unroll") for (int k = 0; k < 2; ++k) dst[m][k] = *(const PG8_LAS bf16x8*)(lds + PG8_SA(b, h) + aoff + m * 2048 + k * 1024); } while (0)
#define PG8_LDB(dst, b, h) do { _Pragma("unroll") for (int n = 0; n < 2; ++n) _Pragma("unroll") for (int k = 0; k < 2; ++k) dst[n][k] = *(const PG8_LAS bf16x8*)(lds + PG8_SB(b, h) + boff + n * 2048 + k * 1024); } while (0)
#define PG8_MMA(ai, bj, At, Bt) do { __builtin_amdgcn_s_setprio(1); _Pragma("unroll") for (int m = 0; m < 4; ++m) _Pragma("unroll") for (int n = 0; n < 2; ++n) _Pragma("unroll") for (int k = 0; k < 2; ++k) \
        acc[ai][bj][m][n] = __builtin_amdgcn_mfma_f32_16x16x32_bf16(Bt[n][k], At[m][k], acc[ai][bj][m][n], 0, 0, 0); __builtin_amdgcn_s_setprio(0); } while (0)
#define PG8_WAIT_V(n) asm volatile("s_waitcnt vmcnt(" #n ")" ::: "memory")
#define PG8_WAIT_L(n) asm volatile("s_waitcnt lgkmcnt(" #n ")" ::: "memory")
#define PG8_BAR __builtin_amdgcn_s_barrier()
#define PG8_SCHED __builtin_amdgcn_sched_barrier(0)
    Unit cur, nxt; int ui = 0;
    if (!S.next(0, cur)) return;
    f32x4 acc[2][2][4][2];
#pragma unroll
    for (int a = 0; a < 2; ++a)
#pragma unroll
        for (int b = 0; b < 2; ++b)
#pragma unroll
            for (int m = 0; m < 4; ++m)
#pragma unroll
                for (int n = 0; n < 2; ++n) acc[a][b][m][n] = (f32x4){0.f, 0.f, 0.f, 0.f};
    bf16x8 At[4][2], B0[2][2], B1[2][2];
    const char* cA = (const char*)g.A + (size_t)cur.pm * tstepA; const char* cB = (const char*)g.Bt + (size_t)cur.pn * tstepB;
    S.a_ready(cur);
    if constexpr (SP2) {
        PG8_STAGE(PG8_SB(0, 0), cB, voffB); PG8_STAGE(PG8_SB(0, 1), cB + hstepB, voffB); PG8_STAGE(PG8_SA(0, 0), cA, voffA); PG8_STAGE(PG8_SA(0, 1), cA + hstepA, voffA);
        if (wr == 1) PG8_BAR;
        PG8_WAIT_V(2); PG8_BAR;
        PG8_STAGE(PG8_SB(1, 0), cB + kstep, voffB); PG8_STAGE(PG8_SA(1, 0), cA + kstep, voffA); PG8_STAGE(PG8_SB(1, 1), cB + hstepB + kstep, voffB);
        PG8_WAIT_V(6); PG8_BAR;
    } else {
        PG8_STAGE(PG8_SB(0, 0), cB, voffB); PG8_STAGE(PG8_SA(0, 0), cA, voffA); PG8_STAGE(PG8_SB(0, 1), cB + hstepB, voffB); PG8_STAGE(PG8_SA(0, 1), cA + hstepA, voffA);
        if (wr == 1) PG8_BAR;
        PG8_WAIT_V(4); PG8_BAR;
        PG8_STAGE(PG8_SB(1, 0), cB + kstep, voffB); PG8_STAGE(PG8_SA(1, 0), cA + kstep, voffA); PG8_STAGE(PG8_SB(1, 1), cB + hstepB + kstep, voffB);
        PG8_WAIT_V(6); PG8_BAR;
    }
    for (;;) {
        const bool has_next = S.next(ui + 1, nxt);
        const char* nA = has_next ? (const char*)g.A + (size_t)nxt.pm * tstepA : cA; const char* nB = has_next ? (const char*)g.Bt + (size_t)nxt.pn * tstepB : cB;
        for (int t = 0; t < nt; t += 2) {
            const bool last = (t == nt - 2);
            const char* a1 = cA + (size_t)(t + 1) * kstep;
            const char* a2 = last ? nA : cA + (size_t)(t + 2) * kstep; const char* b2 = last ? nB : cB + (size_t)(t + 2) * kstep;
            const char* a3 = a2 + kstep; const char* b3 = b2 + kstep;
            if (last && has_next) S.a_ready(nxt);
            if constexpr (SP2) {
            PG8_LDB(B0, 0, 0); PG8_LDB(B1, 0, 1); PG8_SCHED; PG8_LDA(At, 0, 0); PG8_STAGE(PG8_SA(1, 1), a1 + hstepA, voffA);
            PG8_WAIT_V(8); PG8_WAIT_L(0); PG8_BAR; PG8_MMA(0, 0, At, B0); PG8_MMA(0, 1, At, B1); PG8_BAR; PG8_SCHED;
            PG8_LDA(At, 0, 1); PG8_STAGE(PG8_SB(0, 0), b2, voffB); PG8_STAGE(PG8_SB(0, 1), b2 + hstepB, voffB); PG8_STAGE(PG8_SA(0, 0), a2, voffA);
            PG8_WAIT_V(8); PG8_WAIT_L(0); PG8_BAR; PG8_MMA(1, 0, At, B0); PG8_MMA(1, 1, At, B1); PG8_BAR; PG8_SCHED;
            PG8_LDB(B0, 1, 0); PG8_LDB(B1, 1, 1); PG8_SCHED; PG8_LDA(At, 1, 0); PG8_STAGE(PG8_SA(0, 1), a2 + hstepA, voffA);
            PG8_WAIT_V(8); PG8_WAIT_L(0); PG8_BAR; PG8_MMA(0, 0, At, B0); PG8_MMA(0, 1, At, B1); PG8_BAR; PG8_SCHED;
            PG8_LDA(At, 1, 1); PG8_STAGE(PG8_SB(1, 0), b3, voffB); PG8_STAGE(PG8_SB(1, 1), b3 + hstepB, voffB); PG8_STAGE(PG8_SA(1, 0), a3, voffA);
            PG8_WAIT_V(8); PG8_WAIT_L(0); PG8_BAR; PG8_MMA(1, 0, At, B0); PG8_MMA(1, 1, At, B1); PG8_BAR; PG8_SCHED;
            } else {
            PG8_LDB(B0, 0, 0); PG8_SCHED; PG8_LDA(At, 0, 0); PG8_STAGE(PG8_SA(1, 1), a1 + hstepA, voffA);
            PG8_WAIT_L(8); PG8_BAR; PG8_WAIT_L(0); PG8_MMA(0, 0, At, B0); PG8_BAR; PG8_SCHED;
            PG8_LDB(B1, 0, 1); PG8_STAGE(PG8_SB(0, 0), b2, voffB);
            PG8_BAR; PG8_WAIT_L(0); PG8_MMA(0, 1, At, B1); PG8_BAR;
            PG8_LDA(At, 0, 1); PG8_STAGE(PG8_SA(0, 0), a2, voffA);
            PG8_BAR; PG8_WAIT_L(0); PG8_MMA(1, 0, At, B0); PG8_BAR; PG8_SCHED;
            PG8_STAGE(PG8_SB(0, 1), b2 + hstepB, voffB);
            PG8_WAIT_V(6); PG8_BAR; PG8_MMA(1, 1, At, B1); PG8_BAR;
            PG8_LDB(B0, 1, 0); PG8_SCHED; PG8_LDA(At, 1, 0); PG8_STAGE(PG8_SA(0, 1), a2 + hstepA, voffA);
            PG8_WAIT_L(8); PG8_BAR; PG8_WAIT_L(0); PG8_MMA(0, 0, At, B0); PG8_BAR; PG8_SCHED;
            PG8_LDB(B1, 1, 1); PG8_STAGE(PG8_SB(1, 0), b3, voffB);
            PG8_BAR; PG8_WAIT_L(0); PG8_MMA(0, 1, At, B1); PG8_BAR;
            PG8_LDA(At, 1, 1); PG8_STAGE(PG8_SA(1, 0), a3, voffA);
            PG8_BAR; PG8_WAIT_L(0); PG8_MMA(1, 0, At, B0); PG8_BAR; PG8_SCHED;
            PG8_STAGE(PG8_SB(1, 1), b3 + hstepB, voffB);
            PG8_WAIT_V(6); PG8_BAR; PG8_MMA(1, 1, At, B1); PG8_BAR;
            }
        }
        if constexpr (ALIGN_EPI) { if (wr == 0) PG8_BAR; }
        if constexpr (!Epi::AFTER_DRAIN) { E(acc, cur, wr, wc, fr, fq); S.done(cur); }
        if (!has_next) break;
#pragma unroll
        for (int a = 0; a < 2; ++a)
#pragma unroll
            for (int b = 0; b < 2; ++b)
#pragma unroll
                for (int m = 0; m < 4; ++m)
#pragma unroll
                    for (int n = 0; n < 2; ++n) acc[a][b][m][n] = (f32x4){0.f, 0.f, 0.f, 0.f};
        cur = nxt; cA = nA; cB = nB; ++ui;
        if constexpr (ALIGN_EPI) { if (wr == 1) PG8_BAR; }
    }
    PG8_WAIT_V(0);
    if constexpr (!ALIGN_EPI) { if (wr == 0) PG8_BAR; }
    PG8_BAR;
    if constexpr (Epi::AFTER_DRAIN) { E.fused(acc, cur, wr, wc, fr, fq, lds, wid, lane); S.done(cur); }
#undef PG8_SA
#undef PG8_SB
#undef PG8_STAGE
#undef PG8_LDA
#undef PG8_LDB
#undef PG8_MMA
#undef PG8_WAIT_V
#undef PG8_WAIT_L
#undef PG8_BAR
#undef PG8_SCHED
}
}


constexpr int NB = 2, S = 4096, M = NB * S, D = 4096, DEPTH = 4, NMEM = 256;
constexpr int DIN = 10384, NT_IN = 41, NPAD = NT_IN * 256;
constexpr float LN_EPS = 1e-5f, RMS_EPS = 1e-6f;
constexpr float ALPHA = 1.681792830507429f;
constexpr float LOG2E = 1.4426950408889634f;
constexpr float QS_MLA = 0.07216878364870322f * LOG2E;
constexpr float QS_DSA = 0.08838834764831845f * LOG2E;
constexpr float QS_MEM = 0.0625f * LOG2E;
constexpr int NWAVES = 8, NTHR = 512;

constexpr size_t MiB = 1u << 20;
constexpr size_t WS_CTL = 0, CTL_ZERO_BYTES = 1 * MiB;
constexpr size_t SZ_WIN = (size_t)NPAD * D * 2, SZ_WO = (size_t)D * D * 2, SZ_WUQ = (size_t)1536 * 1024 * 2, SZ_WUKV = (size_t)2048 * 512 * 2,
                 SZ_WMKV = (size_t)2048 * 4096 * 2, SZ_WG = (size_t)16 * 64 * 64 * 2;
constexpr size_t WS_WIN = 1 * MiB;
constexpr size_t WS_WO = WS_WIN + DEPTH * SZ_WIN;
constexpr size_t WS_WUQ = WS_WO + DEPTH * SZ_WO;
constexpr size_t WS_WUKV = WS_WUQ + DEPTH * SZ_WUQ;
constexpr size_t WS_WMKV = WS_WUKV + DEPTH * SZ_WUKV;
constexpr size_t WS_WA = WS_WMKV + DEPTH * SZ_WMKV;
constexpr size_t WS_WX = WS_WA + DEPTH * SZ_WG;
constexpr size_t WS_ACT = ((WS_WX + DEPTH * SZ_WG + MiB - 1) / MiB) * MiB;
constexpr size_t WS_XB = WS_ACT;
constexpr size_t WS_XN = WS_XB + (size_t)M * D * 2;
constexpr size_t WS_HL = WS_XN + MiB;
constexpr size_t WS_Z = WS_XN + (size_t)M * D * 4;
constexpr size_t WS_MEMB = WS_Z + (size_t)M * D * 4;
constexpr size_t WS_CQ = WS_MEMB + (size_t)512 * D * 2;
constexpr size_t WS_CKV = WS_CQ + (size_t)M * 1024 * 2;
constexpr size_t WS_G = WS_CKV + (size_t)M * 512 * 2;
constexpr size_t WS_BQ = WS_G + (size_t)M * 4096 * 2;
constexpr size_t WS_BK = WS_BQ + (size_t)M * 1024 * 2;
constexpr size_t WS_VTD = WS_BK + (size_t)M * 256 * 2;
constexpr size_t WS_QI = WS_VTD + (size_t)M * 256 * 2;
constexpr size_t WS_KI = WS_QI + (size_t)M * 1024 * 2;
constexpr size_t WS_WI = WS_KI + (size_t)M * 64 * 2;
constexpr size_t WS_CU = WS_WI + (size_t)M * 16 * 4;
constexpr size_t WS_DQ = WS_CU + (size_t)M * 1024 * 4;
constexpr size_t WS_SMALL = WS_DQ + (size_t)M * 1024 * 2;
constexpr size_t WS_SSQ = WS_SMALL + (size_t)M * 256 * 4;
constexpr size_t WS_SSKV = WS_SSQ + (size_t)M * 16 * 4;
constexpr size_t WS_QM = WS_SSKV + (size_t)M * 8 * 4;
constexpr size_t WS_KM = WS_QM + (size_t)M * 1536 * 2;
constexpr size_t WS_VTM = WS_KM + (size_t)M * 1536 * 2;
constexpr size_t WS_SC = WS_VTM + (size_t)M * 1024 * 2;
constexpr size_t WS_MASK = WS_SC + (size_t)NB * S * S * 4;
constexpr size_t WS_MIX = WS_MASK + (size_t)M * 128 * 4;
constexpr size_t WS_LSUM = WS_MIX + (size_t)M * 4096 * 2;
constexpr size_t WS_KMEM = WS_LSUM + (size_t)NB * 32 * 1024 * 8;
constexpr size_t WS_VTMEM = WS_KMEM + (size_t)512 * 1024 * 2;
constexpr size_t WS_CSM = WS_VTMEM + (size_t)512 * 1024 * 2;
constexpr size_t WS_CSD = WS_CSM + (size_t)M * 32 * 8;
constexpr size_t WS_CSI = WS_CSD + (size_t)M * 16 * 8;
constexpr size_t WS_END = WS_CSI + (size_t)M * 8 * 8;
constexpr int CW_BAR = 4096;

constexpr int RING_BYTES = 131072;
constexpr int LDSCTL_OFF = RING_BYTES, MISC_OFF = LDSCTL_OFF + 320;
constexpr int LDS_BYTES = 147456;

#define LDS_WAIT() asm volatile("s_waitcnt lgkmcnt(0)" ::: "memory")
#define VM_WAIT() asm volatile("s_waitcnt vmcnt(0)" ::: "memory")

#define XB_TMO      128
#define XB_XCNT(j)  (256  + 64 * (j))
#define XB_XSUB(j)  (1280 + 64 * (j))
#define XB_XGEN(j)  (2304 + 64 * (j))
#define XB_TOP      3328
#define XB_TOPGEN   3392
#define XCD_BAR_WORDS 3456
#define XB_SPIN_CAP (1u << 18)

__device__ __forceinline__ unsigned xb_ld(unsigned* p)              { return __hip_atomic_load(p, __ATOMIC_RELAXED, __HIP_MEMORY_SCOPE_AGENT); }
__device__ __forceinline__ unsigned xb_add(unsigned* p, unsigned v) { return __hip_atomic_fetch_add(p, v, __ATOMIC_RELAXED, __HIP_MEMORY_SCOPE_AGENT); }
__device__ __forceinline__ unsigned xb_xcc_id() { return (unsigned)__builtin_amdgcn_s_getreg((3 << 11) | 20) & 0xFu; }
#define XB_SPIN(cond, bar) do { unsigned _sp = 0; while (cond) { __builtin_amdgcn_s_sleep(1); \
    if ((++_sp & 255u) == 0u) { if (xb_ld(&(bar)[XB_TMO])) break; if (_sp > XB_SPIN_CAP) { atomicAdd(&(bar)[XB_TMO], 1u); break; } } } } while (0)

struct XcdBarrier {
    unsigned* bar; unsigned x;
    volatile LAS unsigned* st;
};

__device__ __forceinline__ XcdBarrier xcd_barrier_post(unsigned* bar, volatile LAS unsigned* st) {
    XcdBarrier b; b.bar = bar; b.x = xb_xcc_id(); b.st = st;
    if (threadIdx.x == 0) (void)xb_add(&bar[XB_XCNT(b.x)], 1u);
    return b;
}
__device__ __forceinline__ void xcd_barrier_complete(unsigned* bar, unsigned x, unsigned& nloc, unsigned& nx) {
    const unsigned G = gridDim.x * gridDim.y * gridDim.z;
    unsigned sum, cnt, mine, sp = 0u;
    for (;;) {
        sum = 0u; cnt = 0u; mine = 0u;
#pragma unroll
        for (unsigned j = 0; j < 16; ++j) { const unsigned c = xb_ld(&bar[XB_XCNT(j)]); sum += c; cnt += (c > 0u) ? 1u : 0u; mine = (j == x) ? c : mine; }
        if (sum == G) break;
        __builtin_amdgcn_s_sleep(1);
        if ((++sp & 255u) == 0u) { if (xb_ld(&bar[XB_TMO])) break; if (sp > XB_SPIN_CAP) { atomicAdd(&bar[XB_TMO], 1u); break; } }
    }
    nloc = mine > 0u ? mine : 1u; nx = cnt > 0u ? cnt : 1u;
}

__device__ __forceinline__ void xcd_barrier(const XcdBarrier& b) {
    asm volatile("s_waitcnt vmcnt(0)" ::: "memory");
    __syncthreads();
    if (threadIdx.x == 0) {
        unsigned* bar = b.bar;
        __builtin_amdgcn_s_waitcnt(0);
        unsigned nloc = b.st[0], nx = b.st[1];
        if (nloc == 0u) { xcd_barrier_complete(bar, b.x, nloc, nx); b.st[0] = nloc; b.st[1] = nx; }
        const unsigned old = xb_add(&bar[XB_XSUB(b.x)], 1u);
        const unsigned gen = old / nloc;
        if (old + 1u == (gen + 1u) * nloc) {
            __builtin_amdgcn_fence(__ATOMIC_RELEASE, "agent");
            asm volatile("s_waitcnt vmcnt(0)" ::: "memory");
            const unsigned og = xb_add(&bar[XB_TOP], 1u);
            const unsigned tg = og / nx;
            if (og + 1u == (tg + 1u) * nx) xb_add(&bar[XB_TOPGEN], 1u);
            else XB_SPIN(xb_ld(&bar[XB_TOPGEN]) == tg, bar);
            __builtin_amdgcn_fence(__ATOMIC_ACQUIRE, "agent");
            xb_add(&bar[XB_XGEN(b.x)], 1u);
            asm volatile("s_waitcnt vmcnt(0)" ::: "memory");
        } else {
            XB_SPIN(xb_ld(&bar[XB_XGEN(b.x)]) == gen, bar);
            __builtin_amdgcn_fence(__ATOMIC_ACQUIRE, "agent");
            asm volatile("s_waitcnt vmcnt(0)" ::: "memory");
        }
    }
    __syncthreads();

}

struct Frame {
    LAS unsigned char* lds;
    int tid, lane, wave, G, bid;
    float* out; unsigned char* ws;
};
constexpr int PTR_OFF = LDSCTL_OFF + 1024;
enum { I_X = 0, I_MEM, I_POS, I_WIN, I_GCQ, I_GCKV, I_WUQ, I_WUKV, I_CONVW, I_CONVB, I_WA, I_BA, I_WX, I_BX, I_LAM, I_WMK, I_WMV, I_WO, I_LNG, I_LNB };
template <class T> DI const T* inp(const Frame& F, int k) {
    const unsigned long long v = ((const LAS unsigned long long*)(F.lds + PTR_OFF))[k];
    const unsigned lo = __builtin_amdgcn_readfirstlane((unsigned)v), hi = __builtin_amdgcn_readfirstlane((unsigned)(v >> 32));
    return (const T*)(const GAS T*)(((unsigned long long)hi << 32) | lo);
}
template <class T> DI T* wsp(const Frame& F, size_t off) { return (T*)(F.ws + off); }

DI int ropeperm(int dp, int half) { const int i = dp >> 1; return (dp & 1) ? half + i : i; }
DI int win_src(int nc) {
    const int t = nc >> 8, j = nc & 255;
    if (t < 4) return t * 256 + j;
    if (t < 6) return 1024 + (t - 4) * 256 + j;
    if (t < 10) return 1600 + (t - 6) * 256 + j;
    if (t < 14) { const int c = (t - 10) * 256 + j, hd = c >> 7, dp = c & 127; return 2624 + hd * 128 + (dp < 32 ? ropeperm(dp, 16) : dp); }
    if (t == 14) { const int hd = j >> 7, dp = j & 127; return 3648 + hd * 128 + (dp < 32 ? ropeperm(dp, 16) : dp); }
    if (t == 15) return 3904 + j;
    if (t < 20) { const int c = (t - 16) * 256 + j, hd = c >> 6, dp = c & 63; return 4160 + hd * 64 + (dp < 16 ? ropeperm(dp, 8) : dp); }
    if (t < 24) return 5264 + (t - 20) * 256 + j;
    if (t < 28) return 6288 + (t - 24) * 256 + j;
    if (t < 32) return 7312 + (t - 28) * 256 + j;
    if (t < 36) return 8336 + (t - 32) * 256 + j;
    if (t < 40) return 9360 + (t - 36) * 256 + j;
    if (j < 64) return 1536 + ropeperm(j, 32);
    if (j < 128) { const int dp = j - 64; return 5184 + (dp < 16 ? ropeperm(dp, 8) : dp); }
    if (j < 144) return 5248 + (j - 128);
    return -1;
}
DI int wuq_src(int nc) {
    if (nc < 1024) return (nc >> 7) * 192 + (nc & 127);
    const int r = nc - 1024; return (r >> 6) * 192 + 128 + ropeperm(r & 63, 32);
}
template <int MAP> DI int conv_src(int n) { return (MAP == 1) ? win_src(n) : (MAP == 2) ? wuq_src(n) : n; }
template <int MAP> DI void conv_item(const float* W, int ldw, const float* kscale, bf16* WT, int ldk, int k0, int n0, LAS unsigned char* scr, int lane) {
    const int nq = lane & 15, kq = lane >> 4;
    const int sc0 = conv_src<MAP>(n0 + 4 * nq), sc1 = conv_src<MAP>(n0 + 4 * nq + 1), sc2 = conv_src<MAP>(n0 + 4 * nq + 2), sc3 = conv_src<MAP>(n0 + 4 * nq + 3);
    const bool contig = (sc0 >= 0) && (sc3 == sc0 + 3) && (sc1 == sc0 + 1) && (sc2 == sc0 + 2);
    f32x4 v[16];
    if (contig) {
#pragma unroll
        for (int i = 0; i < 16; ++i) v[i] = __builtin_nontemporal_load((const f32x4*)(W + (size_t)(k0 + 4 * i + kq) * ldw + sc0));
    } else {
#pragma unroll
        for (int i = 0; i < 16; ++i) { const float* wr = W + (size_t)(k0 + 4 * i + kq) * ldw;
            v[i][0] = sc0 >= 0 ? wr[sc0] : 0.f; v[i][1] = sc1 >= 0 ? wr[sc1] : 0.f; v[i][2] = sc2 >= 0 ? wr[sc2] : 0.f; v[i][3] = sc3 >= 0 ? wr[sc3] : 0.f; }
    }
    if (kscale) {
#pragma unroll
        for (int i = 0; i < 16; ++i) v[i] = v[i] * kscale[k0 + 4 * i + kq];
    }
#pragma unroll
    for (int i = 0; i < 16; ++i) { const int k = 4 * i + kq; *(LAS f32x4*)(scr + k * 256 + 16 * (nq ^ ((k >> 3) & 7))) = v[i]; }
    LDS_WAIT(); asm volatile("" ::: "memory");
#pragma unroll
    for (int j = 0; j < 8; ++j) { const int c = lane + 64 * j, n = c >> 3, kc = c & 7;
        const LAS unsigned char* p = scr + 16 * ((n >> 2) ^ kc) + 4 * (n & 3) + (8 * kc) * 256;
        u32x4 o; o.x = pk2(*(const LAS float*)(p), *(const LAS float*)(p + 256)); o.y = pk2(*(const LAS float*)(p + 512), *(const LAS float*)(p + 768));
        o.z = pk2(*(const LAS float*)(p + 1024), *(const LAS float*)(p + 1280)); o.w = pk2(*(const LAS float*)(p + 1536), *(const LAS float*)(p + 1792));
        __builtin_nontemporal_store(o, (u32x4*)(WT + (size_t)(n0 + n) * ldk + k0 + 8 * kc)); }
    LDS_WAIT(); asm volatile("" ::: "memory");
}
constexpr int I_IN = (D / 64) * (NPAD / 64), I_O = (D / 64) * (D / 64), I_UQ = (1024 / 64) * (1536 / 64), I_UKV = (512 / 64) * (2048 / 64), I_MK = (D / 64) * (1024 / 64), I_G = 16;
constexpr int I_LAYER = I_IN + I_O + I_UQ + I_UKV + 2 * I_MK + 2 * I_G;
DI void conv_layer_item(const Frame& F, int l, int r, LAS unsigned char* scr) {
    if (r < I_IN) { const int nb = NPAD / 64; conv_item<1>(inp<float>(F, I_WIN) + (size_t)l * D * DIN, DIN, nullptr, wsp<bf16>(F, WS_WIN + l * SZ_WIN), D, 64 * (r / nb), 64 * (r % nb), scr, F.lane); return; } r -= I_IN;
    if (r < I_O) { const int nb = D / 64; conv_item<0>(inp<float>(F, I_WO) + (size_t)l * D * D, D, nullptr, wsp<bf16>(F, WS_WO + l * SZ_WO), D, 64 * (r / nb), 64 * (r % nb), scr, F.lane); return; } r -= I_O;
    if (r < I_UQ) { const int nb = 1536 / 64; conv_item<2>(inp<float>(F, I_WUQ) + (size_t)l * 1024 * 1536, 1536, inp<float>(F, I_GCQ) + l * 1024, wsp<bf16>(F, WS_WUQ + l * SZ_WUQ), 1024, 64 * (r / nb), 64 * (r % nb), scr, F.lane); return; } r -= I_UQ;
    if (r < I_UKV) { const int nb = 2048 / 64; conv_item<0>(inp<float>(F, I_WUKV) + (size_t)l * 512 * 2048, 2048, inp<float>(F, I_GCKV) + l * 512, wsp<bf16>(F, WS_WUKV + l * SZ_WUKV), 512, 64 * (r / nb), 64 * (r % nb), scr, F.lane); return; } r -= I_UKV;
    if (r < I_MK) { const int nb = 1024 / 64; conv_item<0>(inp<float>(F, I_WMK) + (size_t)l * D * 1024, 1024, nullptr, wsp<bf16>(F, WS_WMKV + l * SZ_WMKV), D, 64 * (r / nb), 64 * (r % nb), scr, F.lane); return; } r -= I_MK;
    if (r < I_MK) { const int nb = 1024 / 64; conv_item<0>(inp<float>(F, I_WMV) + (size_t)l * D * 1024, 1024, nullptr, wsp<bf16>(F, WS_WMKV + l * SZ_WMKV) + (size_t)1024 * D, D, 64 * (r / nb), 64 * (r % nb), scr, F.lane); return; } r -= I_MK;
    if (r < I_G) { conv_item<0>(inp<float>(F, I_WA) + ((size_t)l * 16 + r) * 4096, 64, nullptr, wsp<bf16>(F, WS_WA + l * SZ_WG) + r * 4096, 64, 0, 0, scr, F.lane); return; } r -= I_G;
    conv_item<0>(inp<float>(F, I_WX) + ((size_t)l * 16 + r) * 4096, 64, nullptr, wsp<bf16>(F, WS_WX + l * SZ_WG) + r * 4096, 64, 0, 0, scr, F.lane);
}
DI void conv_layer(const Frame& F, int l, int wg_lo, int it_lo, int it_hi) {
    if (F.bid < wg_lo) return;
    LAS unsigned char* scr = F.lds + F.wave * 16384;
    const int gw = (F.bid - wg_lo) * NWAVES + F.wave, NGW = (F.G - wg_lo) * NWAVES;
    for (int it = it_lo + gw; it < it_hi; it += NGW) conv_layer_item(F, l, it, scr);
}
DI void rope_entry(int pos, int i, int rot, float& c, float& s) {
    const double e = -((double)(2 * i) / (double)rot) * 13.122363377404329;
    const float inv = (float)exp(e);
    const float ang = (float)pos * inv;
    const double a = (double)ang; const double n = rint(a * 0.15915494309189535); const double r = a - n * 6.283185307179586;
    const float rf = (float)r; c = cosf(rf); s = sinf(rf);
}
DI void p0_prologue(const Frame& F) {
    conv_layer(F, 0, 0, 0, I_IN);
    conv_layer(F, 0, 0, I_IN + I_O + I_UQ + I_UKV, I_IN + I_O + I_UQ + I_UKV + 2 * I_MK);
    const int gw = F.bid * NWAVES + F.wave, NGW = F.G * NWAVES; (void)gw; (void)NGW;
    const size_t gt = (size_t)F.bid * NTHR + F.tid, NGT = (size_t)F.G * NTHR;
    { bf16* xb = wsp<bf16>(F, WS_XB); const float* xin = inp<float>(F, I_X); for (size_t i = gt; i < (size_t)M * D / 8; i += NGT) { const f32x4 a = *(const f32x4*)(xin + i * 8), b = *(const f32x4*)(xin + i * 8 + 4); *(u32x4*)(xb + i * 8) = pack8(a, b); } }
    { bf16* mb = wsp<bf16>(F, WS_MEMB); const float* min_ = inp<float>(F, I_MEM); for (size_t i = gt; i < (size_t)512 * D / 8; i += NGT) { const f32x4 a = *(const f32x4*)(min_ + i * 8), b = *(const f32x4*)(min_ + i * 8 + 4); *(u32x4*)(mb + i * 8) = pack8(a, b); } }
    { f32x2* csm = wsp<f32x2>(F, WS_CSM); f32x2* csd = wsp<f32x2>(F, WS_CSD); f32x2* csi = wsp<f32x2>(F, WS_CSI);
      for (size_t i = gt; i < (size_t)M * 56; i += NGT) { const int row = (int)(i / 56), e = (int)(i % 56); const int p = inp<int>(F, I_POS)[row]; float c, s;
          if (e < 32) { rope_entry(p, e, 64, c, s); csm[(size_t)row * 32 + e] = (f32x2){c, s}; }
          else if (e < 48) { rope_entry(p, e - 32, 32, c, s); csd[(size_t)row * 16 + e - 32] = (f32x2){c, s}; }
          else { rope_entry(p, e - 48, 16, c, s); csi[(size_t)row * 8 + e - 48] = (f32x2){c, s}; } } }
}

using pg8::Unit;
DI void rope8(f32x4& v0, f32x4& v1, const f32x2* cs) {
    const f32x4 a = *(const f32x4*)cs, b = *(const f32x4*)(cs + 2);
    float x1, x2;
    x1 = v0[0]; x2 = v0[1]; v0[0] = x1 * a[0] - x2 * a[1]; v0[1] = x2 * a[0] + x1 * a[1];
    x1 = v0[2]; x2 = v0[3]; v0[2] = x1 * a[2] - x2 * a[3]; v0[3] = x2 * a[2] + x1 * a[3];
    x1 = v1[0]; x2 = v1[1]; v1[0] = x1 * b[0] - x2 * b[1]; v1[1] = x2 * b[0] + x1 * b[1];
    x1 = v1[2]; x2 = v1[3]; v1[2] = x1 * b[2] - x2 * b[3]; v1[3] = x2 * b[2] + x1 * b[3];
}
#define EPI_LOOP_BEGIN _Pragma("unroll") for (int ai = 0; ai < 2; ++ai) _Pragma("unroll") for (int m = 0; m < 4; ++m) { const int row = rbase + ai * 128 + m * 16; _Pragma("unroll") for (int bj = 0; bj < 2; ++bj) { \
        f32x4 v0 = acc[ai][bj][m][0], v1 = acc[ai][bj][m][1]; const int ct = ctb + bj * 128; (void)ct; (void)row;
#define EPI_LOOP_END } }

struct EpiA {
    static constexpr bool PERM = true, AFTER_DRAIN = false;
    unsigned char* ws;
    DI void operator()(const f32x4 (&acc)[2][2][4][2], const Unit& u, int wr, int wc, int fr, int fq) const {
        asm volatile("" : "+v"(fr), "+v"(fq));
        bf16 *cq = (bf16*)(ws + WS_CQ), *ckv = (bf16*)(ws + WS_CKV), *G = (bf16*)(ws + WS_G), *bq = (bf16*)(ws + WS_BQ), *bk = (bf16*)(ws + WS_BK), *vtd = (bf16*)(ws + WS_VTD), *qi = (bf16*)(ws + WS_QI), *dq = (bf16*)(ws + WS_DQ),
             *km = (bf16*)(ws + WS_KM), *ki = (bf16*)(ws + WS_KI); float *cu = (float*)(ws + WS_CU), *wi = (float*)(ws + WS_WI), *ssq = (float*)(ws + WS_SSQ), *sskv = (float*)(ws + WS_SSKV);
        const f32x2 *csm = (const f32x2*)(ws + WS_CSM), *csd = (const f32x2*)(ws + WS_CSD), *csi = (const f32x2*)(ws + WS_CSI);
        const int tile = u.pn, rbase = u.pm * 256 + wr * 64 + fr, ctb = wc * 32 + 8 * fq;
        if (tile < 6) {
            const bool isq = tile < 4; bf16* dst = isq ? cq : ckv; const int ld = isq ? 1024 : 512, tcol = isq ? tile * 256 : (tile - 4) * 256;
#pragma unroll
            for (int ai = 0; ai < 2; ++ai)
#pragma unroll
                for (int m = 0; m < 4; ++m) { const int row = rbase + ai * 128 + m * 16; float ss = 0.f;
#pragma unroll
                    for (int bj = 0; bj < 2; ++bj) { const f32x4 v0 = acc[ai][bj][m][0], v1 = acc[ai][bj][m][1];
                        *(u32x4*)(dst + (size_t)row * ld + tcol + ctb + bj * 128) = pack8(v0, v1);
                        ss += (v0[0] * v0[0] + v0[1] * v0[1]) + (v0[2] * v0[2] + v0[3] * v0[3]) + (v1[0] * v1[0] + v1[1] * v1[1]) + (v1[2] * v1[2] + v1[3] * v1[3]); }
                    ss += __shfl_xor(ss, 16); ss += __shfl_xor(ss, 32);
                    if (fq == 0) { if (isq) ssq[(size_t)row * 16 + tile * 4 + wc] = ss; else sskv[(size_t)row * 8 + (tile - 4) * 4 + wc] = ss; } }
        } else if (tile < 10 || (tile >= 20 && tile < 24) || (tile >= 28 && tile < 32) || tile >= 36 && tile < 40) {
            const int gcol = tile < 10 ? (tile - 6) * 256 : tile < 24 ? 1024 + (tile - 20) * 256 : tile < 32 ? 2048 + (tile - 28) * 256 : 3072 + (tile - 36) * 256;
            EPI_LOOP_BEGIN
#pragma unroll
                for (int j = 0; j < 4; ++j) { v0[j] = silu_f(v0[j]); v1[j] = silu_f(v1[j]); }
                *(u32x4*)(G + (size_t)row * 4096 + gcol + ct) = pack8(v0, v1);
            EPI_LOOP_END
        } else if (tile < 15) {
            const bool isq = tile < 14; bf16* dst = isq ? bq : bk; const int ld = isq ? 1024 : 256, tcol = isq ? (tile - 10) * 256 : 0; const float sc = isq ? QS_DSA : 1.0f;
            EPI_LOOP_BEGIN
                if (wc == 0) rope8(v0, v1, csd + (size_t)row * 16 + 4 * fq);
                v0 = v0 * sc; v1 = v1 * sc;
                *(u32x4*)(dst + (size_t)row * ld + tcol + ct) = pack8(v0, v1);
            EPI_LOOP_END
        } else if (tile == 15) {
            EPI_LOOP_BEGIN
                const int b = row >> 12, t = row & 4095, d0 = wc * 32 + 8 * fq; bf16* p = vtd + ((size_t)(b * 2 + bj) * 128 + d0) * S + t;
#pragma unroll
                for (int j = 0; j < 4; ++j) { p[(size_t)j * S] = f2bf(v0[j]); p[(size_t)(j + 4) * S] = f2bf(v1[j]); }
            EPI_LOOP_END
        } else if (tile < 20) {
            EPI_LOOP_BEGIN
                if ((wc & 1) == 0 && fq < 2) rope8(v0, v1, csi + (size_t)row * 8 + 4 * fq);
                v0 = v0 * 0.125f; v1 = v1 * 0.125f;
                *(u32x4*)(qi + (size_t)row * 1024 + (tile - 16) * 256 + ct) = pack8(v0, v1);
            EPI_LOOP_END
        } else if (tile < 28) {
            EPI_LOOP_BEGIN
                float* p = cu + (size_t)row * 1024 + (tile - 24) * 256 + ct; *(f32x4*)p = v0; *(f32x4*)(p + 4) = v1;
            EPI_LOOP_END
        } else if (tile < 36) {
            EPI_LOOP_BEGIN
                v0 = v0 * QS_MEM; v1 = v1 * QS_MEM;
                *(u32x4*)(dq + (size_t)row * 1024 + (tile - 32) * 256 + ct) = pack8(v0, v1);
            EPI_LOOP_END
        } else {
            EPI_LOOP_BEGIN
                if (ct < 64) { rope8(v0, v1, csm + (size_t)row * 32 + (ct >> 1)); const u32x4 w = pack8(v0, v1);
#pragma unroll
                    for (int hd = 0; hd < 8; ++hd) *(u32x4*)(km + ((size_t)row * 8 + hd) * 192 + 128 + ct) = w; }
                else if (ct < 128) { const int dp = ct - 64; if (dp < 16) rope8(v0, v1, csi + (size_t)row * 8 + (dp >> 1)); *(u32x4*)(ki + (size_t)row * 64 + dp) = pack8(v0, v1); }
                else if (ct < 144) { float* p = wi + (size_t)row * 16 + (ct - 128); *(f32x4*)p = v0 * 0.25f; *(f32x4*)(p + 4) = v1 * 0.25f; }
            EPI_LOOP_END
        }
    }
};
struct EpiMemKV {
    static constexpr bool PERM = true, AFTER_DRAIN = false;
    unsigned char* ws;
    DI void operator()(const f32x4 (&acc)[2][2][4][2], const Unit& u, int wr, int wc, int fr, int fq) const {
        asm volatile("" : "+v"(fr), "+v"(fq));
        bf16 *kmem = (bf16*)(ws + WS_KMEM), *vtmem = (bf16*)(ws + WS_VTMEM);
        const int tile = u.pn, rbase = u.pm * 256 + wr * 64 + fr, ctb = wc * 32 + 8 * fq;
        if (tile < 4) {
            EPI_LOOP_BEGIN
                *(u32x4*)(kmem + (size_t)row * 1024 + tile * 256 + ct) = pack8(v0, v1);
            EPI_LOOP_END
        } else {
            EPI_LOOP_BEGIN
                const int b = row >> 8, mm = row & 255; bf16* p = vtmem + ((size_t)(b * 4 + (tile - 4)) * 256 + ct) * 256 + mm;
#pragma unroll
                for (int j = 0; j < 4; ++j) { p[(size_t)j * 256] = f2bf(v0[j]); p[(size_t)(j + 4) * 256] = f2bf(v1[j]); }
            EPI_LOOP_END
        }
    }
};
struct EpiUQ {
    static constexpr bool PERM = true, AFTER_DRAIN = false;
    unsigned char* ws;
    DI void operator()(const f32x4 (&acc)[2][2][4][2], const Unit& u, int wr, int wc, int fr, int fq) const {
        asm volatile("" : "+v"(fr), "+v"(fq));
        bf16* qm = (bf16*)(ws + WS_QM); const float* ssq = (const float*)(ws + WS_SSQ); const f32x2* csm = (const f32x2*)(ws + WS_CSM);
        const int tile = u.pn, rbase = u.pm * 256 + wr * 64 + fr, ctb = wc * 32 + 8 * fq;
        float rs[2][4];
#pragma unroll
        for (int ai = 0; ai < 2; ++ai)
#pragma unroll
            for (int m = 0; m < 4; ++m) { const float* p = ssq + (size_t)(rbase + ai * 128 + m * 16) * 16; const f32x4 a = *(const f32x4*)p, b = *(const f32x4*)(p + 4), c = *(const f32x4*)(p + 8), d = *(const f32x4*)(p + 12);
                const float s = ((a[0] + a[1]) + (a[2] + a[3])) + ((b[0] + b[1]) + (b[2] + b[3])) + ((c[0] + c[1]) + (c[2] + c[3])) + ((d[0] + d[1]) + (d[2] + d[3]));
                rs[ai][m] = rsqrtf(s * (1.0f / 1024.0f) + RMS_EPS) * QS_MLA; }
        if (tile < 4) {
            EPI_LOOP_BEGIN
                const int head = tile * 2 + bj, d0 = wc * 32 + 8 * fq; v0 = v0 * rs[ai][m]; v1 = v1 * rs[ai][m];
                *(u32x4*)(qm + ((size_t)row * 8 + head) * 192 + d0) = pack8(v0, v1);
            EPI_LOOP_END
        } else {
            EPI_LOOP_BEGIN
                const int head = (tile - 4) * 4 + (ct >> 6), dp = ct & 63;
                rope8(v0, v1, csm + (size_t)row * 32 + (dp >> 1)); v0 = v0 * rs[ai][m]; v1 = v1 * rs[ai][m];
                *(u32x4*)(qm + ((size_t)row * 8 + head) * 192 + 128 + dp) = pack8(v0, v1);
            EPI_LOOP_END
        }
    }
};
struct EpiUKV {
    static constexpr bool PERM = true, AFTER_DRAIN = false;
    unsigned char* ws;
    DI void operator()(const f32x4 (&acc)[2][2][4][2], const Unit& u, int wr, int wc, int fr, int fq) const {
        asm volatile("" : "+v"(fr), "+v"(fq));
        bf16 *km = (bf16*)(ws + WS_KM), *vtm = (bf16*)(ws + WS_VTM); const float* sskv = (const float*)(ws + WS_SSKV);
        const int head = u.pn, rbase = u.pm * 256 + wr * 64 + fr, ctb = wc * 32 + 8 * fq;
        float rs[2][4];
#pragma unroll
        for (int ai = 0; ai < 2; ++ai)
#pragma unroll
            for (int m = 0; m < 4; ++m) { const float* p = sskv + (size_t)(rbase + ai * 128 + m * 16) * 8; const f32x4 a = *(const f32x4*)p, b = *(const f32x4*)(p + 4);
                const float s = ((a[0] + a[1]) + (a[2] + a[3])) + ((b[0] + b[1]) + (b[2] + b[3]));
                rs[ai][m] = rsqrtf(s * (1.0f / 512.0f) + RMS_EPS); }
        EPI_LOOP_BEGIN
            v0 = v0 * rs[ai][m]; v1 = v1 * rs[ai][m]; const int d0 = wc * 32 + 8 * fq;
            if (bj == 0) *(u32x4*)(km + ((size_t)row * 8 + head) * 192 + d0) = pack8(v0, v1);
            else { const int b = row >> 12, t = row & 4095; bf16* p = vtm + ((size_t)(b * 8 + head) * 128 + d0) * S + t;
#pragma unroll
                for (int j = 0; j < 4; ++j) { p[(size_t)j * S] = f2bf(v0[j]); p[(size_t)(j + 4) * S] = f2bf(v1[j]); } }
        EPI_LOOP_END
    }
};
struct EpiO {
    static constexpr bool PERM = true, AFTER_DRAIN = false;
    const float* xin; const float* g; const float* bb; unsigned char* ws;
    DI void operator()(const f32x4 (&acc)[2][2][4][2], const Unit& u, int wr, int wc, int fr, int fq) const {
        asm volatile("" : "+v"(fr), "+v"(fq));
        float* z = (float*)(ws + WS_Z); const f32x2* st = (const f32x2*)(ws + WS_XN);
        const int rbase = u.pm * 256 + wr * 64 + fr, ctb = u.pn * 256 + wc * 32 + 8 * fq;
        if (xin) {
            EPI_LOOP_BEGIN
                const size_t o = (size_t)row * D + ct; const f32x4 r0 = *(const f32x4*)(xin + o), r1 = *(const f32x4*)(xin + o + 4);
                *(f32x4*)(z + o) = r0 * ALPHA + v0; *(f32x4*)(z + o + 4) = r1 * ALPHA + v1;
            EPI_LOOP_END
        } else {
            f32x4 g0[2], g1[2], b0[2], b1[2];
#pragma unroll
            for (int bj = 0; bj < 2; ++bj) { const int c = ctb + bj * 128; g0[bj] = *(const f32x4*)(g + c) * ALPHA; g1[bj] = *(const f32x4*)(g + c + 4) * ALPHA; b0[bj] = *(const f32x4*)(bb + c) * ALPHA; b1[bj] = *(const f32x4*)(bb + c + 4) * ALPHA; }
#pragma unroll
            for (int ai = 0; ai < 2; ++ai)
#pragma unroll
                for (int m = 0; m < 4; ++m) { const int row = rbase + ai * 128 + m * 16; const f32x2 ms = st[row];
#pragma unroll
                    for (int bj = 0; bj < 2; ++bj) { const size_t o = (size_t)row * D + ctb + bj * 128; const f32x4 z0 = *(const f32x4*)(z + o), z1 = *(const f32x4*)(z + o + 4);
                        *(f32x4*)(z + o) = (z0 - ms.x) * ms.y * g0[bj] + b0[bj] + acc[ai][bj][m][0]; *(f32x4*)(z + o + 4) = (z1 - ms.x) * ms.y * g1[bj] + b1[bj] + acc[ai][bj][m][1]; } }
        }
    }
};
template <int DQK> struct AttnCfg { static constexpr int CPR = DQK / 8, KROW = DQK * 2, KBYTES = 64 * KROW, NKC = DQK / 64; };
template <int DQK> DI int attn_kswz(int rho) { return (DQK == 192) ? ((rho >> 1) & 7) : (rho & 15); }
template <int DQK, int MODE, int NDB>
DI void attn_unit(LAS unsigned char* lds, int tid, int wid, int lane,
                  const bf16* Qw, int qstride, const bf16* Kb, int kstride, const bf16* VTb, int vtstride, int nkt, int qpos0,
                  const unsigned* maskrow0, bf16* Ow, const bf16* Gw, int ostride) {
    typedef AttnCfg<DQK> C;
    constexpr bool PIPE = (DQK != 256);
    constexpr int NBUF = PIPE ? 3 : 2;
    constexpr int VBYTES = 32 * NDB * 128, KOFF0 = 0, VOFF0 = NBUF * C::KBYTES;
    const int r = lane & 31, h = lane >> 5, grp = wid >> 2;
    bf16x8 qf[DQK / 16];
    { const unsigned qoff = (unsigned)(r * qstride + 8 * h) * 2u;
#pragma unroll
      for (int ks = 0; ks < DQK / 16; ++ks) qf[ks] = *(const bf16x8*)((const char*)Qw + qoff + 32 * ks); }
    f32x16 o[NDB];
#pragma unroll
    for (int db = 0; db < NDB; ++db)
#pragma unroll
        for (int i = 0; i < 16; ++i) o[db][i] = 0.f;
    float mrun = -1e30f, lrun = 0.f;
    unsigned ksrc[C::NKC], vsrc0;
#pragma unroll
    for (int q = 0; q < C::NKC; ++q) { const int L = (8 * q + wid) * 64 + lane, rho = L / C::CPR, cp = L % C::CPR, r5 = rho & 31;
        const int key = (rho & 32) + (r5 & 19) + ((r5 & 4) << 1) + ((r5 & 8) >> 1);
        ksrc[q] = (unsigned)(key * kstride) * 2u + (unsigned)((cp ^ attn_kswz<DQK>(rho)) * 16); }
    { const int L = wid * 64 + lane, d = L >> 3, cp = L & 7; vsrc0 = (unsigned)(d * vtstride) * 2u + (unsigned)((cp ^ ((d >> 1) & 7)) * 16); }
#define ATTN_DMAK(kt_, buf_) do { const int kc_ = (kt_) < nkt ? (kt_) : nkt - 1; const char* kb_ = (const char*)Kb + (size_t)kc_ * (size_t)(128 * kstride); \
        _Pragma("unroll") for (int q = 0; q < C::NKC; ++q) __builtin_amdgcn_global_load_lds((const unsigned*)(kb_ + ksrc[q]), (LAS unsigned*)(lds + KOFF0 + (buf_) * C::KBYTES + (8 * q + wid) * 1024), 16, 0, 0); } while (0)
#define ATTN_DMAV(kt_, buf_) do { const int kc_ = (kt_) < nkt ? (kt_) : nkt - 1; const char* vb_ = (const char*)VTb + (size_t)kc_ * 128; \
        _Pragma("unroll") for (int q = 0; q < NDB / 2; ++q) __builtin_amdgcn_global_load_lds((const unsigned*)(vb_ + (size_t)q * (size_t)(128 * vtstride) + vsrc0), (LAS unsigned*)(lds + VOFF0 + (buf_) * VBYTES + (8 * q + wid) * 1024), 16, 0, 0); } while (0)
#define ATTN_SYNC() do { asm volatile("s_waitcnt vmcnt(0)" ::: "memory"); __builtin_amdgcn_s_barrier(); asm volatile("" ::: "memory"); } while (0)
#define ATTN_SYNCN(n_) do { asm volatile("s_waitcnt vmcnt(%0)" :: "n"(n_) : "memory"); __builtin_amdgcn_s_barrier(); asm volatile("" ::: "memory"); } while (0)
    constexpr int NDMA = C::NKC + NDB / 2;
    const int krow = 32 * grp + r, kswz = attn_kswz<DQK>(krow);
    int klow[4];
    if (DQK == 192) {
#pragma unroll
        for (int c = 0; c < 4; ++c) klow[c] = ((2 * c + h) ^ kswz) * 16;
    }
    int vsw[2];
#pragma unroll
    for (int s2 = 0; s2 < 2; ++s2) vsw[s2] = r * 128 + (((4 * grp + 2 * s2 + h) ^ ((r >> 1) & 7)) * 16);
#define ATTN_KOFF(ks_) (DQK == 192 ? klow[(ks_) & 3] + ((ks_) >> 2) * 128 : (((2 * (ks_) + h) ^ kswz) * 16))
#define ATTN_QK(dst, buf_) do { const LAS unsigned char* kp_ = lds + KOFF0 + (buf_) * C::KBYTES + krow * C::KROW; constexpr int NKS = DQK / 16, KBATCH = 4; \
        _Pragma("unroll") for (int i = 0; i < 16; ++i) dst[i] = 0.f; \
        _Pragma("unroll") for (int kb = 0; kb < NKS; kb += KBATCH) { bf16x8 kf[KBATCH]; \
            _Pragma("unroll") for (int ks = 0; ks < KBATCH; ++ks) if (kb + ks < NKS) kf[ks] = *(const LAS bf16x8*)(kp_ + ATTN_KOFF(kb + ks)); \
            __builtin_amdgcn_sched_barrier(0); \
            _Pragma("unroll") for (int ks = 0; ks < KBATCH; ++ks) if (kb + ks < NKS) dst = MFMA32(kf[ks], qf[kb + ks], dst); \
            __builtin_amdgcn_sched_barrier(0); } } while (0)
#define ATTN_DMAV1(vbp_, buf_, q_) __builtin_amdgcn_global_load_lds((const unsigned*)((vbp_) + (size_t)(q_) * (size_t)(128 * vtstride) + vsrc0), (LAS unsigned*)(lds + VOFF0 + (buf_) * VBYTES + (8 * (q_) + wid) * 1024), 16, 0, 0)
    static_assert(!PIPE || (DQK / 64 == C::NKC && NDB == 4), "one K piece per QK batch, two V pieces");
    f32x16 s, sn;
    constexpr int MTOFF = 106496;
    unsigned mw[8];
    if (MODE == 2) {
#pragma unroll
        for (int i = 0; i < 8; ++i) mw[i] = maskrow0[tid + 512 * i];
    }
    __syncthreads();
    if (MODE == 2) {
#pragma unroll
        for (int i = 0; i < 8; ++i) { const int idx = tid + 512 * i, row = idx >> 7, w = idx & 127; *(LAS unsigned*)(lds + MTOFF + (row * 129 + w) * 4) = mw[i]; }
        LDS_WAIT();
    }
    if (PIPE) { ATTN_DMAK(0, 0); ATTN_DMAK(1, 1); ATTN_DMAV(0, 0); ATTN_DMAK(2, 2); ATTN_DMAV(1, 1); ATTN_SYNCN(2 * NDMA); ATTN_QK(s, 0); }
    else { ATTN_DMAK(0, 0); ATTN_DMAV(0, 0); }
    if (__builtin_amdgcn_readfirstlane(wid) >= 4) __builtin_amdgcn_s_setprio(1);
    auto tile_step = [&](f32x16& s, f32x16& sn, const int kt, auto c0c) __attribute__((always_inline)) {
        const int c0 = (int)c0c;
        const int c1 = c0 == 2 ? 0 : c0 + 1, c2 = c1 == 2 ? 0 : c1 + 1, vb = PIPE ? c0 : (kt & 1);
        const int kck = kt + 3 < nkt ? kt + 3 : nkt - 1, kcv = kt + 2 < nkt ? kt + 2 : nkt - 1;
        const char* kbp = (const char*)Kb + (size_t)kck * (size_t)(128 * kstride); const char* vbp = (const char*)VTb + (size_t)kcv * 128;
        if (PIPE) ATTN_SYNCN(NDMA);
        else { ATTN_SYNC(); ATTN_DMAK(kt + 1, (kt + 1) & 1); ATTN_DMAV(kt + 1, (kt + 1) & 1); ATTN_QK(s, kt & 1); }
        constexpr bool VEARLY = (DQK != 256);
        bf16x8 vf[NDB][2];
        const LAS unsigned char* vq2[2];
#pragma unroll
        for (int s2 = 0; s2 < 2; ++s2) { vq2[s2] = lds + VOFF0 + vb * VBYTES + vsw[s2]; asm volatile("" : "+v"(vq2[s2])); }
#define ATTN_VFRAG(db_, s2_) (*(const LAS bf16x8*)(vq2[s2_] + (db_) * 4096))
        constexpr bool VLATE = (DQK == 192);
        if (VEARLY) {
            if (!VLATE) {
#pragma unroll
                for (int db = 0; db < NDB; ++db)
#pragma unroll
                    for (int s2 = 0; s2 < 2; ++s2) vf[db][s2] = ATTN_VFRAG(db, s2);
                __builtin_amdgcn_sched_barrier(0);
            }
            if (PIPE) { ATTN_DMAV1(vbp, c2, 0); __builtin_amdgcn_sched_barrier(0); }
        }
        constexpr int NKS = DQK / 16, KW = (DQK == 192) ? 2 : 4, SL0 = (NKS - 8) / 2;
        const LAS unsigned char* kpn = lds + KOFF0 + c1 * C::KBYTES + krow * C::KROW;
        const LAS unsigned char* kq4[4];
        if (DQK == 192) {
#pragma unroll
            for (int c = 0; c < 4; ++c) { kq4[c] = kpn + klow[c]; asm volatile("" : "+v"(kq4[c])); }
        }
#define ATTN_KFRAG(ks_) (*(const LAS bf16x8*)(DQK == 192 ? kq4[(ks_) & 3] + ((ks_) >> 2) * 128 : kpn + ATTN_KOFF(ks_)))
        bf16x8 kf[PIPE ? NKS : 1];
        if (PIPE) {
#pragma unroll
            for (int ks = 0; ks < KW; ++ks) kf[ks] = ATTN_KFRAG(ks);
            __builtin_amdgcn_sched_barrier(0);
        }
        const int key0 = 64 * kt + 32 * grp;
        const bool need_mask = (MODE == 2) || (MODE == 1 && key0 + 31 > qpos0);
        unsigned vmask = 0xffffffffu;
        if (need_mask) {
            if (MODE == 1) { const int lim = qpos0 + r - key0; vmask = lim >= 31 ? 0xffffffffu : (lim < 0 ? 0u : ((2u << lim) - 1u)); }
            else vmask = *(const LAS unsigned*)(lds + MTOFF + (r * 129 + 2 * kt + grp) * 4);
            vmask >>= 8 * h;
        }
        float mx = max3_asm(s[0], s[1], s[2]);
#pragma unroll
        for (int i = 3; i < 15; i += 2) mx = max3_asm(mx, s[i], s[i + 1]);
        mx = xhalf_max_asm(max_asm(mx, s[15]));
        if (__any(mx > mrun + 8.0f)) { const float mn = fmaxf(mrun, mx), alpha = ex2(mrun - mn); mrun = mn; lrun *= alpha;
#pragma unroll
            for (int db = 0; db < NDB; ++db)
#pragma unroll
                for (int i = 0; i < 16; ++i) o[db][i] *= alpha; }
        bf16x8 pf[2];
        if (PIPE) {
            float ps0 = 0.f; unsigned pw[8];
            f32x16 zero16;
#pragma unroll
            for (int i = 0; i < 16; ++i) zero16[i] = 0.f;
#define ATTN_SLOT(KS_, M_) if ((KS_) < NKS) { constexpr int ks = (KS_) < NKS ? (KS_) : 0; \
                if (ks + KW < NKS) kf[(ks + KW) % NKS] = ATTN_KFRAG((ks + KW) % NKS); \
                if (ks == 0) sn = MFMA32(kf[0], qf[0], zero16); else sn = MFMA32(kf[ks], qf[ks], sn); \
                constexpr int j_ = ks - SL0; \
                if (j_ >= 0 && j_ < 8) { constexpr int e0_ = 2 * (j_ & 7), e1_ = e0_ + 1; unsigned m0_ = 0, m1_ = 0; \
                    if (M_) { asm("v_bfe_i32 %0, %1, %2, 1" : "=v"(m0_) : "v"(vmask), "n"((e0_ & 7) + 16 * (e0_ >> 3))); asm("v_bfe_i32 %0, %1, %2, 1" : "=v"(m1_) : "v"(vmask), "n"((e1_ & 7) + 16 * (e1_ >> 3))); } \
                    float p0_ = ex2(s[e0_] - mr_), p1_ = ex2(s[e1_] - mr_); \
                    if (M_) { p0_ = __builtin_bit_cast(float, __builtin_bit_cast(unsigned, p0_) & m0_); p1_ = __builtin_bit_cast(float, __builtin_bit_cast(unsigned, p1_) & m1_); } \
                    ps0 += p0_; ps0 += p1_; pw[j_ & 7] = pk2(p0_, p1_); } \
                if ((ks & 3) == 3) __builtin_amdgcn_global_load_lds((const unsigned*)(kbp + ksrc[ks >> 2]), (LAS unsigned*)(lds + KOFF0 + c0 * C::KBYTES + (8 * (ks >> 2) + wid) * 1024), 16, 0, 0); \
                __builtin_amdgcn_sched_barrier(0); }
#define ATTN_BLOCKB(M_) do { float mr_ = mrun; asm volatile("" : "+v"(mr_));     \
            ATTN_SLOT(0, M_) ATTN_SLOT(1, M_) ATTN_SLOT(2, M_) ATTN_SLOT(3, M_) ATTN_SLOT(4, M_) ATTN_SLOT(5, M_) ATTN_SLOT(6, M_) ATTN_SLOT(7, M_) ATTN_SLOT(8, M_) ATTN_SLOT(9, M_) ATTN_SLOT(10, M_) ATTN_SLOT(11, M_) } while (0)
            if (need_mask) ATTN_BLOCKB(true); else ATTN_BLOCKB(false);
#undef ATTN_BLOCKB
#undef ATTN_SLOT
            if (VLATE) { vf[0][0] = ATTN_VFRAG(0, 0); vf[0][1] = ATTN_VFRAG(0, 1); vf[1][0] = ATTN_VFRAG(1, 0); vf[1][1] = ATTN_VFRAG(1, 1); vf[2][0] = ATTN_VFRAG(2, 0); vf[2][1] = ATTN_VFRAG(2, 1); vf[3][0] = ATTN_VFRAG(3, 0); vf[3][1] = ATTN_VFRAG(3, 1); __builtin_amdgcn_sched_barrier(0); }
            lrun += ps0;
            ATTN_DMAV1(vbp, c2, 1); __builtin_amdgcn_sched_barrier(0);
            pf[0] = __builtin_bit_cast(bf16x8, ((u32x4){pw[0], pw[1], pw[2], pw[3]})); pf[1] = __builtin_bit_cast(bf16x8, ((u32x4){pw[4], pw[5], pw[6], pw[7]}));
        } else {
            float ps = 0.f; float pv[16];
            if (need_mask) {
#pragma unroll
                for (int i = 0; i < 16; ++i) { const int kl = (i & 7) + 16 * (i >> 3); const unsigned mi = (unsigned)__builtin_amdgcn_sbfe((int)vmask, kl, 1);
                    const float p = __builtin_bit_cast(float, __builtin_bit_cast(unsigned, ex2(s[i] - mrun)) & mi); pv[i] = p; ps += p; }
            } else {
#pragma unroll
                for (int i = 0; i < 16; ++i) { const float p = ex2(s[i] - mrun); pv[i] = p; ps += p; }
            }
            lrun += ps;
#pragma unroll
            for (int s2 = 0; s2 < 2; ++s2) { u32x4 w; w.x = pk2(pv[8 * s2], pv[8 * s2 + 1]); w.y = pk2(pv[8 * s2 + 2], pv[8 * s2 + 3]); w.z = pk2(pv[8 * s2 + 4], pv[8 * s2 + 5]); w.w = pk2(pv[8 * s2 + 6], pv[8 * s2 + 7]); pf[s2] = __builtin_bit_cast(bf16x8, w); }
        }
#pragma unroll
        for (int db = 0; db < NDB; ++db) {
            if (!VEARLY) { vf[0][0] = ATTN_VFRAG(db, 0); vf[0][1] = ATTN_VFRAG(db, 1); o[db] = MFMA32(vf[0][0], pf[0], o[db]); o[db] = MFMA32(vf[0][1], pf[1], o[db]); }
            else {
#pragma unroll
                for (int s2 = 0; s2 < 2; ++s2) o[db] = MFMA32(vf[db][s2], pf[s2], o[db]); } }
#undef ATTN_VFRAG
#undef ATTN_KFRAG
    };
    if (DQK != 128) { int c0 = 0;
        for (int kt = 0; kt < nkt; kt += 2) { tile_step(s, sn, kt, c0); c0 = c0 == 2 ? 0 : c0 + 1; if (kt + 1 < nkt) { tile_step(sn, s, kt + 1, c0); c0 = c0 == 2 ? 0 : c0 + 1; } }
    } else
    for (int kt = 0; kt < nkt; kt += 6) {
        tile_step(s, sn, kt, IC<0>{}); if (kt + 1 >= nkt) break;
        tile_step(sn, s, kt + 1, IC<1>{}); if (kt + 2 >= nkt) break;
        tile_step(s, sn, kt + 2, IC<2>{}); if (kt + 3 >= nkt) break;
        tile_step(sn, s, kt + 3, IC<0>{}); if (kt + 4 >= nkt) break;
        tile_step(s, sn, kt + 4, IC<1>{}); if (kt + 5 >= nkt) break;
        tile_step(sn, s, kt + 5, IC<2>{});
    }
    __builtin_amdgcn_s_setprio(0);
    asm volatile("s_waitcnt vmcnt(0)" ::: "memory");
#undef ATTN_DMAK
#undef ATTN_DMAV
#undef ATTN_SYNC
#undef ATTN_SYNCN
#undef ATTN_QK
#undef ATTN_KOFF
#undef ATTN_DMAV1
    const float lt = xhalf_sum(lrun);
    int ln = lane; asm volatile("" : "+v"(ln)); const int re = ln & 31, he = ln >> 5;
    constexpr int CPRW = NDB * 4, RPI = 64 / CPRW;
    constexpr bool GPRE = (NDB == 4);
    u32x4 gpre[GPRE ? 32 / RPI : 1];
    if (GPRE && grp == 0) {
#pragma unroll
        for (int it = 0; it < 32 / RPI; ++it) { const int row = it * RPI + ln / CPRW, ch = ln % CPRW; gpre[it] = *(const u32x4*)((const char*)Gw + (unsigned)(row * ostride) * 2u + (unsigned)ch * 16u); }
    }
    __syncthreads();
    LAS float* mb = (LAS float*)lds + (wid & 3) * ((NDB * 16 + 2) * 64);
    if (grp == 1) {
#pragma unroll
        for (int db = 0; db < NDB; ++db)
#pragma unroll
            for (int i = 0; i < 16; ++i) mb[(db * 16 + i) * 64 + lane] = o[db][i];
        mb[(NDB * 16) * 64 + lane] = mrun; mb[(NDB * 16 + 1) * 64 + lane] = lt;
    }
    __syncthreads();
    if (grp == 0) {
        const float m2 = mb[(NDB * 16) * 64 + lane], l2 = mb[(NDB * 16 + 1) * 64 + lane];
        const float mm = fmaxf(mrun, m2), a1 = ex2(mrun - mm), a2 = ex2(m2 - mm);
        const float inv = frcp(lt * a1 + l2 * a2);
        const float c1 = a1 * inv, c2 = a2 * inv;
        LAS unsigned char* stg = lds + 4 * ((NDB * 16 + 2) * 256) + (wid & 3) * (32 * 272);
#pragma unroll
        for (int db = 0; db < NDB; ++db)
#pragma unroll
            for (int g4 = 0; g4 < 4; ++g4) {
                const float y0 = o[db][4 * g4 + 0] * c1 + mb[(db * 16 + 4 * g4 + 0) * 64 + lane] * c2, y1 = o[db][4 * g4 + 1] * c1 + mb[(db * 16 + 4 * g4 + 1) * 64 + lane] * c2;
                const float y2 = o[db][4 * g4 + 2] * c1 + mb[(db * 16 + 4 * g4 + 2) * 64 + lane] * c2, y3 = o[db][4 * g4 + 3] * c1 + mb[(db * 16 + 4 * g4 + 3) * 64 + lane] * c2;
                *(LAS u32x2*)(stg + re * 272 + (32 * db + 8 * g4 + 4 * he) * 2) = (u32x2){pk2(y0, y1), pk2(y2, y3)}; }
        LDS_WAIT(); asm volatile("" ::: "memory");
#pragma unroll
        for (int it = 0; it < 32 / RPI; ++it) { const int row = it * RPI + ln / CPRW, ch = ln % CPRW; const unsigned off = (unsigned)(row * ostride) * 2u + (unsigned)ch * 16u;
            const u32x4 yv = *(const LAS u32x4*)(stg + row * 272 + ch * 16); u32x4 gv; if (GPRE) gv = gpre[it]; else gv = *(const u32x4*)((const char*)Gw + off);
            *(u32x4*)((char*)Ow + off) = (u32x4){pk2(bflo(yv.x) * bflo(gv.x), bfhi(yv.x) * bfhi(gv.x)), pk2(bflo(yv.y) * bflo(gv.y), bfhi(yv.y) * bfhi(gv.y)),
                                                 pk2(bflo(yv.z) * bflo(gv.z), bfhi(yv.z) * bfhi(gv.z)), pk2(bflo(yv.w) * bflo(gv.w), bfhi(yv.w) * bfhi(gv.w))}; }
    }
}

DI void mla_phase(const Frame& F) {
    const bf16* qm = wsp<bf16>(F, WS_QM); const bf16* km = wsp<bf16>(F, WS_KM); const bf16* vtm = wsp<bf16>(F, WS_VTM); const bf16* G = wsp<bf16>(F, WS_G); bf16* mix = wsp<bf16>(F, WS_MIX);
    const int wq = F.wave & 3;
    for (int j0 = F.bid; j0 < 256; j0 += F.G) {
        const int j = (F.G == 256) ? ((j0 & 7) * 32 + (j0 >> 3)) : j0;
        const int bh = j >> 4, b = bh >> 3, head = bh & 7, p = j & 15;
        for (int k = 0; k < 2; ++k) { const int qb = k ? p : 31 - p, q0 = 128 * qb, row0 = b * S + q0 + 32 * wq;
            attn_unit<192, 1, 4>(F.lds, F.tid, F.wave, F.lane, qm + ((size_t)row0 * 8 + head) * 192, 1536, km + ((size_t)(b * S) * 8 + head) * 192, 1536,
                              vtm + (size_t)(b * 8 + head) * 128 * S, S, 2 * qb + 2, q0 + 32 * wq, nullptr, mix + (size_t)row0 * 4096 + head * 128, G + (size_t)row0 * 4096 + head * 128, 4096); }
    }
}
DI void dsa_phase(const Frame& F) {
    const bf16* bq = wsp<bf16>(F, WS_BQ); const bf16* bk = wsp<bf16>(F, WS_BK); const bf16* vtd = wsp<bf16>(F, WS_VTD); const bf16* G = wsp<bf16>(F, WS_G); bf16* mix = wsp<bf16>(F, WS_MIX);
    const unsigned* mask = wsp<unsigned>(F, WS_MASK);
    const int wq = F.wave & 3;
    for (int j0 = F.bid; j0 < 256; j0 += F.G) {
        const int j = (F.G == 256) ? ((j0 & 7) * 32 + (j0 >> 3)) : j0;
        const int bn = j >> 6, b = bn >> 1, n = bn & 1, p = j & 63, hh = 4 * n + wq;
        for (int k = 0; k < 2; ++k) { const int qb = k ? p : 127 - p, q0 = 32 * qb, row0 = b * S + q0;
            attn_unit<128, 2, 4>(F.lds, F.tid, F.wave, F.lane, bq + (size_t)row0 * 1024 + hh * 128, 1024, bk + (size_t)(b * S) * 256 + n * 128, 256,
                              vtd + (size_t)(b * 2 + n) * 128 * S, S, qb / 2 + 1, q0, mask + (size_t)row0 * 128, mix + (size_t)row0 * 4096 + 1024 + hh * 128, G + (size_t)row0 * 4096 + 1024 + hh * 128, 4096); }
    }
}
DI void mem_unit(LAS unsigned char* lds, int tid, int wid, int lane, const bf16* Qw, const bf16* Kb, const bf16* VTb, bf16* Ow, const bf16* Gw) {
    constexpr int DQK = 256, CPR = 32, KROW = 512, KBYTES = 64 * KROW, VBYTES = 256 * 128, VOFF0 = 2 * KBYTES, qstride = 1024, kstride = 1024, vtstride = 256, ostride = 4096, nkt = 4;
    const int r = lane & 31, h = lane >> 5, grp = wid >> 2;
    bf16x8 qf[16];
    { const unsigned qoff = (unsigned)(r * qstride + 8 * h) * 2u;
#pragma unroll
      for (int ks = 0; ks < 16; ++ks) qf[ks] = *(const bf16x8*)((const char*)Qw + qoff + 32 * ks); }
    f32x16 o[4];
#pragma unroll
    for (int db = 0; db < 4; ++db)
#pragma unroll
        for (int i = 0; i < 16; ++i) o[db][i] = 0.f;
    float mrun = -1e30f, lrun = 0.f;
    unsigned ksrc[4], vsrc[4];
#pragma unroll
    for (int q = 0; q < 4; ++q) { const int L = (8 * q + wid) * 64 + lane, rho = L / CPR, cp = L % CPR, r5 = rho & 31;
        const int key = (rho & 32) + (r5 & 19) + ((r5 & 4) << 1) + ((r5 & 8) >> 1);
        ksrc[q] = (unsigned)(key * kstride) * 2u + (unsigned)((cp ^ (rho & 15)) * 16);
        const int d = L >> 3, cv = L & 7; vsrc[q] = (unsigned)(d * vtstride) * 2u + (unsigned)((cv ^ ((d >> 1) & 7)) * 16); }
#define MEM_DMA(kt_, buf_) do { const int kc_ = (kt_) < nkt ? (kt_) : nkt - 1; const char* kb_ = (const char*)Kb + (size_t)kc_ * (size_t)(128 * kstride); const char* vb_ = (const char*)VTb + (size_t)kc_ * 128; \
        _Pragma("unroll") for (int q = 0; q < 4; ++q) { __builtin_amdgcn_global_load_lds((const unsigned*)(kb_ + ksrc[q]), (LAS unsigned*)(lds + (buf_) * KBYTES + (8 * q + wid) * 1024), 16, 0, 0); \
            __builtin_amdgcn_global_load_lds((const unsigned*)(vb_ + vsrc[q]), (LAS unsigned*)(lds + VOFF0 + (buf_) * VBYTES + (8 * q + wid) * 1024), 16, 0, 0); } } while (0)
    __syncthreads();
    MEM_DMA(0, 0);
    for (int kt = 0; kt < nkt; ++kt) {
        asm volatile("s_waitcnt vmcnt(0)" ::: "memory"); __builtin_amdgcn_s_barrier(); asm volatile("" ::: "memory");
        MEM_DMA(kt + 1, (kt + 1) & 1);
#pragma unroll 1
        for (int sub = 0; sub < 2; ++sub) {
            const int krow = 32 * sub + r, kswz = krow & 15;
            const LAS unsigned char* kp = lds + (kt & 1) * KBYTES + krow * KROW;
            f32x16 s;
#pragma unroll
            for (int i = 0; i < 16; ++i) s[i] = 0.f;
#pragma unroll
            for (int kb = 0; kb < 16; kb += 4) { bf16x8 kf[4];
#pragma unroll
                for (int ks = 0; ks < 4; ++ks) kf[ks] = *(const LAS bf16x8*)(kp + (((2 * (kb + ks) + h) ^ kswz) * 16));
                __builtin_amdgcn_sched_barrier(0);
#pragma unroll
                for (int ks = 0; ks < 4; ++ks) s = MFMA32(kf[ks], qf[kb + ks], s);
                __builtin_amdgcn_sched_barrier(0); }
            float mx = s[0];
#pragma unroll
            for (int i = 1; i < 16; ++i) mx = fmaxf(mx, s[i]);
            mx = xhalf_max(mx);
            if (__any(mx > mrun + 8.0f)) { const float mn = fmaxf(mrun, mx), alpha = ex2(mrun - mn); mrun = mn; lrun *= alpha;
#pragma unroll
                for (int db = 0; db < 4; ++db)
#pragma unroll
                    for (int i = 0; i < 16; ++i) o[db][i] *= alpha; }
            float ps = 0.f; float pv[16];
#pragma unroll
            for (int i = 0; i < 16; ++i) { const float p = ex2(s[i] - mrun); pv[i] = p; ps += p; }
            lrun += ps;
            bf16x8 pf[2];
#pragma unroll
            for (int s2 = 0; s2 < 2; ++s2) { u32x4 w; w.x = pk2(pv[8 * s2], pv[8 * s2 + 1]); w.y = pk2(pv[8 * s2 + 2], pv[8 * s2 + 3]); w.z = pk2(pv[8 * s2 + 4], pv[8 * s2 + 5]); w.w = pk2(pv[8 * s2 + 6], pv[8 * s2 + 7]); pf[s2] = __builtin_bit_cast(bf16x8, w); }
#pragma unroll
            for (int db = 0; db < 4; ++db) { const int d = 128 * grp + 32 * db + r; const LAS unsigned char* vp = lds + VOFF0 + (kt & 1) * VBYTES + d * 128; const int vsw = (d >> 1) & 7;
                const bf16x8 v0 = *(const LAS bf16x8*)(vp + (((4 * sub + h) ^ vsw) * 16)), v1 = *(const LAS bf16x8*)(vp + (((4 * sub + 2 + h) ^ vsw) * 16));
                o[db] = MFMA32(v0, pf[0], o[db]); o[db] = MFMA32(v1, pf[1], o[db]); }
        }
    }
#undef MEM_DMA
    asm volatile("s_waitcnt vmcnt(0)" ::: "memory");
    __syncthreads();
    {
        int ln = lane; asm volatile("" : "+v"(ln)); const int re = ln & 31, he = ln >> 5;
        const float inv = frcp(xhalf_sum(lrun));
        LAS unsigned char* stg = lds + wid * (32 * 272);
#pragma unroll
        for (int db = 0; db < 4; ++db)
#pragma unroll
            for (int g4 = 0; g4 < 4; ++g4)
                *(LAS u32x2*)(stg + re * 272 + (32 * db + 8 * g4 + 4 * he) * 2) = (u32x2){pk2(o[db][4 * g4] * inv, o[db][4 * g4 + 1] * inv), pk2(o[db][4 * g4 + 2] * inv, o[db][4 * g4 + 3] * inv)};
        LDS_WAIT(); asm volatile("" ::: "memory");
#pragma unroll
        for (int it = 0; it < 8; ++it) { const int row = it * 4 + (ln >> 4), ch = ln & 15; const unsigned off = (unsigned)(row * ostride) * 2u + (unsigned)(128 * grp) * 2u + (unsigned)ch * 16u;
            const u32x4 yv = *(const LAS u32x4*)(stg + row * 272 + ch * 16); const u32x4 gv = *(const u32x4*)((const char*)Gw + off);
            *(u32x4*)((char*)Ow + off) = (u32x4){pk2(bflo(yv.x) * bflo(gv.x), bfhi(yv.x) * bfhi(gv.x)), pk2(bflo(yv.y) * bflo(gv.y), bfhi(yv.y) * bfhi(gv.y)),
                                                 pk2(bflo(yv.z) * bflo(gv.z), bfhi(yv.z) * bfhi(gv.z)), pk2(bflo(yv.w) * bflo(gv.w), bfhi(yv.w) * bfhi(gv.w))}; }
    }
}
DI void mem_phase(const Frame& F) {
    const bf16* dq = wsp<bf16>(F, WS_DQ); const bf16* kmem = wsp<bf16>(F, WS_KMEM); const bf16* vtmem = wsp<bf16>(F, WS_VTMEM); const bf16* G = wsp<bf16>(F, WS_G); bf16* mix = wsp<bf16>(F, WS_MIX);
    const int wq = F.wave & 3;
    for (int j = F.bid; j < 256; j += F.G) {
        const int bh = j >> 5, b = bh >> 2, head = bh & 3, qb = j & 31, row0 = b * S + 128 * qb + 32 * wq;
        mem_unit(F.lds, F.tid, F.wave, F.lane, dq + (size_t)row0 * 1024 + head * 256, kmem + (size_t)(b * 256) * 1024 + head * 256, vtmem + (size_t)(b * 4 + head) * 256 * 256,
                 mix + (size_t)row0 * 4096 + 3072 + head * 256, G + (size_t)row0 * 4096 + 3072 + head * 256);
    }
}

DI void select_row(const Frame& F, int row);
DI void idx_item(const Frame& F, int b, int p) {
    const bf16* qi = wsp<bf16>(F, WS_QI); const bf16* ki = wsp<bf16>(F, WS_KI); const float* wi = wsp<float>(F, WS_WI); float* sc = wsp<float>(F, WS_SC);
    const int lane = F.lane, r = lane & 31, h = lane >> 5, tA = 16 * p + 2 * F.wave, tB = 16 * (255 - p) + 2 * F.wave;
    const int aq = (r >> 2) & 1, ah = (r & 3) + 4 * (r >> 3);
    bf16x8 afA[4], afB[4];
#pragma unroll
    for (int ks = 0; ks < 4; ++ks) { afA[ks] = *(const bf16x8*)(qi + ((size_t)(b * S + tA + aq) * 16 + ah) * 64 + 16 * ks + 8 * h); afB[ks] = *(const bf16x8*)(qi + ((size_t)(b * S + tB + aq) * 16 + ah) * 64 + 16 * ks + 8 * h); }
    float wlA[16], wlB[16];
    { const float* wa = wi + (size_t)(b * S + tA + h) * 16; const float* wb = wi + (size_t)(b * S + tB + h) * 16;
#pragma unroll
      for (int i = 0; i < 4; ++i) { const f32x4 x = *(const f32x4*)(wa + 4 * i), y = *(const f32x4*)(wb + 4 * i);
          wlA[4 * i] = x[0]; wlA[4 * i + 1] = x[1]; wlA[4 * i + 2] = x[2]; wlA[4 * i + 3] = x[3]; wlB[4 * i] = y[0]; wlB[4 * i + 1] = y[1]; wlB[4 * i + 2] = y[2]; wlB[4 * i + 3] = y[3]; } }
    float* orowA = sc + ((size_t)(b * S + tA + h)) * S + r; float* orowB = sc + ((size_t)(b * S + tB + h)) * S + r;
    const int nktA = (16 * p + 15) / 32 + 1, nktB = (16 * (255 - p) + 15) / 32 + 1;
    LAS unsigned char* lds = F.lds; constexpr int CHB = 256 * 144;
    const char* kbase = (const char*)(ki + (size_t)(b * S) * 64);
    const int nch = (nktB + 7) >> 3;
    u32x4 stg[4];
#define IDX_GLOAD(c_) do { int tl_ = F.tid; asm volatile("" : "+v"(tl_)); const char* cb_ = kbase + (size_t)(c_) * 32768; _Pragma("unroll") for (int i_ = 0; i_ < 4; ++i_) stg[i_] = *(const u32x4*)(cb_ + (unsigned)(tl_ + 512 * i_) * 16u); } while (0)
#define IDX_LSTORE(buf_) do { int tl_ = F.tid; asm volatile("" : "+v"(tl_)); _Pragma("unroll") for (int i_ = 0; i_ < 4; ++i_) { const int c_ = tl_ + 512 * i_; *(LAS u32x4*)(lds + (buf_) * CHB + (c_ >> 3) * 144 + (c_ & 7) * 16) = stg[i_]; } } while (0)
#define IDX_MMA(af_, wl_, orow_, kt_) do { f32x16 a; _Pragma("unroll") for (int i = 0; i < 16; ++i) a[i] = 0.f; _Pragma("unroll") for (int ks = 0; ks < 4; ++ks) a = MFMA32(af_[ks], kf[ks], a); \
          float s0_ = 0.f, s1_ = 0.f; _Pragma("unroll") for (int i = 0; i < 16; i += 2) { s0_ += wl_[i] * fmaxf(a[i], 0.f); s1_ += wl_[i + 1] * fmaxf(a[i + 1], 0.f); } orow_[32 * (kt_)] = s0_ + s1_; } while (0)
    __syncthreads();
    IDX_GLOAD(0); IDX_LSTORE(0);
    __syncthreads();
    for (int c = 0; c < nch; ++c) {
        if (c + 1 < nch) IDX_GLOAD(c + 1);
        const LAS unsigned char* kb = lds + (c & 1) * CHB + r * 144 + 16 * h;
        for (int t = 0; t < 8; ++t) { const int kt = 8 * c + t; if (kt >= nktB) break;
            bf16x8 kf[4];
#pragma unroll
            for (int ks = 0; ks < 4; ++ks) kf[ks] = *(const LAS bf16x8*)(kb + t * (32 * 144) + 32 * ks);
            IDX_MMA(afB, wlB, orowB, kt);
            if (kt < nktA) IDX_MMA(afA, wlA, orowA, kt);
        }
        if (c + 1 < nch) IDX_LSTORE((c + 1) & 1);
        __syncthreads();
    }
#undef IDX_GLOAD
#undef IDX_LSTORE
#undef IDX_MMA
    asm volatile("s_waitcnt vmcnt(0)" ::: "memory");
    for (int q = 0; q < 4; ++q) select_row(F, b * S + ((q & 2) ? tB : tA) + (q & 1));
}
DI void idx_phase(const Frame& F) {
    for (int j = F.bid; j < 256; j += F.G) idx_item(F, j >> 7, j & 127);
}
DI float wave_max(float v) {
#pragma unroll
    for (int o = 1; o < 64; o <<= 1) v = fmaxf(v, __shfl_xor(v, o));
    return v;
}
DI void select_row(const Frame& F, int row) {
    const float* sc = wsp<float>(F, WS_SC); unsigned* mask = wsp<unsigned>(F, WS_MASK);
    const int lane = F.lane;
    {
        const int t = row & (S - 1), n = t + 1, ng = (n + 511) >> 9;
        const float* srow = sc + (size_t)row * S;
        float u[64];
        { const float* p0 = srow + lane; asm volatile("" : "+v"(p0));
#pragma unroll
          for (int e = 0; e < 32; ++e) u[e] = p0[64 * e]; }
        if (ng > 4) { const float* p1 = srow + 2048 + lane; asm volatile("" : "+v"(p1));
#pragma unroll
          for (int e = 0; e < 32; ++e) u[32 + e] = p1[64 * e]; }
        float vmax = -__builtin_inff(), vmin = __builtin_inff();
#pragma unroll
        for (int g = 0; g < 8; ++g) {
            if (g < ng) {
#pragma unroll
                for (int k = 0; k < 8; ++k) { const int e = 8 * g + k, key = 64 * e + lane; const bool ok = key <= t; const float rv = u[e]; u[e] = ok ? rv : -__builtin_inff(); vmax = fmaxf(vmax, u[e]); vmin = fminf(vmin, ok ? rv : __builtin_inff()); }
            } else {
#pragma unroll
                for (int k = 0; k < 8; ++k) u[8 * g + k] = -__builtin_inff();
            }
        }
        float thr = -__builtin_inff();
        if (n > 256) {
            float lo = -wave_max(-vmin), hi = wave_max(vmax);
            { const unsigned hb = __builtin_bit_cast(unsigned, hi); hi = __builtin_bit_cast(float, (hi > 0.f) ? hb + 1u : (hi < 0.f ? hb - 1u : 1u)); }
            thr = lo;
            for (int it = 0; it < 64; ++it) {
                const float mid = lo + 0.5f * (hi - lo);
                if (!(mid > lo) || !(mid < hi)) break;
                int cnt = 0;
#pragma unroll
                for (int g = 0; g < 8; ++g) {
                    if (g < ng) {
                        unsigned long long bb[8];
#pragma unroll
                        for (int k = 0; k < 8; ++k) bb[k] = __ballot(u[8 * g + k] >= mid);
                        __builtin_amdgcn_sched_barrier(0);
#pragma unroll
                        for (int k = 0; k < 8; ++k) cnt += __popcll(bb[k]);
                        __builtin_amdgcn_sched_barrier(0);
                    }
                }
                if (cnt >= 256) { lo = mid; thr = mid; } else hi = mid;
                if (cnt == 256) break;
            }
        }
        unsigned mlo = 0u, mhi = 0u;
#pragma unroll
        for (int g = 0; g < 8; ++g) {
            if (g < ng) {
#pragma unroll
                for (int k = 0; k < 8; ++k) { const int e = 8 * g + k; const unsigned long long bal = __ballot(u[e] >= thr && u[e] > -__builtin_inff()); if (lane == e) { mlo = (unsigned)bal; mhi = (unsigned)(bal >> 32); } }
            }
        }
        *(u32x2*)(mask + (size_t)row * 128 + 2 * lane) = (u32x2){mlo, mhi};
    }
}
DI void lru_load_raw(const float* cu, int tid, int b, int ch, int n, f32x4 (&raw)[5]) {
#pragma unroll
    for (int i = 0; i < 5; ++i) { const int c = tid + 512 * i, row = c >> 4, part = c & 15, tr = 128 * ch - 3 + row;
        raw[i] = (f32x4){0.f, 0.f, 0.f, 0.f}; if (c < 131 * 16 && tr >= 0) raw[i] = *(const f32x4*)(cu + (size_t)(b * S + tr) * 1024 + 64 * n + 4 * part); }
}
template <bool FINAL>
DI void lru_unit(const Frame& F, int layer, int b, int ch, int n, f32x4 (&raw)[5], bool has_next, int nb, int nch, bool load_cw) {
    LAS unsigned char* lds = F.lds;
    LAS float* U32 = (LAS float*)lds;
    LAS unsigned char* Ub = lds + 32768;
    LAS float* LA = (LAS float*)(lds + 51200);
    LAS float* IG = (LAS float*)(lds + 83968);
    LAS f32x2* SUM = (LAS f32x2*)(lds + 116736);
    LAS f32x2* PRE = (LAS f32x2*)(lds + 116736 + 4096);
    const float* cu = wsp<float>(F, WS_CU); const int tid = F.tid, lane = F.lane, w = F.wave, t0 = 128 * ch;
    const int gr_ = lane & 31, gh_ = lane >> 5, gt_ = w & 1;
    const bf16* WTg = wsp<bf16>(F, (gt_ ? WS_WX : WS_WA) + (size_t)layer * SZ_WG) + (size_t)n * 4096;
    bf16x8 bfr[2][4]; float bsv[2], splv[2];
#pragma unroll
    for (int et = 0; et < 2; ++et) { const int e = 32 * et + gr_;
#pragma unroll
        for (int ks = 0; ks < 4; ++ks) bfr[et][ks] = *(const bf16x8*)(WTg + (size_t)e * 64 + 16 * ks + 8 * gh_);
        bsv[et] = (gt_ ? inp<float>(F, I_BX) : inp<float>(F, I_BA))[(size_t)layer * 1024 + 64 * n + e];
        splv[et] = inp<float>(F, I_LAM)[(size_t)layer * 1024 + 64 * n + e]; }
    __syncthreads();
    {
        LAS unsigned char* RAW = lds + 51200; LAS float* CW = (LAS float*)(lds + 124928);
#pragma unroll
        for (int i = 0; i < 5; ++i) { const int c = tid + 512 * i; if (c < 131 * 16) *(LAS f32x4*)(RAW + (c >> 4) * 272 + (c & 15) * 16) = raw[i]; }
        if (load_cw && tid < 80) { const int j = tid >> 4, part = tid & 15;
            const float* src = (j < 4) ? inp<float>(F, I_CONVW) + ((size_t)layer * 4 + j) * 1024 + 64 * n + 4 * part : inp<float>(F, I_CONVB) + (size_t)layer * 1024 + 64 * n + 4 * part;
            *(LAS f32x4*)(CW + j * 64 + 4 * part) = *(const f32x4*)src; }
        if (has_next) lru_load_raw(cu, tid, nb, nch, n, raw);
    }
    __syncthreads();
    {
        const LAS unsigned char* RAW = lds + 51200; const LAS float* CW = (const LAS float*)(lds + 124928);
        const int t = tid >> 2, cg = (tid & 3) * 16;
        f32x4 acc4[4];
#pragma unroll
        for (int q = 0; q < 4; ++q) acc4[q] = *(const LAS f32x4*)(CW + 256 + cg + 4 * q);
#pragma unroll
        for (int j = 0; j < 4; ++j)
#pragma unroll
            for (int q = 0; q < 4; ++q) acc4[q] += *(const LAS f32x4*)(RAW + (t + j) * 272 + (cg + 4 * q) * 4) * *(const LAS f32x4*)(CW + j * 64 + cg + 4 * q);
#pragma unroll
        for (int q = 0; q < 4; ++q) *(LAS f32x4*)(U32 + t * 64 + cg + 4 * q) = acc4[q];
        *(LAS u32x4*)(Ub + t * 144 + cg * 2) = pack8(acc4[0], acc4[1]); *(LAS u32x4*)(Ub + t * 144 + cg * 2 + 16) = pack8(acc4[2], acc4[3]);
    }
    __syncthreads();
    {
        const int r = lane & 31, h = lane >> 5, rt = w >> 1, gt = w & 1;
        bf16x8 af[4];
#pragma unroll
        for (int ks = 0; ks < 4; ++ks) af[ks] = *(const LAS bf16x8*)(Ub + (32 * rt + r) * 144 + (16 * ks + 8 * h) * 2);
#pragma unroll
        for (int et = 0; et < 2; ++et) { const int e = 32 * et + r;
            f32x16 a;
#pragma unroll
            for (int i = 0; i < 16; ++i) a[i] = 0.f;
#pragma unroll
            for (int ks = 0; ks < 4; ++ks) a = MFMA32(af[ks], bfr[et][ks], a);
            const float bs = bsv[et];
            float spl = 0.f; if (gt == 0) spl = -8.0f * log1pf(expf(-splv[et]));
#pragma unroll
            for (int i = 0; i < 16; ++i) { const int tok = 32 * rt + (i & 3) + 8 * (i >> 2) + 4 * h; const float sg = frcp(1.0f + __expf(-(a[i] + bs)));
                if (gt == 0) LA[tok * 64 + e] = sg * spl; else IG[tok * 64 + e] = sg; } }
    }
    __syncthreads();
    float hloc[16], acum[16]; float hl = 0.f, ac = 1.f;
#pragma unroll
    for (int tt = 0; tt < 16; ++tt) { const int tok = 16 * w + tt; const float la = LA[tok * 64 + lane]; const float a = ex2(la * LOG2E); const float y2 = 2.0f * la;
        const float em = (y2 > -0.25f) ? -y2 * (1.0f + y2 * (0.5f + y2 * (0.16666667f + y2 * (0.041666668f + y2 * (0.0083333338f + y2 * 0.0013888889f))))) : 1.0f - a * a;
        const float mult = __builtin_sqrtf(em);
        const float xin = mult * IG[tok * 64 + lane] * U32[tok * 64 + lane]; hl = a * hl + xin; ac *= a; hloc[tt] = hl; acum[tt] = ac; }
    SUM[w * 64 + lane] = (f32x2){ac, hl};
    const f32x2* lsum = wsp<f32x2>(F, WS_LSUM); const int c = 64 * n + lane;
    if (FINAL) {
        float A = 1.f, H = 0.f;
#pragma unroll
        for (int q = 0; q < 4; ++q) { const int j = 4 * w + q; if (j < ch) { const f32x2 sj = lsum[((size_t)(b * 32 + j)) * 1024 + c]; H = sj.x * H + sj.y; A *= sj.x; } }
        PRE[w * 64 + lane] = (f32x2){A, H};
    }
    __syncthreads();
    float cin = 0.f;
    if (FINAL) {
#pragma unroll
        for (int q = 0; q < 8; ++q) { const f32x2 pq = PRE[q * 64 + lane]; cin = pq.x * cin + pq.y; }
    }
    float cw = cin, atot = 1.f, aw = 1.f;
#pragma unroll
    for (int q = 0; q < 8; ++q) { const f32x2 sq = SUM[q * 64 + lane]; if (q < w) { cw = sq.x * cw + sq.y; aw *= sq.x; } atot *= sq.x; }
    if (FINAL) {
        const bf16* G = wsp<bf16>(F, WS_G); bf16* mix = wsp<bf16>(F, WS_MIX);
#pragma unroll
        for (int tt = 0; tt < 16; ++tt) { const size_t o = (size_t)(b * S + t0 + 16 * w + tt) * 4096 + 2048 + c; const float hv = hloc[tt] + acum[tt] * cw; mix[o] = f2bf(hv * bf2f(G[o])); }
    } else {
        unsigned* hl32 = wsp<unsigned>(F, WS_HL);
#pragma unroll
        for (int tt = 0; tt < 16; ++tt) hl32[(size_t)(b * S + t0 + 16 * w + tt) * 1024 + c] = pk2(hloc[tt] + acum[tt] * cw, acum[tt] * aw);
        if (w == 7) { const f32x2 s7 = SUM[7 * 64 + lane]; wsp<f32x2>(F, WS_LSUM)[((size_t)(b * 32 + ch)) * 1024 + c] = (f32x2){atot, s7.x * cw + s7.y}; }
    }
}
DI void lru_final_phase(const Frame& F) {
    const f32x2* lsum = wsp<f32x2>(F, WS_LSUM); const unsigned* hl32 = wsp<unsigned>(F, WS_HL); const bf16* G = wsp<bf16>(F, WS_G); bf16* mix = wsp<bf16>(F, WS_MIX);
    LAS float* car = (LAS float*)F.lds;
    for (int u = F.bid; u < 256; u += F.G) {
        const int b = u >> 7, ch = (u >> 2) & 31, cq = u & 3;
        __syncthreads();
        if (F.tid < 256) { const int c = 256 * cq + F.tid; float H = 0.f;
            for (int j = 0; j < ch; ++j) { const f32x2 sj = lsum[((size_t)(b * 32 + j)) * 1024 + c]; H = sj.x * H + sj.y; }
            car[F.tid] = H; }
        __syncthreads();
        const int cg = F.tid & 31, tl = F.tid >> 5, c0 = 256 * cq + 8 * cg;
        float cr[8];
#pragma unroll
        for (int k = 0; k < 8; ++k) cr[k] = car[8 * cg + k];
#pragma unroll
        for (int i = 0; i < 8; ++i) { const size_t row = (size_t)(b * S + 128 * ch + tl + 16 * i);
            const u32x4 p0 = *(const u32x4*)(hl32 + row * 1024 + c0), p1 = *(const u32x4*)(hl32 + row * 1024 + c0 + 4); const u32x4 g = *(const u32x4*)(G + row * 4096 + 2048 + c0);
            float y[8];
            y[0] = (bflo(p0.x) + bfhi(p0.x) * cr[0]) * bflo(g.x); y[1] = (bflo(p0.y) + bfhi(p0.y) * cr[1]) * bfhi(g.x); y[2] = (bflo(p0.z) + bfhi(p0.z) * cr[2]) * bflo(g.y); y[3] = (bflo(p0.w) + bfhi(p0.w) * cr[3]) * bfhi(g.y);
            y[4] = (bflo(p1.x) + bfhi(p1.x) * cr[4]) * bflo(g.z); y[5] = (bflo(p1.y) + bfhi(p1.y) * cr[5]) * bfhi(g.z); y[6] = (bflo(p1.z) + bfhi(p1.z) * cr[6]) * bflo(g.w); y[7] = (bflo(p1.w) + bfhi(p1.w) * cr[7]) * bfhi(g.w);
            *(u32x4*)(mix + row * 4096 + 2048 + c0) = (u32x4){pk2(y[0], y[1]), pk2(y[2], y[3]), pk2(y[4], y[5]), pk2(y[6], y[7])}; }
    }
}
template <bool FINAL> DI void lru_phase(const Frame& F, int layer) {
    int u0, ustep, uend;
    if (F.G == 256) { if (F.bid < 192) { u0 = F.bid; ustep = 192; uend = 576; } else { u0 = 576 + (F.bid - 192); ustep = 64; uend = 1024; } }
    else { u0 = F.bid; ustep = F.G; uend = 1024; }
    f32x4 raw[5]; int nprev = -1;
    if (u0 < uend) lru_load_raw(wsp<float>(F, WS_CU), F.tid, u0 >> 9, (u0 >> 4) & 31, u0 & 15, raw);
    for (int u = u0; u < uend; u += ustep) { const int un = u + ustep, n = u & 15;
        lru_unit<FINAL>(F, layer, u >> 9, (u >> 4) & 31, n, raw, un < uend && (un & 15) == n, un >> 9, (un >> 4) & 31, n != nprev);
        if (un < uend && (un & 15) != n) lru_load_raw(wsp<float>(F, WS_CU), F.tid, un >> 9, (un >> 4) & 31, un & 15, raw);
        nprev = n; }
}

DI float wave_sum(float v) {
#pragma unroll
    for (int o = 1; o < 64; o <<= 1) v += __shfl_xor(v, o);
    return v;
}
DI void ln_phase(const Frame& F, int layer, bool last) {
    const float* z = wsp<float>(F, WS_Z); bf16* xb = wsp<bf16>(F, WS_XB); f32x2* st = wsp<f32x2>(F, WS_XN);
    const float* g = inp<float>(F, I_LNG) + (size_t)layer * D; const float* bb = inp<float>(F, I_LNB) + (size_t)layer * D;
    const int lane = F.lane;
    for (int row = F.bid * NWAVES + F.wave; row < M; row += F.G * NWAVES) {
        const f32x4* zr = (const f32x4*)(z + (size_t)row * D) + lane;
        f32x4 v[16]; float s = 0.f;
#pragma unroll
        for (int j = 0; j < 16; ++j) { v[j] = zr[64 * j]; s += (v[j][0] + v[j][1]) + (v[j][2] + v[j][3]); }
        const float mean = wave_sum(s) * (1.0f / D); float s2 = 0.f;
#pragma unroll
        for (int j = 0; j < 16; ++j) { v[j] = v[j] - mean; s2 += (v[j][0] * v[j][0] + v[j][1] * v[j][1]) + (v[j][2] * v[j][2] + v[j][3] * v[j][3]); }
        const float rstd = 1.0f / sqrtf(wave_sum(s2) * (1.0f / D) + LN_EPS);
        if (!last && lane == 0) st[row] = (f32x2){mean, rstd};
#pragma unroll
        for (int j = 0; j < 16; ++j) { const int col = 4 * (lane + 64 * j); const f32x4 gg = *(const f32x4*)(g + col), b4 = *(const f32x4*)(bb + col);
            const f32x4 y = v[j] * rstd * gg + b4;
            if (last) *(f32x4*)(F.out + (size_t)row * D + col) = y;
            else *(u32x2*)(xb + (size_t)row * D + col) = (u32x2){pk2(y[0], y[1]), pk2(y[2], y[3])}; }
    }
}

constexpr int NPH = 1 + 5 * DEPTH;
struct Args { const void* in[20]; float* out; unsigned char* ws; int ph_lo, ph_hi; };
static_assert(sizeof(Args) == 20 * 8 + 8 + 8 + 8, "Args has no padding bytes");

DI Frame make_frame(LAS unsigned char* lds, float* out, unsigned char* ws) {
    Frame F; F.lds = lds;
    int t = threadIdx.x; asm volatile("" : "+v"(t)); F.tid = t; F.lane = t & 63; F.wave = __builtin_amdgcn_readfirstlane(t >> 6);
    int b = blockIdx.x, g = gridDim.x; asm volatile("" : "+s"(b), "+s"(g)); F.bid = b; F.G = g;
    F.out = out; F.ws = ws;
    return F;
}
__global__ void __launch_bounds__(NTHR, 2) hybrid_fwd(Args args) {
    extern __shared__ __attribute__((aligned(16))) unsigned char lds_raw[];
    LAS unsigned char* lds = (LAS unsigned char*)lds_raw;
    volatile LAS unsigned* MISC = (volatile LAS unsigned*)(lds + MISC_OFF);
    for (int u = threadIdx.x; u < (LDS_BYTES - LDSCTL_OFF) / 4; u += NTHR) ((LAS unsigned*)(lds + LDSCTL_OFF))[u] = 0u;
    __syncthreads();
    if (threadIdx.x == 0) { LAS unsigned long long* tb = (LAS unsigned long long*)(lds + PTR_OFF);
#define PUT(k) tb[k] = (unsigned long long)args.in[k];
        PUT(0) PUT(1) PUT(2) PUT(3) PUT(4) PUT(5) PUT(6) PUT(7) PUT(8) PUT(9) PUT(10) PUT(11) PUT(12) PUT(13) PUT(14) PUT(15) PUT(16) PUT(17) PUT(18) PUT(19)
#undef PUT
    }
    __syncthreads();
    XcdBarrier bar; bar.bar = (unsigned*)(args.ws + WS_CTL) + CW_BAR; bar.x = 0; bar.st = nullptr;
    if (MK_N_LAUNCHES == 1) bar = xcd_barrier_post((unsigned*)(args.ws + WS_CTL) + CW_BAR, MISC + 8);
#define GRID_BAR() do { if (MK_N_LAUNCHES == 1) xcd_barrier(bar); } while (0)
#define FRAME() const Frame F = make_frame(lds, args.out, args.ws)
    const int lo = args.ph_lo, hi = args.ph_hi;
#define IN(k) (lo <= (k) && (k) < hi)
#define BOTH(k) (IN(k) && IN((k) + 1))

    if (EN(0) && IN(0)) REPS(0) { FRAME(); p0_prologue(F); }
    if (BOTH(0)) GRID_BAR();

    for (int l = 0; l < DEPTH; ++l) {
        const int base = 1 + 5 * l;
        if (IN(base)) {
            const int GA = (l + 1 < DEPTH) ? (int)gridDim.x - 32 : (int)gridDim.x;
            if ((int)blockIdx.x < GA) {
            if (EN(1)) REPS(1) { FRAME(); pg8::Gemm g{wsp<bf16>(F, WS_XB), wsp<bf16>(F, WS_WIN + (size_t)l * SZ_WIN), D, D, D}; pg8::TileOrder So; So.init(M / 256, NT_IN, GA, F.bid);
              EpiA E{F.ws};
              pg8::gemm_phase<EpiA, pg8::TileOrder, true, true>(F.lds, g, So, E); }
            if (EN(2)) REPS(2) { FRAME(); const int r5 = (M / 256) * NT_IN - 5 * GA;
              pg8::Gemm g{wsp<bf16>(F, WS_MEMB), wsp<bf16>(F, WS_WMKV + (size_t)l * SZ_WMKV), D, D, D}; pg8::TileOrder So; So.init(2, 8, GA, (F.bid + GA - r5) % GA);
              EpiMemKV E{F.ws};
              pg8::gemm_phase<EpiMemKV, pg8::TileOrder, true, true>(F.lds, g, So, E); }
            } else if (EN(14)) { FRAME(); if (l == 0) { conv_layer(F, 0, GA, I_IN, I_IN + I_O + I_UQ + I_UKV); conv_layer(F, 0, GA, I_IN + I_O + I_UQ + I_UKV + 2 * I_MK, I_LAYER); } conv_layer(F, l + 1, GA, 0, I_LAYER); }
        }
        if (BOTH(base)) GRID_BAR();
        if (IN(base + 1)) {
            if (EN(3)) REPS(3) { FRAME(); pg8::Gemm g{wsp<bf16>(F, WS_CQ), wsp<bf16>(F, WS_WUQ + (size_t)l * SZ_WUQ), 1024, 1024, 1024}; pg8::TileOrder So; So.init(M / 256, 6, F.G, F.bid);
              EpiUQ E{F.ws};
              pg8::gemm_phase<EpiUQ, pg8::TileOrder, true, true>(F.lds, g, So, E); }
            if (EN(4)) REPS(4) { FRAME(); pg8::Gemm g{wsp<bf16>(F, WS_CKV), wsp<bf16>(F, WS_WUKV + (size_t)l * SZ_WUKV), 512, 512, 512}; pg8::TileOrder So; So.init(M / 256, 8, F.G, F.bid);
              EpiUKV E{F.ws};
              pg8::gemm_phase<EpiUKV, pg8::TileOrder, true, true>(F.lds, g, So, E); }
            if (EN(5)) REPS(5) { FRAME(); idx_phase(F); }
            if (EN(6)) REPS(6) { FRAME(); mem_phase(F); }
            if (EN(7)) REPS(7) { FRAME(); lru_phase<false>(F, l); }
        }
        if (BOTH(base + 1)) GRID_BAR();
        if (IN(base + 2)) { if (EN(8)) REPS(8) { FRAME(); mla_phase(F); } if (EN(11)) REPS(11) { FRAME(); dsa_phase(F); } if (EN(10)) REPS(10) { FRAME(); lru_final_phase(F); } }
        if (BOTH(base + 2)) GRID_BAR();
        if (EN(12) && IN(base + 3)) REPS(12) {
            FRAME(); pg8::Gemm g{wsp<bf16>(F, WS_MIX), wsp<bf16>(F, WS_WO + (size_t)l * SZ_WO), D, D, D}; pg8::TileOrder So; So.init(M / 256, D / 256, F.G, F.bid);
            EpiO E{l == 0 ? inp<float>(F, I_X) : nullptr, inp<float>(F, I_LNG) + (size_t)(l > 0 ? l - 1 : 0) * D, inp<float>(F, I_LNB) + (size_t)(l > 0 ? l - 1 : 0) * D, F.ws};
            pg8::gemm_phase<EpiO, pg8::TileOrder, true, true>(F.lds, g, So, E);
        }
        if (BOTH(base + 3)) GRID_BAR();
        if (EN(13) && IN(base + 4)) REPS(13) { FRAME(); ln_phase(F, l, l == DEPTH - 1); }
        if (BOTH(base + 4)) GRID_BAR();
    }
#undef IN
#undef BOTH
}

extern "C" void kernel_launch(void* const* d_in, const int* in_sizes, int n_in, void* d_out, int out_size, void* d_ws, size_t ws_size, hipStream_t stream) {
    static int grid = 0;
    if (grid == 0) {
        if (n_in != 20 || out_size != M * D || ws_size < WS_END) { fprintf(stderr, "kernel_launch: unexpected shapes (n_in %d, out %d, ws %zu, need %zu)\n", n_in, out_size, ws_size, (size_t)WS_END); grid = -1; return; }
        int dev = 0, cus = 0, per_cu = 0;
        if (hipGetDevice(&dev) != hipSuccess || hipDeviceGetAttribute(&cus, hipDeviceAttributeMultiprocessorCount, dev) != hipSuccess) { grid = -1; return; }
        if (hipFuncSetAttribute((const void*)hybrid_fwd, hipFuncAttributeMaxDynamicSharedMemorySize, LDS_BYTES) != hipSuccess) { fprintf(stderr, "kernel_launch: hipFuncSetAttribute failed\n"); grid = -1; return; }
        if (hipOccupancyMaxActiveBlocksPerMultiprocessor(&per_cu, (const void*)hybrid_fwd, NTHR, LDS_BYTES) != hipSuccess || per_cu < 1) fprintf(stderr, "kernel_launch: occupancy query reports %d\n", per_cu);
        (void)hipGetLastError();
        grid = cus;
    }
    if (grid < 0) return;
    if (hipMemsetAsync((char*)d_ws + WS_CTL, 0, CTL_ZERO_BYTES, stream) != hipSuccess) return;
    Args a{};
    for (int i = 0; i < 20; ++i) a.in[i] = d_in[i];
    a.out = (float*)d_out; a.ws = (unsigned char*)d_ws;
#if MK_N_LAUNCHES == 1
    a.ph_lo = 0; a.ph_hi = NPH;
    hipLaunchKernelGGL(hybrid_fwd, dim3(grid), dim3(NTHR), LDS_BYTES, stream, a);
#else
    for (int p = 0; p < NPH; ++p) { a.ph_lo = p; a.ph_hi = p + 1; hipLaunchKernelGGL(hybrid_fwd, dim3(grid), dim3(NTHR), LDS_BYTES, stream, a); }
#endif
}
```

```cpp
#include <hip/hip_runtime.h>
#include <cstdio>
#include <cstdint>

#ifndef MK_N_LAUNCHES
#define MK_N_LAUNCHES 1
#endif

#ifndef EN_MASK
#define EN_MASK 0xFFFF
#endif
#define EN(k) (((EN_MASK) >> (k)) & 1)
#ifndef REP_MASK
#define REP_MASK 0
#endif
#define REPS(k) for (int rep_ = 0; rep_ < ((((REP_MASK) >> (k)) & 1) ? 2 : 1); ++rep_)
#define DI __device__ __forceinline__
#define LAS __attribute__((address_space(3)))
#define GAS __attribute__((address_space(1)))
typedef unsigned short bf16;
typedef unsigned short bf16_t;
typedef short bf16x8 __attribute__((ext_vector_type(8)));
typedef short s16x4 __attribute__((ext_vector_type(4)));
typedef float f32x4 __attribute__((ext_vector_type(4)));
typedef float f32x2 __attribute__((ext_vector_type(2)));
typedef float f32x16 __attribute__((ext_vector_type(16)));
typedef unsigned u32x4 __attribute__((ext_vector_type(4)));
typedef unsigned u32x2 __attribute__((ext_vector_type(2)));
typedef __bf16 bf16v2 __attribute__((ext_vector_type(2)));
#define MFMA32(a, b, c) __builtin_amdgcn_mfma_f32_32x32x16_bf16((a), (b), (c), 0, 0, 0)

DI unsigned pk2(float lo, float hi) { f32x2 v = {lo, hi}; bf16v2 b = __builtin_convertvector(v, bf16v2); return __builtin_bit_cast(unsigned, b); }
DI bf16 f2bf(float f) { return (bf16)(pk2(f, 0.f) & 0xffffu); }
DI float bf2f(unsigned short b) { return __builtin_bit_cast(float, ((unsigned)b) << 16); }
DI float bflo(unsigned w) { return __builtin_bit_cast(float, w << 16); }
DI float bfhi(unsigned w) { return __builtin_bit_cast(float, w & 0xffff0000u); }
DI u32x4 pack8(f32x4 a, f32x4 b) { u32x4 w; w.x = pk2(a[0], a[1]); w.y = pk2(a[2], a[3]); w.z = pk2(b[0], b[1]); w.w = pk2(b[2], b[3]); return w; }
DI float frcp(float x) { return __builtin_amdgcn_rcpf(x); }
DI float silu_f(float x) { return x * frcp(1.0f + __expf(-x)); }
DI float ex2(float x) { return __builtin_amdgcn_exp2f(x); }
DI float xhalf_max(float v) { const unsigned b = __builtin_bit_cast(unsigned, v); auto r = __builtin_amdgcn_permlane32_swap(b, b, false, false); return fmaxf(__builtin_bit_cast(float, (unsigned)r[0]), __builtin_bit_cast(float, (unsigned)r[1])); }
DI float max3_asm(float a, float b, float c) { float r; asm("v_max3_f32 %0, %1, %2, %3" : "=v"(r) : "v"(a), "v"(b), "v"(c)); return r; }
DI float max_asm(float a, float b) { float r; asm("v_max_f32 %0, %1, %2" : "=v"(r) : "v"(a), "v"(b)); return r; }
DI float xhalf_max_asm(float v) { const unsigned b = __builtin_bit_cast(unsigned, v); auto r = __builtin_amdgcn_permlane32_swap(b, b, false, false); return max_asm(__builtin_bit_cast(float, (unsigned)r[0]), __builtin_bit_cast(float, (unsigned)r[1])); }
template <int V> struct IC { static constexpr int value = V; constexpr operator int() const { return V; } };
DI float xhalf_sum(float v) { const unsigned b = __builtin_bit_cast(unsigned, v); auto r = __builtin_amdgcn_permlane32_swap(b, b, false, false); return __builtin_bit_cast(float, (unsigned)r[0]) + __builtin_bit_cast(float, (unsigned)r[1]); }

namespace pg8 {
#define PG8_LAS __attribute__((address_space(3)))
constexpr int BM = 256, BK = 64, HALF = 128, HTB = HALF * BK * 2  , STAGE_BYTES = 8 * HTB, NXCD = 8, WGM = 8;

__host__ __device__ __forceinline__ int lds_byte(int r, int c) { const int st = (r >> 4) * 2 + (c >> 5), rr = r & 15, cc = c & 31, ob = rr * 64 + cc * 2; return st * 1024 + (ob ^ (((ob >> 9) & 1) << 5)); }
__host__ __device__ __forceinline__ void stage_rc(int b, int& R, int& C) { const int st = b / 1024, sb = b % 1024, swz = sb ^ (((sb >> 9) & 1) << 5); R = (st >> 1) * 16 + swz / 64; C = (st & 1) * 32 + (swz % 64) / 2; }
__host__ __device__ __forceinline__ int perm32(int rho) { const int n = rho >> 4, i = rho & 15; return 8 * (i >> 2) + 4 * n + (i & 3); }

struct Unit { int pm, pn; };
struct Gemm { const bf16_t* A; const bf16_t* Bt; int K, lda, ldb; };

struct TileOrder {
    int nM, nN, nwg, G, c;
    __device__ __forceinline__ void init(int nM_, int nN_, int G_, int c_) { nM = nM_; nN = nN_; nwg = nM * nN; G = G_; c = c_; }
    __device__ __forceinline__ bool next(int i, Unit& u) const {
        const long L = (long)i * G + c; if (L >= nwg) return false;
        int wgid = (int)L; { const int q = nwg / NXCD, r = nwg % NXCD, xcd = wgid % NXCD, off = wgid / NXCD; wgid = (xcd < r ? xcd * (q + 1) : r * (q + 1) + (xcd - r) * q) + off; }
        const int nig = WGM * nN, gid = wgid / nig, fm = gid * WGM, gsz = (nM - fm) < WGM ? (nM - fm) : WGM;
        u.pm = fm + ((wgid % nig) % gsz); u.pn = (wgid % nig) / gsz; return true;
    }
    __device__ __forceinline__ void a_ready(const Unit&) const {}
    __device__ __forceinline__ void done(const Unit&) const {}
};
template <class Epi, class Sched, bool ALIGN_EPI = false, bool SP2 = false>
__device__ __forceinline__ void gemm_phase(PG8_LAS unsigned char* lds, const Gemm g, const Sched& S, const Epi& E) {
    int tid_ = threadIdx.x; asm volatile("" : "+v"(tid_));
    const int tid = tid_, wid = __builtin_amdgcn_readfirstlane(tid >> 6), lane = tid & 63, wr = wid >> 2, wc = wid & 3, fr = lane & 15, fq = lane >> 4;
    const int K = g.K, nt = K / BK;
    unsigned voffA[2], voffB[2];
#pragma unroll
    for (int i = 0; i < 2; ++i) { int R, C; stage_rc(tid * 16 + i * 8192, R, C); const int Rb = Epi::PERM ? ((R & ~31) + perm32(R & 31)) : R;
        voffA[i] = (unsigned)(R * g.lda + C) * 2u; voffB[i] = (unsigned)(Rb * g.ldb + C) * 2u; }
    const size_t kstep = (size_t)(BK * 2);
    const size_t hstepA = (size_t)HALF * g.lda * 2, hstepB = (size_t)HALF * g.ldb * 2;
    const size_t tstepA = 2 * hstepA, tstepB = 2 * hstepB;
    const unsigned ldsw = (unsigned)wid * 1024u;
    const int aoff = lds_byte(wr * 64 + fr, fq * 8), boff = lds_byte(wc * 32 + fr, fq * 8);
#define PG8_SA(b, h) (((b) * 2 + (h)) * HTB)
#define PG8_SB(b, h) ((4 + (b) * 2 + (h)) * HTB)
#define PG8_STAGE(bufoff, gbase, voff) do { _Pragma("unroll") for (int _i = 0; _i < 2; ++_i) \
        __builtin_amdgcn_global_load_lds((const unsigned*)((const char*)(gbase) + (voff)[_i]), (PG8_LAS unsigned*)(lds + (bufoff) + ldsw + _i * 8192), 16, 0, 0); } while (0)
#define PG8_LDA(dst, b, h) do { _Pragma("unroll") for (int m = 0; m < 4; ++m) _Pragma("unroll") for (int k = 0; k < 2; ++k) dst[m][k] = *(const PG8_LAS bf16x8*)(lds + PG8_SA(b, h) + aoff + m * 2048 + k * 1024); } while (0)
#define PG8_LDB(dst, b, h) do { _Pragma("unroll") for (int n = 0; n < 2; ++n) _Pragma("unroll") for (int k = 0; k < 2; ++k) dst[n][k] = *(const PG8_LAS bf16x8*)(lds + PG8_SB(b, h) + boff + n * 2048 + k * 1024); } while (0)
#define PG8_MMA(ai, bj, At, Bt) do { __builtin_amdgcn_s_setprio(1); _Pragma("unroll") for (int m = 0; m < 4; ++m) _Pragma("unroll") for (int n = 0; n < 2; ++n) _Pragma("unroll") for (int k = 0; k < 2; ++k) \
        acc[ai][bj][m][n] = __builtin_amdgcn_mfma_f32_16x16x32_bf16(Bt[n][k], At[m][k], acc[ai][bj][m][n], 0, 0, 0); __builtin_amdgcn_s_setprio(0); } while (0)
#define PG8_WAIT_V(n) asm volatile("s_waitcnt vmcnt(" #n ")" ::: "memory")
#define PG8_WAIT_L(n) asm volatile("s_waitcnt lgkmcnt(" #n ")" ::: "memory")
#define PG8_BAR __builtin_amdgcn_s_barrier()
#define PG8_SCHED __builtin_amdgcn_sched_barrier(0)
    Unit cur, nxt; int ui = 0;
    if (!S.next(0, cur)) return;
    f32x4 acc[2][2][4][2];
#pragma unroll
    for (int a = 0; a < 2; ++a)
#pragma unroll
        for (int b = 0; b < 2; ++b)
#pragma unroll
            for (int m = 0; m < 4; ++m)
#pragma unroll
                for (int n = 0; n < 2; ++n) acc[a][b][m][n] = (f32x4){0.f, 0.f, 0.f, 0.f};
    bf16x8 At[4][2], B0[2][2], B1[2][2];
    const char* cA = (const char*)g.A + (size_t)cur.pm * tstepA; const char* cB = (const char*)g.Bt + (size_t)cur.pn * tstepB;
    S.a_ready(cur);
    if constexpr (SP2) {
        PG8_STAGE(PG8_SB(0, 0), cB, voffB); PG8_STAGE(PG8_SB(0, 1), cB + hstepB, voffB); PG8_STAGE(PG8_SA(0, 0), cA, voffA); PG8_STAGE(PG8_SA(0, 1), cA + hstepA, voffA);
        if (wr == 1) PG8_BAR;
        PG8_WAIT_V(2); PG8_BAR;
        PG8_STAGE(PG8_SB(1, 0), cB + kstep, voffB); PG8_STAGE(PG8_SA(1, 0), cA + kstep, voffA); PG8_STAGE(PG8_SB(1, 1), cB + hstepB + kstep, voffB);
        PG8_WAIT_V(6); PG8_BAR;
    } else {
        PG8_STAGE(PG8_SB(0, 0), cB, voffB); PG8_STAGE(PG8_SA(0, 0), cA, voffA); PG8_STAGE(PG8_SB(0, 1), cB + hstepB, voffB); PG8_STAGE(PG8_SA(0, 1), cA + hstepA, voffA);
        if (wr == 1) PG8_BAR;
        PG8_WAIT_V(4); PG8_BAR;
        PG8_STAGE(PG8_SB(1, 0), cB + kstep, voffB); PG8_STAGE(PG8_SA(1, 0), cA + kstep, voffA); PG8_STAGE(PG8_SB(1, 1), cB + hstepB + kstep, voffB);
        PG8_WAIT_V(6); PG8_BAR;
    }
    for (;;) {
        const bool has_next = S.next(ui + 1, nxt);
        const char* nA = has_next ? (const char*)g.A + (size_t)nxt.pm * tstepA : cA; const char* nB = has_next ? (const char*)g.Bt + (size_t)nxt.pn * tstepB : cB;
        for (int t = 0; t < nt; t += 2) {
            const bool last = (t == nt - 2);
            const char* a1 = cA + (size_t)(t + 1) * kstep;
            const char* a2 = last ? nA : cA + (size_t)(t + 2) * kstep; const char* b2 = last ? nB : cB + (size_t)(t + 2) * kstep;
            const char* a3 = a2 + kstep; const char* b3 = b2 + kstep;
            if (last && has_next) S.a_ready(nxt);
            if constexpr (SP2) {
            PG8_LDB(B0, 0, 0); PG8_LDB(B1, 0, 1); PG8_SCHED; PG8_LDA(At, 0, 0); PG8_STAGE(PG8_SA(1, 1), a1 + hstepA, voffA);
            PG8_WAIT_V(8); PG8_WAIT_L(0); PG8_BAR; PG8_MMA(0, 0, At, B0); PG8_MMA(0, 1, At, B1); PG8_BAR; PG8_SCHED;
            PG8_LDA(At, 0, 1); PG8_STAGE(PG8_SB(0, 0), b2, voffB); PG8_STAGE(PG8_SB(0, 1), b2 + hstepB, voffB); PG8_STAGE(PG8_SA(0, 0), a2, voffA);
            PG8_WAIT_V(8); PG8_WAIT_L(0); PG8_BAR; PG8_MMA(1, 0, At, B0); PG8_MMA(1, 1, At, B1); PG8_BAR; PG8_SCHED;
            PG8_LDB(B0, 1, 0); PG8_LDB(B1, 1, 1); PG8_SCHED; PG8_LDA(At, 1, 0); PG8_STAGE(PG8_SA(0, 1), a2 + hstepA, voffA);
            PG8_WAIT_V(8); PG8_WAIT_L(0); PG8_BAR; PG8_MMA(0, 0, At, B0); PG8_MMA(0, 1, At, B1); PG8_BAR; PG8_SCHED;
            PG8_LDA(At, 1, 1); PG8_STAGE(PG8_SB(1, 0), b3, voffB); PG8_STAGE(PG8_SB(1, 1), b3 + hstepB, voffB); PG8_STAGE(PG8_SA(1, 0), a3, voffA);
            PG8_WAIT_V(8); PG8_WAIT_L(0); PG8_BAR; PG8_MMA(1, 0, At, B0); PG8_MMA(1, 1, At, B1); PG8_BAR; PG8_SCHED;
            } else {
            PG8_LDB(B0, 0, 0); PG8_SCHED; PG8_LDA(At, 0, 0); PG8_STAGE(PG8_SA(1, 1), a1 + hstepA, voffA);
            PG8_WAIT_L(8); PG8_BAR; PG8_WAIT_L(0); PG8_MMA(0, 0, At, B0); PG8_BAR; PG8_SCHED;
            PG8_LDB(B1, 0, 1); PG8_STAGE(PG8_SB(0, 0), b2, voffB);
            PG8_BAR; PG8_WAIT_L(0); PG8_MMA(0, 1, At, B1); PG8_BAR;
            PG8_LDA(At, 0, 1); PG8_STAGE(PG8_SA(0, 0), a2, voffA);
            PG8_BAR; PG8_WAIT_L(0); PG8_MMA(1, 0, At, B0); PG8_BAR; PG8_SCHED;
            PG8_STAGE(PG8_SB(0, 1), b2 + hstepB, voffB);
            PG8_WAIT_V(6); PG8_BAR; PG8_MMA(1, 1, At, B1); PG8_BAR;
            PG8_LDB(B0, 1, 0); PG8_SCHED; PG8_LDA(At, 1, 0); PG8_STAGE(PG8_SA(0, 1), a2 + hstepA, voffA);
            PG8_WAIT_L(8); PG8_BAR; PG8_WAIT_L(0); PG8_MMA(0, 0, At, B0); PG8_BAR; PG8_SCHED;
            PG8_LDB(B1, 1, 1); PG8_STAGE(PG8_SB(1, 0), b3, voffB);
            PG8_BAR; PG8_WAIT_L(0); PG8_MMA(0, 1, At, B1); PG8_BAR;
            PG8_LDA(At, 1, 1); PG8_STAGE(PG8_SA(1, 0), a3, voffA);
            PG8_BAR; PG8_WAIT_L(0); PG8_MMA(1, 0, At, B0); PG8_BAR; PG8_SCHED;
            PG8_STAGE(PG8_SB(1, 1), b3 + hstepB, voffB);
            PG8_WAIT_V(6); PG8_BAR; PG8_MMA(1, 1, At, B1); PG8_BAR;
            }
        }
        if constexpr (ALIGN_EPI) { if (wr == 0) PG8_BAR; }
        if constexpr (!Epi::AFTER_DRAIN) { E(acc, cur, wr, wc, fr, fq); S.done(cur); }
        if (!has_next) break;
#pragma unroll
        for (int a = 0; a < 2; ++a)
#pragma unroll
            for (int b = 0; b < 2; ++b)
#pragma unroll
                for (int m = 0; m < 4; ++m)
#pragma unroll
                    for (int n = 0; n < 2; ++n) acc[a][b][m][n] = (f32x4){0.f, 0.f, 0.f, 0.f};
        cur = nxt; cA = nA; cB = nB; ++ui;
        if constexpr (ALIGN_EPI) { if (wr == 1) PG8_BAR; }
    }
    PG8_WAIT_V(0);
    if constexpr (!ALIGN_EPI) { if (wr == 0) PG8_BAR; }
    PG8_BAR;
    if constexpr (Epi::AFTER_DRAIN) { E.fused(acc, cur, wr, wc, fr, fq, lds, wid, lane); S.done(cur); }
#undef PG8_SA
#undef PG8_SB
#undef PG8_STAGE
#undef PG8_LDA
#undef PG8_LDB
#undef PG8_MMA
#undef PG8_WAIT_V
#undef PG8_WAIT_L
#undef PG8_BAR
#undef PG8_SCHED
}
}


constexpr int NB = 2, S = 4096, M = NB * S, D = 4096, DEPTH = 4, NMEM = 256;
constexpr int DIN = 10384, NT_IN = 41, NPAD = NT_IN * 256;
constexpr float LN_EPS = 1e-5f, RMS_EPS = 1e-6f;
constexpr float ALPHA = 1.681792830507429f;
constexpr float LOG2E = 1.4426950408889634f;
constexpr float QS_MLA = 0.07216878364870322f * LOG2E;
constexpr float QS_DSA = 0.08838834764831845f * LOG2E;
constexpr float QS_MEM = 0.0625f * LOG2E;
constexpr int NWAVES = 8, NTHR = 512;

constexpr size_t MiB = 1u << 20;
constexpr size_t WS_CTL = 0, CTL_ZERO_BYTES = 1 * MiB;
constexpr size_t SZ_WIN = (size_t)NPAD * D * 2, SZ_WO = (size_t)D * D * 2, SZ_WUQ = (size_t)1536 * 1024 * 2, SZ_WUKV = (size_t)2048 * 512 * 2,
                 SZ_WMKV = (size_t)2048 * 4096 * 2, SZ_WG = (size_t)16 * 64 * 64 * 2;
constexpr size_t WS_WIN = 1 * MiB;
constexpr size_t WS_WO = WS_WIN + DEPTH * SZ_WIN;
constexpr size_t WS_WUQ = WS_WO + DEPTH * SZ_WO;
constexpr size_t WS_WUKV = WS_WUQ + DEPTH * SZ_WUQ;
constexpr size_t WS_WMKV = WS_WUKV + DEPTH * SZ_WUKV;
constexpr size_t WS_WA = WS_WMKV + DEPTH * SZ_WMKV;
constexpr size_t WS_WX = WS_WA + DEPTH * SZ_WG;
constexpr size_t WS_ACT = ((WS_WX + DEPTH * SZ_WG + MiB - 1) / MiB) * MiB;
constexpr size_t WS_XB = WS_ACT;
constexpr size_t WS_XN = WS_XB + (size_t)M * D * 2;
constexpr size_t WS_HL = WS_XN + MiB;
constexpr size_t WS_Z = WS_XN + (size_t)M * D * 4;
constexpr size_t WS_MEMB = WS_Z + (size_t)M * D * 4;
constexpr size_t WS_CQ = WS_MEMB + (size_t)512 * D * 2;
constexpr size_t WS_CKV = WS_CQ + (size_t)M * 1024 * 2;
constexpr size_t WS_G = WS_CKV + (size_t)M * 512 * 2;
constexpr size_t WS_BQ = WS_G + (size_t)M * 4096 * 2;
constexpr size_t WS_BK = WS_BQ + (size_t)M * 1024 * 2;
constexpr size_t WS_VTD = WS_BK + (size_t)M * 256 * 2;
constexpr size_t WS_QI = WS_VTD + (size_t)M * 256 * 2;
constexpr size_t WS_KI = WS_QI + (size_t)M * 1024 * 2;
constexpr size_t WS_WI = WS_KI + (size_t)M * 64 * 2;
constexpr size_t WS_CU = WS_WI + (size_t)M * 16 * 4;
constexpr size_t WS_DQ = WS_CU + (size_t)M * 1024 * 4;
constexpr size_t WS_SMALL = WS_DQ + (size_t)M * 1024 * 2;
constexpr size_t WS_SSQ = WS_SMALL + (size_t)M * 256 * 4;
constexpr size_t WS_SSKV = WS_SSQ + (size_t)M * 16 * 4;
constexpr size_t WS_QM = WS_SSKV + (size_t)M * 8 * 4;
constexpr size_t WS_KM = WS_QM + (size_t)M * 1536 * 2;
constexpr size_t WS_VTM = WS_KM + (size_t)M * 1536 * 2;
constexpr size_t WS_SC = WS_VTM + (size_t)M * 1024 * 2;
constexpr size_t WS_MASK = WS_SC + (size_t)NB * S * S * 4;
constexpr size_t WS_MIX = WS_MASK + (size_t)M * 128 * 4;
constexpr size_t WS_LSUM = WS_MIX + (size_t)M * 4096 * 2;
constexpr size_t WS_KMEM = WS_LSUM + (size_t)NB * 32 * 1024 * 8;
constexpr size_t WS_VTMEM = WS_KMEM + (size_t)512 * 1024 * 2;
constexpr size_t WS_CSM = WS_VTMEM + (size_t)512 * 1024 * 2;
constexpr size_t WS_CSD = WS_CSM + (size_t)M * 32 * 8;
constexpr size_t WS_CSI = WS_CSD + (size_t)M * 16 * 8;
constexpr size_t WS_END = WS_CSI + (size_t)M * 8 * 8;
constexpr int CW_BAR = 4096;

constexpr int RING_BYTES = 131072;
constexpr int LDSCTL_OFF = RING_BYTES, MISC_OFF = LDSCTL_OFF + 320;
constexpr int LDS_BYTES = 147456;

#define LDS_WAIT() asm volatile("s_waitcnt lgkmcnt(0)" ::: "memory")
#define VM_WAIT() asm volatile("s_waitcnt vmcnt(0)" ::: "memory")

#define XB_TMO      128
#define XB_XCNT(j)  (256  + 64 * (j))
#define XB_XSUB(j)  (1280 + 64 * (j))
#define XB_XGEN(j)  (2304 + 64 * (j))
#define XB_TOP      3328
#define XB_TOPGEN   3392
#define XCD_BAR_WORDS 3456
#define XB_SPIN_CAP (1u << 18)

__device__ __forceinline__ unsigned xb_ld(unsigned* p)              { return __hip_atomic_load(p, __ATOMIC_RELAXED, __HIP_MEMORY_SCOPE_AGENT); }
__device__ __forceinline__ unsigned xb_add(unsigned* p, unsigned v) { return __hip_atomic_fetch_add(p, v, __ATOMIC_RELAXED, __HIP_MEMORY_SCOPE_AGENT); }
__device__ __forceinline__ unsigned xb_xcc_id() { return (unsigned)__builtin_amdgcn_s_getreg((3 << 11) | 20) & 0xFu; }
#define XB_SPIN(cond, bar) do { unsigned _sp = 0; while (cond) { __builtin_amdgcn_s_sleep(1); \
    if ((++_sp & 255u) == 0u) { if (xb_ld(&(bar)[XB_TMO])) break; if (_sp > XB_SPIN_CAP) { atomicAdd(&(bar)[XB_TMO], 1u); break; } } } } while (0)

struct XcdBarrier {
    unsigned* bar; unsigned x;
    volatile LAS unsigned* st;
};

__device__ __forceinline__ XcdBarrier xcd_barrier_post(unsigned* bar, volatile LAS unsigned* st) {
    XcdBarrier b; b.bar = bar; b.x = xb_xcc_id(); b.st = st;
    if (threadIdx.x == 0) (void)xb_add(&bar[XB_XCNT(b.x)], 1u);
    return b;
}
__device__ __forceinline__ void xcd_barrier_complete(unsigned* bar, unsigned x, unsigned& nloc, unsigned& nx) {
    const unsigned G = gridDim.x * gridDim.y * gridDim.z;
    unsigned sum, cnt, mine, sp = 0u;
    for (;;) {
        sum = 0u; cnt = 0u; mine = 0u;
#pragma unroll
        for (unsigned j = 0; j < 16; ++j) { const unsigned c = xb_ld(&bar[XB_XCNT(j)]); sum += c; cnt += (c > 0u) ? 1u : 0u; mine = (j == x) ? c : mine; }
        if (sum == G) break;
        __builtin_amdgcn_s_sleep(1);
        if ((++sp & 255u) == 0u) { if (xb_ld(&bar[XB_TMO])) break; if (sp > XB_SPIN_CAP) { atomicAdd(&bar[XB_TMO], 1u); break; } }
    }
    nloc = mine > 0u ? mine : 1u; nx = cnt > 0u ? cnt : 1u;
}

__device__ __forceinline__ void xcd_barrier(const XcdBarrier& b) {
    asm volatile("s_waitcnt vmcnt(0)" ::: "memory");
    __syncthreads();
    if (threadIdx.x == 0) {
        unsigned* bar = b.bar;
        __builtin_amdgcn_s_waitcnt(0);
        unsigned nloc = b.st[0], nx = b.st[1];
        if (nloc == 0u) { xcd_barrier_complete(bar, b.x, nloc, nx); b.st[0] = nloc; b.st[1] = nx; }
        const unsigned old = xb_add(&bar[XB_XSUB(b.x)], 1u);
        const unsigned gen = old / nloc;
        if (old + 1u == (gen + 1u) * nloc) {
            __builtin_amdgcn_fence(__ATOMIC_RELEASE, "agent");
            asm volatile("s_waitcnt vmcnt(0)" ::: "memory");
            const unsigned og = xb_add(&bar[XB_TOP], 1u);
            const unsigned tg = og / nx;
            if (og + 1u == (tg + 1u) * nx) xb_add(&bar[XB_TOPGEN], 1u);
            else XB_SPIN(xb_ld(&bar[XB_TOPGEN]) == tg, bar);
            __builtin_amdgcn_fence(__ATOMIC_ACQUIRE, "agent");
            xb_add(&bar[XB_XGEN(b.x)], 1u);
            asm volatile("s_waitcnt vmcnt(0)" ::: "memory");
        } else {
            XB_SPIN(xb_ld(&bar[XB_XGEN(b.x)]) == gen, bar);
            __builtin_amdgcn_fence(__ATOMIC_ACQUIRE, "agent");
            asm volatile("s_waitcnt vmcnt(0)" ::: "memory");
        }
    }
    __syncthreads();

}

struct Frame {
    LAS unsigned char* lds;
    int tid, lane, wave, G, bid;
    float* out; unsigned char* ws;
};
constexpr int PTR_OFF = LDSCTL_OFF + 1024;
enum { I_X = 0, I_MEM, I_POS, I_WIN, I_GCQ, I_GCKV, I_WUQ, I_WUKV, I_CONVW, I_CONVB, I_WA, I_BA, I_WX, I_BX, I_LAM, I_WMK, I_WMV, I_WO, I_LNG, I_LNB };
template <class T> DI const T* inp(const Frame& F, int k) {
    const unsigned long long v = ((const LAS unsigned long long*)(F.lds + PTR_OFF))[k];
    const unsigned lo = __builtin_amdgcn_readfirstlane((unsigned)v), hi = __builtin_amdgcn_readfirstlane((unsigned)(v >> 32));
    return (const T*)(const GAS T*)(((unsigned long long)hi << 32) | lo);
}
template <class T> DI T* wsp(const Frame& F, size_t off) { return (T*)(F.ws + off); }

DI int ropeperm(int dp, int half) { const int i = dp >> 1; return (dp & 1) ? half + i : i; }
DI int win_src(int nc) {
    const int t = nc >> 8, j = nc & 255;
    if (t < 4) return t * 256 + j;
    if (t < 6) return 1024 + (t - 4) * 256 + j;
    if (t < 10) return 1600 + (t - 6) * 256 + j;
    if (t < 14) { const int c = (t - 10) * 256 + j, hd = c >> 7, dp = c & 127; return 2624 + hd * 128 + (dp < 32 ? ropeperm(dp, 16) : dp); }
    if (t == 14) { const int hd = j >> 7, dp = j & 127; return 3648 + hd * 128 + (dp < 32 ? ropeperm(dp, 16) : dp); }
    if (t == 15) return 3904 + j;
    if (t < 20) { const int c = (t - 16) * 256 + j, hd = c >> 6, dp = c & 63; return 4160 + hd * 64 + (dp < 16 ? ropeperm(dp, 8) : dp); }
    if (t < 24) return 5264 + (t - 20) * 256 + j;
    if (t < 28) return 6288 + (t - 24) * 256 + j;
    if (t < 32) return 7312 + (t - 28) * 256 + j;
    if (t < 36) return 8336 + (t - 32) * 256 + j;
    if (t < 40) return 9360 + (t - 36) * 256 + j;
    if (j < 64) return 1536 + ropeperm(j, 32);
    if (j < 128) { const int dp = j - 64; return 5184 + (dp < 16 ? ropeperm(dp, 8) : dp); }
    if (j < 144) return 5248 + (j - 128);
    return -1;
}
DI int wuq_src(int nc) {
    if (nc < 1024) return (nc >> 7) * 192 + (nc & 127);
    const int r = nc - 1024; return (r >> 6) * 192 + 128 + ropeperm(r & 63, 32);
}
template <int MAP> DI int conv_src(int n) { return (MAP == 1) ? win_src(n) : (MAP == 2) ? wuq_src(n) : n; }
template <int MAP> DI void conv_item(const float* W, int ldw, const float* kscale, bf16* WT, int ldk, int k0, int n0, LAS unsigned char* scr, int lane) {
    const int nq = lane & 15, kq = lane >> 4;
    const int sc0 = conv_src<MAP>(n0 + 4 * nq), sc1 = conv_src<MAP>(n0 + 4 * nq + 1), sc2 = conv_src<MAP>(n0 + 4 * nq + 2), sc3 = conv_src<MAP>(n0 + 4 * nq + 3);
    const bool contig = (sc0 >= 0) && (sc3 == sc0 + 3) && (sc1 == sc0 + 1) && (sc2 == sc0 + 2);
    f32x4 v[16];
    if (contig) {
#pragma unroll
        for (int i = 0; i < 16; ++i) v[i] = __builtin_nontemporal_load((const f32x4*)(W + (size_t)(k0 + 4 * i + kq) * ldw + sc0));
    } else {
#pragma unroll
        for (int i = 0; i < 16; ++i) { const float* wr = W + (size_t)(k0 + 4 * i + kq) * ldw;
            v[i][0] = sc0 >= 0 ? wr[sc0] : 0.f; v[i][1] = sc1 >= 0 ? wr[sc1] : 0.f; v[i][2] = sc2 >= 0 ? wr[sc2] : 0.f; v[i][3] = sc3 >= 0 ? wr[sc3] : 0.f; }
    }
    if (kscale) {
#pragma unroll
        for (int i = 0; i < 16; ++i) v[i] = v[i] * kscale[k0 + 4 * i + kq];
    }
#pragma unroll
    for (int i = 0; i < 16; ++i) { const int k = 4 * i + kq; *(LAS f32x4*)(scr + k * 256 + 16 * (nq ^ ((k >> 3) & 7))) = v[i]; }
    LDS_WAIT(); asm volatile("" ::: "memory");
#pragma unroll
    for (int j = 0; j < 8; ++j) { const int c = lane + 64 * j, n = c >> 3, kc = c & 7;
        const LAS unsigned char* p = scr + 16 * ((n >> 2) ^ kc) + 4 * (n & 3) + (8 * kc) * 256;
        u32x4 o; o.x = pk2(*(const LAS float*)(p), *(const LAS float*)(p + 256)); o.y = pk2(*(const LAS float*)(p + 512), *(const LAS float*)(p + 768));
        o.z = pk2(*(const LAS float*)(p + 1024), *(const LAS float*)(p + 1280)); o.w = pk2(*(const LAS float*)(p + 1536), *(const LAS float*)(p + 1792));
        __builtin_nontemporal_store(o, (u32x4*)(WT + (size_t)(n0 + n) * ldk + k0 + 8 * kc)); }
    LDS_WAIT(); asm volatile("" ::: "memory");
}
constexpr int I_IN = (D / 64) * (NPAD / 64), I_O = (D / 64) * (D / 64), I_UQ = (1024 / 64) * (1536 / 64), I_UKV = (512 / 64) * (2048 / 64), I_MK = (D / 64) * (1024 / 64), I_G = 16;
constexpr int I_LAYER = I_IN + I_O + I_UQ + I_UKV + 2 * I_MK + 2 * I_G;
DI void conv_layer_item(const Frame& F, int l, int r, LAS unsigned char* scr) {
    if (r < I_IN) { const int nb = NPAD / 64; conv_item<1>(inp<float>(F, I_WIN) + (size_t)l * D * DIN, DIN, nullptr, wsp<bf16>(F, WS_WIN + l * SZ_WIN), D, 64 * (r / nb), 64 * (r % nb), scr, F.lane); return; } r -= I_IN;
    if (r < I_O) { const int nb = D / 64; conv_item<0>(inp<float>(F, I_WO) + (size_t)l * D * D, D, nullptr, wsp<bf16>(F, WS_WO + l * SZ_WO), D, 64 * (r / nb), 64 * (r % nb), scr, F.lane); return; } r -= I_O;
    if (r < I_UQ) { const int nb = 1536 / 64; conv_item<2>(inp<float>(F, I_WUQ) + (size_t)l * 1024 * 1536, 1536, inp<float>(F, I_GCQ) + l * 1024, wsp<bf16>(F, WS_WUQ + l * SZ_WUQ), 1024, 64 * (r / nb), 64 * (r % nb), scr, F.lane); return; } r -= I_UQ;
    if (r < I_UKV) { const int nb = 2048 / 64; conv_item<0>(inp<float>(F, I_WUKV) + (size_t)l * 512 * 2048, 2048, inp<float>(F, I_GCKV) + l * 512, wsp<bf16>(F, WS_WUKV + l * SZ_WUKV), 512, 64 * (r / nb), 64 * (r % nb), scr, F.lane); return; } r -= I_UKV;
    if (r < I_MK) { const int nb = 1024 / 64; conv_item<0>(inp<float>(F, I_WMK) + (size_t)l * D * 1024, 1024, nullptr, wsp<bf16>(F, WS_WMKV + l * SZ_WMKV), D, 64 * (r / nb), 64 * (r % nb), scr, F.lane); return; } r -= I_MK;
    if (r < I_MK) { const int nb = 1024 / 64; conv_item<0>(inp<float>(F, I_WMV) + (size_t)l * D * 1024, 1024, nullptr, wsp<bf16>(F, WS_WMKV + l * SZ_WMKV) + (size_t)1024 * D, D, 64 * (r / nb), 64 * (r % nb), scr, F.lane); return; } r -= I_MK;
    if (r < I_G) { conv_item<0>(inp<float>(F, I_WA) + ((size_t)l * 16 + r) * 4096, 64, nullptr, wsp<bf16>(F, WS_WA + l * SZ_WG) + r * 4096, 64, 0, 0, scr, F.lane); return; } r -= I_G;
    conv_item<0>(inp<float>(F, I_WX) + ((size_t)l * 16 + r) * 4096, 64, nullptr, wsp<bf16>(F, WS_WX + l * SZ_WG) + r * 4096, 64, 0, 0, scr, F.lane);
}
DI void conv_layer(const Frame& F, int l, int wg_lo, int it_lo, int it_hi) {
    if (F.bid < wg_lo) return;
    LAS unsigned char* scr = F.lds + F.wave * 16384;
    const int gw = (F.bid - wg_lo) * NWAVES + F.wave, NGW = (F.G - wg_lo) * NWAVES;
    for (int it = it_lo + gw; it < it_hi; it += NGW) conv_layer_item(F, l, it, scr);
}
DI void rope_entry(int pos, int i, int rot, float& c, float& s) {
    const double e = -((double)(2 * i) / (double)rot) * 13.122363377404329;
    const float inv = (float)exp(e);
    const float ang = (float)pos * inv;
    const double a = (double)ang; const double n = rint(a * 0.15915494309189535); const double r = a - n * 6.283185307179586;
    const float rf = (float)r; c = cosf(rf); s = sinf(rf);
}
DI void p0_prologue(const Frame& F) {
    conv_layer(F, 0, 0, 0, I_IN);
    conv_layer(F, 0, 0, I_IN + I_O + I_UQ + I_UKV, I_IN + I_O + I_UQ + I_UKV + 2 * I_MK);
    const int gw = F.bid * NWAVES + F.wave, NGW = F.G * NWAVES; (void)gw; (void)NGW;
    const size_t gt = (size_t)F.bid * NTHR + F.tid, NGT = (size_t)F.G * NTHR;
    { bf16* xb = wsp<bf16>(F, WS_XB); const float* xin = inp<float>(F, I_X); for (size_t i = gt; i < (size_t)M * D / 8; i += NGT) { const f32x4 a = *(const f32x4*)(xin + i * 8), b = *(const f32x4*)(xin + i * 8 + 4); *(u32x4*)(xb + i * 8) = pack8(a, b); } }
    { bf16* mb = wsp<bf16>(F, WS_MEMB); const float* min_ = inp<float>(F, I_MEM); for (size_t i = gt; i < (size_t)512 * D / 8; i += NGT) { const f32x4 a = *(const f32x4*)(min_ + i * 8), b = *(const f32x4*)(min_ + i * 8 + 4); *(u32x4*)(mb + i * 8) = pack8(a, b); } }
    { f32x2* csm = wsp<f32x2>(F, WS_CSM); f32x2* csd = wsp<f32x2>(F, WS_CSD); f32x2* csi = wsp<f32x2>(F, WS_CSI);
      for (size_t i = gt; i < (size_t)M * 56; i += NGT) { const int row = (int)(i / 56), e = (int)(i % 56); const int p = inp<int>(F, I_POS)[row]; float c, s;
          if (e < 32) { rope_entry(p, e, 64, c, s); csm[(size_t)row * 32 + e] = (f32x2){c, s}; }
          else if (e < 48) { rope_entry(p, e - 32, 32, c, s); csd[(size_t)row * 16 + e - 32] = (f32x2){c, s}; }
          else { rope_entry(p, e - 48, 16, c, s); csi[(size_t)row * 8 + e - 48] = (f32x2){c, s}; } } }
}

using pg8::Unit;
DI void rope8(f32x4& v0, f32x4& v1, const f32x2* cs) {
    const f32x4 a = *(const f32x4*)cs, b = *(const f32x4*)(cs + 2);
    float x1, x2;
    x1 = v0[0]; x2 = v0[1]; v0[0] = x1 * a[0] - x2 * a[1]; v0[1] = x2 * a[0] + x1 * a[1];
    x1 = v0[2]; x2 = v0[3]; v0[2] = x1 * a[2] - x2 * a[3]; v0[3] = x2 * a[2] + x1 * a[3];
    x1 = v1[0]; x2 = v1[1]; v1[0] = x1 * b[0] - x2 * b[1]; v1[1] = x2 * b[0] + x1 * b[1];
    x1 = v1[2]; x2 = v1[3]; v1[2] = x1 * b[2] - x2 * b[3]; v1[3] = x2 * b[2] + x1 * b[3];
}
#define EPI_LOOP_BEGIN _Pragma("unroll") for (int ai = 0; ai < 2; ++ai) _Pragma("unroll") for (int m = 0; m < 4; ++m) { const int row = rbase + ai * 128 + m * 16; _Pragma("unroll") for (int bj = 0; bj < 2; ++bj) { \
        f32x4 v0 = acc[ai][bj][m][0], v1 = acc[ai][bj][m][1]; const int ct = ctb + bj * 128; (void)ct; (void)row;
#define EPI_LOOP_END } }

struct EpiA {
    static constexpr bool PERM = true, AFTER_DRAIN = false;
    unsigned char* ws;
    DI void operator()(const f32x4 (&acc)[2][2][4][2], const Unit& u, int wr, int wc, int fr, int fq) const {
        asm volatile("" : "+v"(fr), "+v"(fq));
        bf16 *cq = (bf16*)(ws + WS_CQ), *ckv = (bf16*)(ws + WS_CKV), *G = (bf16*)(ws + WS_G), *bq = (bf16*)(ws + WS_BQ), *bk = (bf16*)(ws + WS_BK), *vtd = (bf16*)(ws + WS_VTD), *qi = (bf16*)(ws + WS_QI), *dq = (bf16*)(ws + WS_DQ),
             *km = (bf16*)(ws + WS_KM), *ki = (bf16*)(ws + WS_KI); float *cu = (float*)(ws + WS_CU), *wi = (float*)(ws + WS_WI), *ssq = (float*)(ws + WS_SSQ), *sskv = (float*)(ws + WS_SSKV);
        const f32x2 *csm = (const f32x2*)(ws + WS_CSM), *csd = (const f32x2*)(ws + WS_CSD), *csi = (const f32x2*)(ws + WS_CSI);
        const int tile = u.pn, rbase = u.pm * 256 + wr * 64 + fr, ctb = wc * 32 + 8 * fq;
        if (tile < 6) {
            const bool isq = tile < 4; bf16* dst = isq ? cq : ckv; const int ld = isq ? 1024 : 512, tcol = isq ? tile * 256 : (tile - 4) * 256;
#pragma unroll
            for (int ai = 0; ai < 2; ++ai)
#pragma unroll
                for (int m = 0; m < 4; ++m) { const int row = rbase + ai * 128 + m * 16; float ss = 0.f;
#pragma unroll
                    for (int bj = 0; bj < 2; ++bj) { const f32x4 v0 = acc[ai][bj][m][0], v1 = acc[ai][bj][m][1];
                        *(u32x4*)(dst + (size_t)row * ld + tcol + ctb + bj * 128) = pack8(v0, v1);
                        ss += (v0[0] * v0[0] + v0[1] * v0[1]) + (v0[2] * v0[2] + v0[3] * v0[3]) + (v1[0] * v1[0] + v1[1] * v1[1]) + (v1[2] * v1[2] + v1[3] * v1[3]); }
                    ss += __shfl_xor(ss, 16); ss += __shfl_xor(ss, 32);
                    if (fq == 0) { if (isq) ssq[(size_t)row * 16 + tile * 4 + wc] = ss; else sskv[(size_t)row * 8 + (tile - 4) * 4 + wc] = ss; } }
        } else if (tile < 10 || (tile >= 20 && tile < 24) || (tile >= 28 && tile < 32) || tile >= 36 && tile < 40) {
            const int gcol = tile < 10 ? (tile - 6) * 256 : tile < 24 ? 1024 + (tile - 20) * 256 : tile < 32 ? 2048 + (tile - 28) * 256 : 3072 + (tile - 36) * 256;
            EPI_LOOP_BEGIN
#pragma unroll
                for (int j = 0; j < 4; ++j) { v0[j] = silu_f(v0[j]); v1[j] = silu_f(v1[j]); }
                __builtin_nontemporal_store(pack8(v0, v1), (u32x4*)(G + (size_t)row * 4096 + gcol + ct));
            EPI_LOOP_END
        } else if (tile < 15) {
            const bool isq = tile < 14; bf16* dst = isq ? bq : bk; const int ld = isq ? 1024 : 256, tcol = isq ? (tile - 10) * 256 : 0; const float sc = isq ? QS_DSA : 1.0f;
            EPI_LOOP_BEGIN
                if (wc == 0) rope8(v0, v1, csd + (size_t)row * 16 + 4 * fq);
                v0 = v0 * sc; v1 = v1 * sc;
                *(u32x4*)(dst + (size_t)row * ld + tcol + ct) = pack8(v0, v1);
            EPI_LOOP_END
        } else if (tile == 15) {
            EPI_LOOP_BEGIN
                const int b = row >> 12, t = row & 4095, d0 = wc * 32 + 8 * fq; bf16* p = vtd + ((size_t)(b * 2 + bj) * 128 + d0) * S + t;
#pragma unroll
                for (int j = 0; j < 4; ++j) { p[(size_t)j * S] = f2bf(v0[j]); p[(size_t)(j + 4) * S] = f2bf(v1[j]); }
            EPI_LOOP_END
        } else if (tile < 20) {
            EPI_LOOP_BEGIN
                if ((wc & 1) == 0 && fq < 2) rope8(v0, v1, csi + (size_t)row * 8 + 4 * fq);
                v0 = v0 * 0.125f; v1 = v1 * 0.125f;
                *(u32x4*)(qi + (size_t)row * 1024 + (tile - 16) * 256 + ct) = pack8(v0, v1);
            EPI_LOOP_END
        } else if (tile < 28) {
            EPI_LOOP_BEGIN
                float* p = cu + (size_t)row * 1024 + (tile - 24) * 256 + ct; __builtin_nontemporal_store(v0, (f32x4*)p); __builtin_nontemporal_store(v1, (f32x4*)(p + 4));
            EPI_LOOP_END
        } else if (tile < 36) {
            EPI_LOOP_BEGIN
                v0 = v0 * QS_MEM; v1 = v1 * QS_MEM;
                *(u32x4*)(dq + (size_t)row * 1024 + (tile - 32) * 256 + ct) = pack8(v0, v1);
            EPI_LOOP_END
        } else {
            EPI_LOOP_BEGIN
                if (ct < 64) { rope8(v0, v1, csm + (size_t)row * 32 + (ct >> 1)); const u32x4 w = pack8(v0, v1);
#pragma unroll
                    for (int hd = 0; hd < 8; ++hd) *(u32x4*)(km + ((size_t)row * 8 + hd) * 192 + 128 + ct) = w; }
                else if (ct < 128) { const int dp = ct - 64; if (dp < 16) rope8(v0, v1, csi + (size_t)row * 8 + (dp >> 1)); *(u32x4*)(ki + (size_t)row * 64 + dp) = pack8(v0, v1); }
                else if (ct < 144) { float* p = wi + (size_t)row * 16 + (ct - 128); *(f32x4*)p = v0 * 0.25f; *(f32x4*)(p + 4) = v1 * 0.25f; }
            EPI_LOOP_END
        }
    }
};
struct EpiMemKV {
    static constexpr bool PERM = true, AFTER_DRAIN = false;
    unsigned char* ws;
    DI void operator()(const f32x4 (&acc)[2][2][4][2], const Unit& u, int wr, int wc, int fr, int fq) const {
        asm volatile("" : "+v"(fr), "+v"(fq));
        bf16 *kmem = (bf16*)(ws + WS_KMEM), *vtmem = (bf16*)(ws + WS_VTMEM);
        const int tile = u.pn, rbase = u.pm * 256 + wr * 64 + fr, ctb = wc * 32 + 8 * fq;
        if (tile < 4) {
            EPI_LOOP_BEGIN
                *(u32x4*)(kmem + (size_t)row * 1024 + tile * 256 + ct) = pack8(v0, v1);
            EPI_LOOP_END
        } else {
            EPI_LOOP_BEGIN
                const int b = row >> 8, mm = row & 255; bf16* p = vtmem + ((size_t)(b * 4 + (tile - 4)) * 256 + ct) * 256 + mm;
#pragma unroll
                for (int j = 0; j < 4; ++j) { p[(size_t)j * 256] = f2bf(v0[j]); p[(size_t)(j + 4) * 256] = f2bf(v1[j]); }
            EPI_LOOP_END
        }
    }
};
struct EpiUQ {
    static constexpr bool PERM = true, AFTER_DRAIN = false;
    unsigned char* ws;
    DI void operator()(const f32x4 (&acc)[2][2][4][2], const Unit& u, int wr, int wc, int fr, int fq) const {
        asm volatile("" : "+v"(fr), "+v"(fq));
        bf16* qm = (bf16*)(ws + WS_QM); const float* ssq = (const float*)(ws + WS_SSQ); const f32x2* csm = (const f32x2*)(ws + WS_CSM);
        const int tile = u.pn, rbase = u.pm * 256 + wr * 64 + fr, ctb = wc * 32 + 8 * fq;
        float rs[2][4];
#pragma unroll
        for (int ai = 0; ai < 2; ++ai)
#pragma unroll
            for (int m = 0; m < 4; ++m) { const float* p = ssq + (size_t)(rbase + ai * 128 + m * 16) * 16; const f32x4 a = *(const f32x4*)p, b = *(const f32x4*)(p + 4), c = *(const f32x4*)(p + 8), d = *(const f32x4*)(p + 12);
                const float s = ((a[0] + a[1]) + (a[2] + a[3])) + ((b[0] + b[1]) + (b[2] + b[3])) + ((c[0] + c[1]) + (c[2] + c[3])) + ((d[0] + d[1]) + (d[2] + d[3]));
                rs[ai][m] = rsqrtf(s * (1.0f / 1024.0f) + RMS_EPS) * QS_MLA; }
        if (tile < 4) {
            EPI_LOOP_BEGIN
                const int head = tile * 2 + bj, d0 = wc * 32 + 8 * fq; v0 = v0 * rs[ai][m]; v1 = v1 * rs[ai][m];
                *(u32x4*)(qm + ((size_t)row * 8 + head) * 192 + d0) = pack8(v0, v1);
            EPI_LOOP_END
        } else {
            EPI_LOOP_BEGIN
                const int head = (tile - 4) * 4 + (ct >> 6), dp = ct & 63;
                rope8(v0, v1, csm + (size_t)row * 32 + (dp >> 1)); v0 = v0 * rs[ai][m]; v1 = v1 * rs[ai][m];
                *(u32x4*)(qm + ((size_t)row * 8 + head) * 192 + 128 + dp) = pack8(v0, v1);
            EPI_LOOP_END
        }
    }
};
struct EpiUKV {
    static constexpr bool PERM = true, AFTER_DRAIN = false;
    unsigned char* ws;
    DI void operator()(const f32x4 (&acc)[2][2][4][2], const Unit& u, int wr, int wc, int fr, int fq) const {
        asm volatile("" : "+v"(fr), "+v"(fq));
        bf16 *km = (bf16*)(ws + WS_KM), *vtm = (bf16*)(ws + WS_VTM); const float* sskv = (const float*)(ws + WS_SSKV);
        const int head = u.pn, rbase = u.pm * 256 + wr * 64 + fr, ctb = wc * 32 + 8 * fq;
        float rs[2][4];
#pragma unroll
        for (int ai = 0; ai < 2; ++ai)
#pragma unroll
            for (int m = 0; m < 4; ++m) { const float* p = sskv + (size_t)(rbase + ai * 128 + m * 16) * 8; const f32x4 a = *(const f32x4*)p, b = *(const f32x4*)(p + 4);
                const float s = ((a[0] + a[1]) + (a[2] + a[3])) + ((b[0] + b[1]) + (b[2] + b[3]));
                rs[ai][m] = rsqrtf(s * (1.0f / 512.0f) + RMS_EPS); }
        EPI_LOOP_BEGIN
            v0 = v0 * rs[ai][m]; v1 = v1 * rs[ai][m]; const int d0 = wc * 32 + 8 * fq;
            if (bj == 0) *(u32x4*)(km + ((size_t)row * 8 + head) * 192 + d0) = pack8(v0, v1);
            else { const int b = row >> 12, t = row & 4095; bf16* p = vtm + ((size_t)(b * 8 + head) * 128 + d0) * S + t;
#pragma unroll
                for (int j = 0; j < 4; ++j) { p[(size_t)j * S] = f2bf(v0[j]); p[(size_t)(j + 4) * S] = f2bf(v1[j]); } }
        EPI_LOOP_END
    }
};
struct EpiO {
    static constexpr bool PERM = true, AFTER_DRAIN = false;
    const float* xin; const float* g; const float* bb; unsigned char* ws;
    DI void operator()(const f32x4 (&acc)[2][2][4][2], const Unit& u, int wr, int wc, int fr, int fq) const {
        asm volatile("" : "+v"(fr), "+v"(fq));
        float* z = (float*)(ws + WS_Z); const f32x2* st = (const f32x2*)(ws + WS_XN);
        const int rbase = u.pm * 256 + wr * 64 + fr, ctb = u.pn * 256 + wc * 32 + 8 * fq;
        if (xin) {
            EPI_LOOP_BEGIN
                const size_t o = (size_t)row * D + ct; const f32x4 r0 = *(const f32x4*)(xin + o), r1 = *(const f32x4*)(xin + o + 4);
                *(f32x4*)(z + o) = r0 * ALPHA + v0; *(f32x4*)(z + o + 4) = r1 * ALPHA + v1;
            EPI_LOOP_END
        } else {
            f32x4 g0[2], g1[2], b0[2], b1[2];
#pragma unroll
            for (int bj = 0; bj < 2; ++bj) { const int c = ctb + bj * 128; g0[bj] = *(const f32x4*)(g + c) * ALPHA; g1[bj] = *(const f32x4*)(g + c + 4) * ALPHA; b0[bj] = *(const f32x4*)(bb + c) * ALPHA; b1[bj] = *(const f32x4*)(bb + c + 4) * ALPHA; }
#pragma unroll
            for (int ai = 0; ai < 2; ++ai)
#pragma unroll
                for (int m = 0; m < 4; ++m) { const int row = rbase + ai * 128 + m * 16; const f32x2 ms = st[row];
#pragma unroll
                    for (int bj = 0; bj < 2; ++bj) { const size_t o = (size_t)row * D + ctb + bj * 128; const f32x4 z0 = *(const f32x4*)(z + o), z1 = *(const f32x4*)(z + o + 4);
                        *(f32x4*)(z + o) = (z0 - ms.x) * ms.y * g0[bj] + b0[bj] + acc[ai][bj][m][0]; *(f32x4*)(z + o + 4) = (z1 - ms.x) * ms.y * g1[bj] + b1[bj] + acc[ai][bj][m][1]; } }
        }
    }
};
template <int DQK> struct AttnCfg { static constexpr int CPR = DQK / 8, KROW = DQK * 2, KBYTES = 64 * KROW, NKC = DQK / 64; };
template <int DQK> DI int attn_kswz(int rho) { return (DQK == 192) ? ((rho >> 1) & 7) : (rho & 15); }
template <int DQK, int MODE, int NDB>
DI void attn_unit(LAS unsigned char* lds, int tid, int wid, int lane,
                  const bf16* Qw, int qstride, const bf16* Kb, int kstride, const bf16* VTb, int vtstride, int nkt, int qpos0,
                  const unsigned* maskrow0, bf16* Ow, const bf16* Gw, int ostride) {
    typedef AttnCfg<DQK> C;
    constexpr bool PIPE = (DQK != 256);
    constexpr int NBUF = PIPE ? 3 : 2;
    constexpr int VBYTES = 32 * NDB * 128, KOFF0 = 0, VOFF0 = NBUF * C::KBYTES;
    const int r = lane & 31, h = lane >> 5, grp = wid >> 2;
    bf16x8 qf[DQK / 16];
    { const unsigned qoff = (unsigned)(r * qstride + 8 * h) * 2u;
#pragma unroll
      for (int ks = 0; ks < DQK / 16; ++ks) qf[ks] = *(const bf16x8*)((const char*)Qw + qoff + 32 * ks); }
    f32x16 o[NDB];
#pragma unroll
    for (int db = 0; db < NDB; ++db)
#pragma unroll
        for (int i = 0; i < 16; ++i) o[db][i] = 0.f;
    float mrun = -1e30f, lrun = 0.f;
    unsigned ksrc[C::NKC], vsrc0;
#pragma unroll
    for (int q = 0; q < C::NKC; ++q) { const int L = (8 * q + wid) * 64 + lane, rho = L / C::CPR, cp = L % C::CPR, r5 = rho & 31;
        const int key = (rho & 32) + (r5 & 19) + ((r5 & 4) << 1) + ((r5 & 8) >> 1);
        ksrc[q] = (unsigned)(key * kstride) * 2u + (unsigned)((cp ^ attn_kswz<DQK>(rho)) * 16); }
    { const int L = wid * 64 + lane, d = L >> 3, cp = L & 7; vsrc0 = (unsigned)(d * vtstride) * 2u + (unsigned)((cp ^ ((d >> 1) & 7)) * 16); }
#define ATTN_DMAK(kt_, buf_) do { const int kc_ = (kt_) < nkt ? (kt_) : nkt - 1; const char* kb_ = (const char*)Kb + (size_t)kc_ * (size_t)(128 * kstride); \
        _Pragma("unroll") for (int q = 0; q < C::NKC; ++q) __builtin_amdgcn_global_load_lds((const unsigned*)(kb_ + ksrc[q]), (LAS unsigned*)(lds + KOFF0 + (buf_) * C::KBYTES + (8 * q + wid) * 1024), 16, 0, 0); } while (0)
#define ATTN_DMAV(kt_, buf_) do { const int kc_ = (kt_) < nkt ? (kt_) : nkt - 1; const char* vb_ = (const char*)VTb + (size_t)kc_ * 128; \
        _Pragma("unroll") for (int q = 0; q < NDB / 2; ++q) __builtin_amdgcn_global_load_lds((const unsigned*)(vb_ + (size_t)q * (size_t)(128 * vtstride) + vsrc0), (LAS unsigned*)(lds + VOFF0 + (buf_) * VBYTES + (8 * q + wid) * 1024), 16, 0, 0); } while (0)
#define ATTN_SYNC() do { asm volatile("s_waitcnt vmcnt(0)" ::: "memory"); __builtin_amdgcn_s_barrier(); asm volatile("" ::: "memory"); } while (0)
#define ATTN_SYNCN(n_) do { asm volatile("s_waitcnt vmcnt(%0)" :: "n"(n_) : "memory"); __builtin_amdgcn_s_barrier(); asm volatile("" ::: "memory"); } while (0)
    constexpr int NDMA = C::NKC + NDB / 2;
    const int krow = 32 * grp + r, kswz = attn_kswz<DQK>(krow);
    int klow[4];
    if (DQK == 192) {
#pragma unroll
        for (int c = 0; c < 4; ++c) klow[c] = ((2 * c + h) ^ kswz) * 16;
    }
    int vsw[2];
#pragma unroll
    for (int s2 = 0; s2 < 2; ++s2) vsw[s2] = r * 128 + (((4 * grp + 2 * s2 + h) ^ ((r >> 1) & 7)) * 16);
#define ATTN_KOFF(ks_) (DQK == 192 ? klow[(ks_) & 3] + ((ks_) >> 2) * 128 : (((2 * (ks_) + h) ^ kswz) * 16))
#define ATTN_QK(dst, buf_) do { const LAS unsigned char* kp_ = lds + KOFF0 + (buf_) * C::KBYTES + krow * C::KROW; constexpr int NKS = DQK / 16, KBATCH = 4; \
        _Pragma("unroll") for (int i = 0; i < 16; ++i) dst[i] = 0.f; \
        _Pragma("unroll") for (int kb = 0; kb < NKS; kb += KBATCH) { bf16x8 kf[KBATCH]; \
            _Pragma("unroll") for (int ks = 0; ks < KBATCH; ++ks) if (kb + ks < NKS) kf[ks] = *(const LAS bf16x8*)(kp_ + ATTN_KOFF(kb + ks)); \
            __builtin_amdgcn_sched_barrier(0); \
            _Pragma("unroll") for (int ks = 0; ks < KBATCH; ++ks) if (kb + ks < NKS) dst = MFMA32(kf[ks], qf[kb + ks], dst); \
            __builtin_amdgcn_sched_barrier(0); } } while (0)
#define ATTN_DMAV1(vbp_, buf_, q_) __builtin_amdgcn_global_load_lds((const unsigned*)((vbp_) + (size_t)(q_) * (size_t)(128 * vtstride) + vsrc0), (LAS unsigned*)(lds + VOFF0 + (buf_) * VBYTES + (8 * (q_) + wid) * 1024), 16, 0, 0)
    static_assert(!PIPE || (DQK / 64 == C::NKC && NDB == 4), "one K piece per QK batch, two V pieces");
    f32x16 s, sn;
    constexpr int MTOFF = 106496;
    unsigned mw[8];
    if (MODE == 2) {
#pragma unroll
        for (int i = 0; i < 8; ++i) mw[i] = maskrow0[tid + 512 * i];
    }
    __syncthreads();
    if (MODE == 2) {
#pragma unroll
        for (int i = 0; i < 8; ++i) { const int idx = tid + 512 * i, row = idx >> 7, w = idx & 127; *(LAS unsigned*)(lds + MTOFF + (row * 129 + w) * 4) = mw[i]; }
        LDS_WAIT();
    }
    if (PIPE) { ATTN_DMAK(0, 0); ATTN_DMAK(1, 1); ATTN_DMAV(0, 0); ATTN_DMAK(2, 2); ATTN_DMAV(1, 1); ATTN_SYNCN(2 * NDMA); ATTN_QK(s, 0); }
    else { ATTN_DMAK(0, 0); ATTN_DMAV(0, 0); }
    if (__builtin_amdgcn_readfirstlane(wid) >= 4) __builtin_amdgcn_s_setprio(1);
    auto tile_step = [&](f32x16& s, f32x16& sn, const int kt, auto c0c) __attribute__((always_inline)) {
        const int c0 = (int)c0c;
        const int c1 = c0 == 2 ? 0 : c0 + 1, c2 = c1 == 2 ? 0 : c1 + 1, vb = PIPE ? c0 : (kt & 1);
        const int kck = kt + 3 < nkt ? kt + 3 : nkt - 1, kcv = kt + 2 < nkt ? kt + 2 : nkt - 1;
        const char* kbp = (const char*)Kb + (size_t)kck * (size_t)(128 * kstride); const char* vbp = (const char*)VTb + (size_t)kcv * 128;
        if (PIPE) ATTN_SYNCN(NDMA);
        else { ATTN_SYNC(); ATTN_DMAK(kt + 1, (kt + 1) & 1); ATTN_DMAV(kt + 1, (kt + 1) & 1); ATTN_QK(s, kt & 1); }
        constexpr bool VEARLY = (DQK != 256);
        bf16x8 vf[NDB][2];
        const LAS unsigned char* vq2[2];
#pragma unroll
        for (int s2 = 0; s2 < 2; ++s2) { vq2[s2] = lds + VOFF0 + vb * VBYTES + vsw[s2]; asm volatile("" : "+v"(vq2[s2])); }
#define ATTN_VFRAG(db_, s2_) (*(const LAS bf16x8*)(vq2[s2_] + (db_) * 4096))
        constexpr bool VLATE = (DQK == 192);
        if (VEARLY) {
            if (!VLATE) {
#pragma unroll
                for (int db = 0; db < NDB; ++db)
#pragma unroll
                    for (int s2 = 0; s2 < 2; ++s2) vf[db][s2] = ATTN_VFRAG(db, s2);
                __builtin_amdgcn_sched_barrier(0);
            }
            if (PIPE) { ATTN_DMAV1(vbp, c2, 0); __builtin_amdgcn_sched_barrier(0); }
        }
        constexpr int NKS = DQK / 16, KW = (DQK == 192) ? 2 : 4, SL0 = (NKS - 8) / 2;
        const LAS unsigned char* kpn = lds + KOFF0 + c1 * C::KBYTES + krow * C::KROW;
        const LAS unsigned char* kq4[4];
        if (DQK == 192) {
#pragma unroll
            for (int c = 0; c < 4; ++c) { kq4[c] = kpn + klow[c]; asm volatile("" : "+v"(kq4[c])); }
        }
#define ATTN_KFRAG(ks_) (*(const LAS bf16x8*)(DQK == 192 ? kq4[(ks_) & 3] + ((ks_) >> 2) * 128 : kpn + ATTN_KOFF(ks_)))
        bf16x8 kf[PIPE ? NKS : 1];
        if (PIPE) {
#pragma unroll
            for (int ks = 0; ks < KW; ++ks) kf[ks] = ATTN_KFRAG(ks);
            __builtin_amdgcn_sched_barrier(0);
        }
        const int key0 = 64 * kt + 32 * grp;
        const bool need_mask = (MODE == 2) || (MODE == 1 && key0 + 31 > qpos0);
        unsigned vmask = 0xffffffffu;
        if (need_mask) {
            if (MODE == 1) { const int lim = qpos0 + r - key0; vmask = lim >= 31 ? 0xffffffffu : (lim < 0 ? 0u : ((2u << lim) - 1u)); }
            else vmask = *(const LAS unsigned*)(lds + MTOFF + (r * 129 + 2 * kt + grp) * 4);
            vmask >>= 8 * h;
        }
        float mx = max3_asm(s[0], s[1], s[2]);
#pragma unroll
        for (int i = 3; i < 15; i += 2) mx = max3_asm(mx, s[i], s[i + 1]);
        mx = xhalf_max_asm(max_asm(mx, s[15]));
        if (__any(mx > mrun + 8.0f)) { const float mn = fmaxf(mrun, mx), alpha = ex2(mrun - mn); mrun = mn; lrun *= alpha;
#pragma unroll
            for (int db = 0; db < NDB; ++db)
#pragma unroll
                for (int i = 0; i < 16; ++i) o[db][i] *= alpha; }
        bf16x8 pf[2];
        if (PIPE) {
            float ps0 = 0.f; unsigned pw[8];
            f32x16 zero16;
#pragma unroll
            for (int i = 0; i < 16; ++i) zero16[i] = 0.f;
#define ATTN_SLOT(KS_, M_) if ((KS_) < NKS) { constexpr int ks = (KS_) < NKS ? (KS_) : 0; \
                if (ks + KW < NKS) kf[(ks + KW) % NKS] = ATTN_KFRAG((ks + KW) % NKS); \
                if (ks == 0) sn = MFMA32(kf[0], qf[0], zero16); else sn = MFMA32(kf[ks], qf[ks], sn); \
                constexpr int j_ = ks - SL0; \
                if (j_ >= 0 && j_ < 8) { constexpr int e0_ = 2 * (j_ & 7), e1_ = e0_ + 1; unsigned m0_ = 0, m1_ = 0; \
                    if (M_) { asm("v_bfe_i32 %0, %1, %2, 1" : "=v"(m0_) : "v"(vmask), "n"((e0_ & 7) + 16 * (e0_ >> 3))); asm("v_bfe_i32 %0, %1, %2, 1" : "=v"(m1_) : "v"(vmask), "n"((e1_ & 7) + 16 * (e1_ >> 3))); } \
                    float p0_ = ex2(s[e0_] - mr_), p1_ = ex2(s[e1_] - mr_); \
                    if (M_) { p0_ = __builtin_bit_cast(float, __builtin_bit_cast(unsigned, p0_) & m0_); p1_ = __builtin_bit_cast(float, __builtin_bit_cast(unsigned, p1_) & m1_); } \
                    ps0 += p0_; ps0 += p1_; pw[j_ & 7] = pk2(p0_, p1_); } \
                if ((ks & 3) == 3) __builtin_amdgcn_global_load_lds((const unsigned*)(kbp + ksrc[ks >> 2]), (LAS unsigned*)(lds + KOFF0 + c0 * C::KBYTES + (8 * (ks >> 2) + wid) * 1024), 16, 0, 0); \
                __builtin_amdgcn_sched_barrier(0); }
#define ATTN_BLOCKB(M_) do { float mr_ = mrun; asm volatile("" : "+v"(mr_));     \
            ATTN_SLOT(0, M_) ATTN_SLOT(1, M_) ATTN_SLOT(2, M_) ATTN_SLOT(3, M_) ATTN_SLOT(4, M_) ATTN_SLOT(5, M_) ATTN_SLOT(6, M_) ATTN_SLOT(7, M_) ATTN_SLOT(8, M_) ATTN_SLOT(9, M_) ATTN_SLOT(10, M_) ATTN_SLOT(11, M_) } while (0)
            if (need_mask) ATTN_BLOCKB(true); else ATTN_BLOCKB(false);
#undef ATTN_BLOCKB
#undef ATTN_SLOT
            if (VLATE) { vf[0][0] = ATTN_VFRAG(0, 0); vf[0][1] = ATTN_VFRAG(0, 1); vf[1][0] = ATTN_VFRAG(1, 0); vf[1][1] = ATTN_VFRAG(1, 1); vf[2][0] = ATTN_VFRAG(2, 0); vf[2][1] = ATTN_VFRAG(2, 1); vf[3][0] = ATTN_VFRAG(3, 0); vf[3][1] = ATTN_VFRAG(3, 1); __builtin_amdgcn_sched_barrier(0); }
            lrun += ps0;
            ATTN_DMAV1(vbp, c2, 1); __builtin_amdgcn_sched_barrier(0);
            pf[0] = __builtin_bit_cast(bf16x8, ((u32x4){pw[0], pw[1], pw[2], pw[3]})); pf[1] = __builtin_bit_cast(bf16x8, ((u32x4){pw[4], pw[5], pw[6], pw[7]}));
        } else {
            float ps = 0.f; float pv[16];
            if (need_mask) {
#pragma unroll
                for (int i = 0; i < 16; ++i) { const int kl = (i & 7) + 16 * (i >> 3); const unsigned mi = (unsigned)__builtin_amdgcn_sbfe((int)vmask, kl, 1);
                    const float p = __builtin_bit_cast(float, __builtin_bit_cast(unsigned, ex2(s[i] - mrun)) & mi); pv[i] = p; ps += p; }
            } else {
#pragma unroll
                for (int i = 0; i < 16; ++i) { const float p = ex2(s[i] - mrun); pv[i] = p; ps += p; }
            }
            lrun += ps;
#pragma unroll
            for (int s2 = 0; s2 < 2; ++s2) { u32x4 w; w.x = pk2(pv[8 * s2], pv[8 * s2 + 1]); w.y = pk2(pv[8 * s2 + 2], pv[8 * s2 + 3]); w.z = pk2(pv[8 * s2 + 4], pv[8 * s2 + 5]); w.w = pk2(pv[8 * s2 + 6], pv[8 * s2 + 7]); pf[s2] = __builtin_bit_cast(bf16x8, w); }
        }
#pragma unroll
        for (int db = 0; db < NDB; ++db) {
            if (!VEARLY) { vf[0][0] = ATTN_VFRAG(db, 0); vf[0][1] = ATTN_VFRAG(db, 1); o[db] = MFMA32(vf[0][0], pf[0], o[db]); o[db] = MFMA32(vf[0][1], pf[1], o[db]); }
            else {
#pragma unroll
                for (int s2 = 0; s2 < 2; ++s2) o[db] = MFMA32(vf[db][s2], pf[s2], o[db]); } }
#undef ATTN_VFRAG
#undef ATTN_KFRAG
    };
    if (DQK != 128) { int c0 = 0;
        for (int kt = 0; kt < nkt; kt += 2) { tile_step(s, sn, kt, c0); c0 = c0 == 2 ? 0 : c0 + 1; if (kt + 1 < nkt) { tile_step(sn, s, kt + 1, c0); c0 = c0 == 2 ? 0 : c0 + 1; } }
    } else
    for (int kt = 0; kt < nkt; kt += 6) {
        tile_step(s, sn, kt, IC<0>{}); if (kt + 1 >= nkt) break;
        tile_step(sn, s, kt + 1, IC<1>{}); if (kt + 2 >= nkt) break;
        tile_step(s, sn, kt + 2, IC<2>{}); if (kt + 3 >= nkt) break;
        tile_step(sn, s, kt + 3, IC<0>{}); if (kt + 4 >= nkt) break;
        tile_step(s, sn, kt + 4, IC<1>{}); if (kt + 5 >= nkt) break;
        tile_step(sn, s, kt + 5, IC<2>{});
    }
    __builtin_amdgcn_s_setprio(0);
    asm volatile("s_waitcnt vmcnt(0)" ::: "memory");
#undef ATTN_DMAK
#undef ATTN_DMAV
#undef ATTN_SYNC
#undef ATTN_SYNCN
#undef ATTN_QK
#undef ATTN_KOFF
#undef ATTN_DMAV1
    const float lt = xhalf_sum(lrun);
    int ln = lane; asm volatile("" : "+v"(ln)); const int re = ln & 31, he = ln >> 5;
    constexpr int CPRW = NDB * 4, RPI = 64 / CPRW;
    constexpr bool GPRE = (NDB == 4);
    u32x4 gpre[GPRE ? 32 / RPI : 1];
    if (GPRE && grp == 0) {
#pragma unroll
        for (int it = 0; it < 32 / RPI; ++it) { const int row = it * RPI + ln / CPRW, ch = ln % CPRW; gpre[it] = *(const u32x4*)((const char*)Gw + (unsigned)(row * ostride) * 2u + (unsigned)ch * 16u); }
    }
    __syncthreads();
    LAS float* mb = (LAS float*)lds + (wid & 3) * ((NDB * 16 + 2) * 64);
    if (grp == 1) {
#pragma unroll
        for (int db = 0; db < NDB; ++db)
#pragma unroll
            for (int i = 0; i < 16; ++i) mb[(db * 16 + i) * 64 + lane] = o[db][i];
        mb[(NDB * 16) * 64 + lane] = mrun; mb[(NDB * 16 + 1) * 64 + lane] = lt;
    }
    __syncthreads();
    if (grp == 0) {
        const float m2 = mb[(NDB * 16) * 64 + lane], l2 = mb[(NDB * 16 + 1) * 64 + lane];
        const float mm = fmaxf(mrun, m2), a1 = ex2(mrun - mm), a2 = ex2(m2 - mm);
        const float inv = frcp(lt * a1 + l2 * a2);
        const float c1 = a1 * inv, c2 = a2 * inv;
        LAS unsigned char* stg = lds + 4 * ((NDB * 16 + 2) * 256) + (wid & 3) * (32 * 272);
#pragma unroll
        for (int db = 0; db < NDB; ++db)
#pragma unroll
            for (int g4 = 0; g4 < 4; ++g4) {
                const float y0 = o[db][4 * g4 + 0] * c1 + mb[(db * 16 + 4 * g4 + 0) * 64 + lane] * c2, y1 = o[db][4 * g4 + 1] * c1 + mb[(db * 16 + 4 * g4 + 1) * 64 + lane] * c2;
                const float y2 = o[db][4 * g4 + 2] * c1 + mb[(db * 16 + 4 * g4 + 2) * 64 + lane] * c2, y3 = o[db][4 * g4 + 3] * c1 + mb[(db * 16 + 4 * g4 + 3) * 64 + lane] * c2;
                *(LAS u32x2*)(stg + re * 272 + (32 * db + 8 * g4 + 4 * he) * 2) = (u32x2){pk2(y0, y1), pk2(y2, y3)}; }
        LDS_WAIT(); asm volatile("" ::: "memory");
#pragma unroll
        for (int it = 0; it < 32 / RPI; ++it) { const int row = it * RPI + ln / CPRW, ch = ln % CPRW; const unsigned off = (unsigned)(row * ostride) * 2u + (unsigned)ch * 16u;
            const u32x4 yv = *(const LAS u32x4*)(stg + row * 272 + ch * 16); u32x4 gv; if (GPRE) gv = gpre[it]; else gv = *(const u32x4*)((const char*)Gw + off);
            __builtin_nontemporal_store((u32x4){pk2(bflo(yv.x) * bflo(gv.x), bfhi(yv.x) * bfhi(gv.x)), pk2(bflo(yv.y) * bflo(gv.y), bfhi(yv.y) * bfhi(gv.y)),
                                                 pk2(bflo(yv.z) * bflo(gv.z), bfhi(yv.z) * bfhi(gv.z)), pk2(bflo(yv.w) * bflo(gv.w), bfhi(yv.w) * bfhi(gv.w))}, (u32x4*)((char*)Ow + off)); }
    }
}

DI void mla_phase(const Frame& F) {
    const bf16* qm = wsp<bf16>(F, WS_QM); const bf16* km = wsp<bf16>(F, WS_KM); const bf16* vtm = wsp<bf16>(F, WS_VTM); const bf16* G = wsp<bf16>(F, WS_G); bf16* mix = wsp<bf16>(F, WS_MIX);
    const int wq = F.wave & 3;
    for (int j0 = F.bid; j0 < 256; j0 += F.G) {
        const int j = (F.G == 256) ? ((j0 & 7) * 32 + (j0 >> 3)) : j0;
        const int bh = j >> 4, b = bh >> 3, head = bh & 7, p = j & 15;
        for (int k = 0; k < 2; ++k) { const int qb = k ? p : 31 - p, q0 = 128 * qb, row0 = b * S + q0 + 32 * wq;
            attn_unit<192, 1, 4>(F.lds, F.tid, F.wave, F.lane, qm + ((size_t)row0 * 8 + head) * 192, 1536, km + ((size_t)(b * S) * 8 + head) * 192, 1536,
                              vtm + (size_t)(b * 8 + head) * 128 * S, S, 2 * qb + 2, q0 + 32 * wq, nullptr, mix + (size_t)row0 * 4096 + head * 128, G + (size_t)row0 * 4096 + head * 128, 4096); }
    }
}
DI void dsa_phase(const Frame& F) {
    const bf16* bq = wsp<bf16>(F, WS_BQ); const bf16* bk = wsp<bf16>(F, WS_BK); const bf16* vtd = wsp<bf16>(F, WS_VTD); const bf16* G = wsp<bf16>(F, WS_G); bf16* mix = wsp<bf16>(F, WS_MIX);
    const unsigned* mask = wsp<unsigned>(F, WS_MASK);
    const int wq = F.wave & 3;
    for (int j0 = F.bid; j0 < 256; j0 += F.G) {
        const int j = (F.G == 256) ? ((j0 & 7) * 32 + (j0 >> 3)) : j0;
        const int bn = j >> 6, b = bn >> 1, n = bn & 1, p = j & 63, hh = 4 * n + wq;
        for (int k = 0; k < 2; ++k) { const int qb = k ? p : 127 - p, q0 = 32 * qb, row0 = b * S + q0;
            attn_unit<128, 2, 4>(F.lds, F.tid, F.wave, F.lane, bq + (size_t)row0 * 1024 + hh * 128, 1024, bk + (size_t)(b * S) * 256 + n * 128, 256,
                              vtd + (size_t)(b * 2 + n) * 128 * S, S, qb / 2 + 1, q0, mask + (size_t)row0 * 128, mix + (size_t)row0 * 4096 + 1024 + hh * 128, G + (size_t)row0 * 4096 + 1024 + hh * 128, 4096); }
    }
}
DI void mem_unit(LAS unsigned char* lds, int tid, int wid, int lane, const bf16* Qw, const bf16* Kb, const bf16* VTb, bf16* Ow, const bf16* Gw) {
    constexpr int DQK = 256, CPR = 32, KROW = 512, KBYTES = 64 * KROW, VBYTES = 256 * 128, VOFF0 = 2 * KBYTES, qstride = 1024, kstride = 1024, vtstride = 256, ostride = 4096, nkt = 4;
    const int r = lane & 31, h = lane >> 5, grp = wid >> 2;
    bf16x8 qf[16];
    { const unsigned qoff = (unsigned)(r * qstride + 8 * h) * 2u;
#pragma unroll
      for (int ks = 0; ks < 16; ++ks) qf[ks] = *(const bf16x8*)((const char*)Qw + qoff + 32 * ks); }
    f32x16 o[4];
#pragma unroll
    for (int db = 0; db < 4; ++db)
#pragma unroll
        for (int i = 0; i < 16; ++i) o[db][i] = 0.f;
    float mrun = -1e30f, lrun = 0.f;
    unsigned ksrc[4], vsrc[4];
#pragma unroll
    for (int q = 0; q < 4; ++q) { const int L = (8 * q + wid) * 64 + lane, rho = L / CPR, cp = L % CPR, r5 = rho & 31;
        const int key = (rho & 32) + (r5 & 19) + ((r5 & 4) << 1) + ((r5 & 8) >> 1);
        ksrc[q] = (unsigned)(key * kstride) * 2u + (unsigned)((cp ^ (rho & 15)) * 16);
        const int d = L >> 3, cv = L & 7; vsrc[q] = (unsigned)(d * vtstride) * 2u + (unsigned)((cv ^ ((d >> 1) & 7)) * 16); }
#define MEM_DMA(kt_, buf_) do { const int kc_ = (kt_) < nkt ? (kt_) : nkt - 1; const char* kb_ = (const char*)Kb + (size_t)kc_ * (size_t)(128 * kstride); const char* vb_ = (const char*)VTb + (size_t)kc_ * 128; \
        _Pragma("unroll") for (int q = 0; q < 4; ++q) { __builtin_amdgcn_global_load_lds((const unsigned*)(kb_ + ksrc[q]), (LAS unsigned*)(lds + (buf_) * KBYTES + (8 * q + wid) * 1024), 16, 0, 0); \
            __builtin_amdgcn_global_load_lds((const unsigned*)(vb_ + vsrc[q]), (LAS unsigned*)(lds + VOFF0 + (buf_) * VBYTES + (8 * q + wid) * 1024), 16, 0, 0); } } while (0)
    __syncthreads();
    MEM_DMA(0, 0);
    for (int kt = 0; kt < nkt; ++kt) {
        asm volatile("s_waitcnt vmcnt(0)" ::: "memory"); __builtin_amdgcn_s_barrier(); asm volatile("" ::: "memory");
        MEM_DMA(kt + 1, (kt + 1) & 1);
#pragma unroll 1
        for (int sub = 0; sub < 2; ++sub) {
            const int krow = 32 * sub + r, kswz = krow & 15;
            const LAS unsigned char* kp = lds + (kt & 1) * KBYTES + krow * KROW;
            f32x16 s;
#pragma unroll
            for (int i = 0; i < 16; ++i) s[i] = 0.f;
#pragma unroll
            for (int kb = 0; kb < 16; kb += 4) { bf16x8 kf[4];
#pragma unroll
                for (int ks = 0; ks < 4; ++ks) kf[ks] = *(const LAS bf16x8*)(kp + (((2 * (kb + ks) + h) ^ kswz) * 16));
                __builtin_amdgcn_sched_barrier(0);
#pragma unroll
                for (int ks = 0; ks < 4; ++ks) s = MFMA32(kf[ks], qf[kb + ks], s);
                __builtin_amdgcn_sched_barrier(0); }
            float mx = s[0];
#pragma unroll
            for (int i = 1; i < 16; ++i) mx = fmaxf(mx, s[i]);
            mx = xhalf_max(mx);
            if (__any(mx > mrun + 8.0f)) { const float mn = fmaxf(mrun, mx), alpha = ex2(mrun - mn); mrun = mn; lrun *= alpha;
#pragma unroll
                for (int db = 0; db < 4; ++db)
#pragma unroll
                    for (int i = 0; i < 16; ++i) o[db][i] *= alpha; }
            float ps = 0.f; float pv[16];
#pragma unroll
            for (int i = 0; i < 16; ++i) { const float p = ex2(s[i] - mrun); pv[i] = p; ps += p; }
            lrun += ps;
            bf16x8 pf[2];
#pragma unroll
            for (int s2 = 0; s2 < 2; ++s2) { u32x4 w; w.x = pk2(pv[8 * s2], pv[8 * s2 + 1]); w.y = pk2(pv[8 * s2 + 2], pv[8 * s2 + 3]); w.z = pk2(pv[8 * s2 + 4], pv[8 * s2 + 5]); w.w = pk2(pv[8 * s2 + 6], pv[8 * s2 + 7]); pf[s2] = __builtin_bit_cast(bf16x8, w); }
#pragma unroll
            for (int db = 0; db < 4; ++db) { const int d = 128 * grp + 32 * db + r; const LAS unsigned char* vp = lds + VOFF0 + (kt & 1) * VBYTES + d * 128; const int vsw = (d >> 1) & 7;
                const bf16x8 v0 = *(const LAS bf16x8*)(vp + (((4 * sub + h) ^ vsw) * 16)), v1 = *(const LAS bf16x8*)(vp + (((4 * sub + 2 + h) ^ vsw) * 16));
                o[db] = MFMA32(v0, pf[0], o[db]); o[db] = MFMA32(v1, pf[1], o[db]); }
        }
    }
#undef MEM_DMA
    asm volatile("s_waitcnt vmcnt(0)" ::: "memory");
    __syncthreads();
    {
        int ln = lane; asm volatile("" : "+v"(ln)); const int re = ln & 31, he = ln >> 5;
        const float inv = frcp(xhalf_sum(lrun));
        LAS unsigned char* stg = lds + wid * (32 * 272);
#pragma unroll
        for (int db = 0; db < 4; ++db)
#pragma unroll
            for (int g4 = 0; g4 < 4; ++g4)
                *(LAS u32x2*)(stg + re * 272 + (32 * db + 8 * g4 + 4 * he) * 2) = (u32x2){pk2(o[db][4 * g4] * inv, o[db][4 * g4 + 1] * inv), pk2(o[db][4 * g4 + 2] * inv, o[db][4 * g4 + 3] * inv)};
        LDS_WAIT(); asm volatile("" ::: "memory");
#pragma unroll
        for (int it = 0; it < 8; ++it) { const int row = it * 4 + (ln >> 4), ch = ln & 15; const unsigned off = (unsigned)(row * ostride) * 2u + (unsigned)(128 * grp) * 2u + (unsigned)ch * 16u;
            const u32x4 yv = *(const LAS u32x4*)(stg + row * 272 + ch * 16); const u32x4 gv = *(const u32x4*)((const char*)Gw + off);
            __builtin_nontemporal_store((u32x4){pk2(bflo(yv.x) * bflo(gv.x), bfhi(yv.x) * bfhi(gv.x)), pk2(bflo(yv.y) * bflo(gv.y), bfhi(yv.y) * bfhi(gv.y)),
                                                 pk2(bflo(yv.z) * bflo(gv.z), bfhi(yv.z) * bfhi(gv.z)), pk2(bflo(yv.w) * bflo(gv.w), bfhi(yv.w) * bfhi(gv.w))}, (u32x4*)((char*)Ow + off)); }
    }
}
DI void mem_phase(const Frame& F) {
    const bf16* dq = wsp<bf16>(F, WS_DQ); const bf16* kmem = wsp<bf16>(F, WS_KMEM); const bf16* vtmem = wsp<bf16>(F, WS_VTMEM); const bf16* G = wsp<bf16>(F, WS_G); bf16* mix = wsp<bf16>(F, WS_MIX);
    const int wq = F.wave & 3;
    for (int j = F.bid; j < 256; j += F.G) {
        const int bh = j >> 5, b = bh >> 2, head = bh & 3, qb = j & 31, row0 = b * S + 128 * qb + 32 * wq;
        mem_unit(F.lds, F.tid, F.wave, F.lane, dq + (size_t)row0 * 1024 + head * 256, kmem + (size_t)(b * 256) * 1024 + head * 256, vtmem + (size_t)(b * 4 + head) * 256 * 256,
                 mix + (size_t)row0 * 4096 + 3072 + head * 256, G + (size_t)row0 * 4096 + 3072 + head * 256);
    }
}

DI void select_load(const Frame& F, int row, float (&u)[64]);
DI void select_row(const Frame& F, int row, float (&u)[64]);
DI void idx_item(const Frame& F, int b, int p) {
    const bf16* qi = wsp<bf16>(F, WS_QI); const bf16* ki = wsp<bf16>(F, WS_KI); const float* wi = wsp<float>(F, WS_WI); float* sc = wsp<float>(F, WS_SC);
    const int lane = F.lane, r = lane & 31, h = lane >> 5, tA = 16 * p + 2 * F.wave, tB = 16 * (255 - p) + 2 * F.wave;
    const int aq = (r >> 2) & 1, ah = (r & 3) + 4 * (r >> 3);
    bf16x8 afA[4], afB[4];
#pragma unroll
    for (int ks = 0; ks < 4; ++ks) { afA[ks] = *(const bf16x8*)(qi + ((size_t)(b * S + tA + aq) * 16 + ah) * 64 + 16 * ks + 8 * h); afB[ks] = *(const bf16x8*)(qi + ((size_t)(b * S + tB + aq) * 16 + ah) * 64 + 16 * ks + 8 * h); }
    float wlA[16], wlB[16];
    { const float* wa = wi + (size_t)(b * S + tA + h) * 16; const float* wb = wi + (size_t)(b * S + tB + h) * 16;
#pragma unroll
      for (int i = 0; i < 4; ++i) { const f32x4 x = *(const f32x4*)(wa + 4 * i), y = *(const f32x4*)(wb + 4 * i);
          wlA[4 * i] = x[0]; wlA[4 * i + 1] = x[1]; wlA[4 * i + 2] = x[2]; wlA[4 * i + 3] = x[3]; wlB[4 * i] = y[0]; wlB[4 * i + 1] = y[1]; wlB[4 * i + 2] = y[2]; wlB[4 * i + 3] = y[3]; } }
    float* orowA = sc + ((size_t)(b * S + tA + h)) * S + r; float* orowB = sc + ((size_t)(b * S + tB + h)) * S + r;
    const int nktA = (16 * p + 15) / 32 + 1, nktB = (16 * (255 - p) + 15) / 32 + 1;
    LAS unsigned char* lds = F.lds; constexpr int CHB = 256 * 144;
    const char* kbase = (const char*)(ki + (size_t)(b * S) * 64);
    const int nch = (nktB + 7) >> 3;
    u32x4 stg[4];
#define IDX_GLOAD(c_) do { int tl_ = F.tid; asm volatile("" : "+v"(tl_)); const char* cb_ = kbase + (size_t)(c_) * 32768; _Pragma("unroll") for (int i_ = 0; i_ < 4; ++i_) stg[i_] = *(const u32x4*)(cb_ + (unsigned)(tl_ + 512 * i_) * 16u); } while (0)
#define IDX_LSTORE(buf_) do { int tl_ = F.tid; asm volatile("" : "+v"(tl_)); _Pragma("unroll") for (int i_ = 0; i_ < 4; ++i_) { const int c_ = tl_ + 512 * i_; *(LAS u32x4*)(lds + (buf_) * CHB + (c_ >> 3) * 144 + (c_ & 7) * 16) = stg[i_]; } } while (0)
#define IDX_MMA(af_, wl_, orow_, kt_) do { f32x16 a; _Pragma("unroll") for (int i = 0; i < 16; ++i) a[i] = 0.f; _Pragma("unroll") for (int ks = 0; ks < 4; ++ks) a = MFMA32(af_[ks], kf[ks], a); \
          float s0_ = 0.f, s1_ = 0.f; _Pragma("unroll") for (int i = 0; i < 16; i += 2) { s0_ += wl_[i] * fmaxf(a[i], 0.f); s1_ += wl_[i + 1] * fmaxf(a[i + 1], 0.f); } orow_[32 * (kt_)] = s0_ + s1_; } while (0)
    __syncthreads();
    IDX_GLOAD(0); IDX_LSTORE(0);
    __syncthreads();
    for (int c = 0; c < nch; ++c) {
        if (c + 1 < nch) IDX_GLOAD(c + 1);
        const LAS unsigned char* kb = lds + (c & 1) * CHB + r * 144 + 16 * h;
        for (int t = 0; t < 8; ++t) { const int kt = 8 * c + t; if (kt >= nktB) break;
            bf16x8 kf[4];
#pragma unroll
            for (int ks = 0; ks < 4; ++ks) kf[ks] = *(const LAS bf16x8*)(kb + t * (32 * 144) + 32 * ks);
            IDX_MMA(afB, wlB, orowB, kt);
            if (kt < nktA) IDX_MMA(afA, wlA, orowA, kt);
        }
        if (c + 1 < nch) IDX_LSTORE((c + 1) & 1);
        __syncthreads();
    }
#undef IDX_GLOAD
#undef IDX_LSTORE
#undef IDX_MMA
    asm volatile("s_waitcnt vmcnt(0)" ::: "memory");
    { const int r0 = b * S + tA, r1 = r0 + 1, r2 = b * S + tB, r3 = r2 + 1;
      float ua[64], ub[64];
      select_load(F, r0, ua);
      select_load(F, r1, ub); select_row(F, r0, ua);
      select_load(F, r2, ua); select_row(F, r1, ub);
      select_load(F, r3, ub); select_row(F, r2, ua);
      select_row(F, r3, ub); }
}
DI void idx_phase(const Frame& F) {
    for (int j = F.bid; j < 256; j += F.G) idx_item(F, j >> 7, j & 127);
}
DI float wave_max(float v) {
#pragma unroll
    for (int o = 1; o < 64; o <<= 1) v = fmaxf(v, __shfl_xor(v, o));
    return v;
}
DI void select_load(const Frame& F, int row, float (&u)[64]) {
    const float* sc = wsp<float>(F, WS_SC);
    const int lane = F.lane, t = row & (S - 1), ng = (t + 512) >> 9;
    const float* srow = sc + (size_t)row * S;
    { const float* p0 = srow + lane; asm volatile("" : "+v"(p0));
#pragma unroll
      for (int e = 0; e < 32; ++e) u[e] = p0[64 * e]; }
    if (ng > 4) { const float* p1 = srow + 2048 + lane; asm volatile("" : "+v"(p1));
#pragma unroll
      for (int e = 0; e < 32; ++e) u[32 + e] = p1[64 * e]; }
}
DI void select_row(const Frame& F, int row, float (&u)[64]) {
    unsigned* mask = wsp<unsigned>(F, WS_MASK);
    const int lane = F.lane;
    {
        const int t = row & (S - 1), n = t + 1, ng = (n + 511) >> 9;
        float vmax = -__builtin_inff(), vmin = __builtin_inff();
        const int gfull = n >> 9;
#pragma unroll
        for (int g = 0; g < 8; ++g) {
            if (g < gfull) {
#pragma unroll
                for (int k = 0; k < 8; ++k) { const int e = 8 * g + k; vmax = fmaxf(vmax, u[e]); vmin = fminf(vmin, u[e]); }
            } else if (g < ng) {
#pragma unroll
                for (int k = 0; k < 8; ++k) { const int e = 8 * g + k, key = 64 * e + lane; const bool ok = key <= t; const float rv = u[e]; u[e] = ok ? rv : -__builtin_inff(); vmax = fmaxf(vmax, u[e]); vmin = fminf(vmin, ok ? rv : __builtin_inff()); }
            } else {
#pragma unroll
                for (int k = 0; k < 8; ++k) u[8 * g + k] = -__builtin_inff();
            }
        }
        float thr = -__builtin_inff();
        if (n > 256) {
            float lo = -wave_max(-vmin), hi = wave_max(vmax);
            { const unsigned hb = __builtin_bit_cast(unsigned, hi); hi = __builtin_bit_cast(float, (hi > 0.f) ? hb + 1u : (hi < 0.f ? hb - 1u : 1u)); }
            thr = lo;
            for (int it = 0; it < 64; ++it) {
                const float mid = lo + 0.5f * (hi - lo);
                if (!(mid > lo) || !(mid < hi)) break;
                int cnt = 0;
#pragma unroll
                for (int g = 0; g < 8; ++g) {
                    if (g < ng) {
                        unsigned long long bb[8];
#pragma unroll
                        for (int k = 0; k < 8; ++k) bb[k] = __ballot(u[8 * g + k] >= mid);
                        __builtin_amdgcn_sched_barrier(0);
#pragma unroll
                        for (int k = 0; k < 8; ++k) cnt += __popcll(bb[k]);
                        __builtin_amdgcn_sched_barrier(0);
                    }
                }
                if (cnt >= 256) { lo = mid; thr = mid; } else hi = mid;
                if (cnt == 256) break;
            }
        }
        unsigned mlo = 0u, mhi = 0u;
#pragma unroll
        for (int g = 0; g < 8; ++g) {
            if (g < ng) {
#pragma unroll
                for (int k = 0; k < 8; ++k) { const int e = 8 * g + k; const unsigned long long bal = __ballot(u[e] >= thr && u[e] > -__builtin_inff()); if (lane == e) { mlo = (unsigned)bal; mhi = (unsigned)(bal >> 32); } }
            }
        }
        *(u32x2*)(mask + (size_t)row * 128 + 2 * lane) = (u32x2){mlo, mhi};
    }
}
DI void lru_load_raw(const float* cu, int tid, int b, int ch, int n, f32x4 (&raw)[5]) {
#pragma unroll
    for (int i = 0; i < 5; ++i) { const int c = tid + 512 * i, row = c >> 4, part = c & 15, tr = 128 * ch - 3 + row;
        raw[i] = (f32x4){0.f, 0.f, 0.f, 0.f}; if (c < 131 * 16 && tr >= 0) raw[i] = *(const f32x4*)(cu + (size_t)(b * S + tr) * 1024 + 64 * n + 4 * part); }
}
template <bool FINAL>
DI void lru_unit(const Frame& F, int layer, int b, int ch, int n, f32x4 (&raw)[5], bool has_next, int nb, int nch, bool load_cw) {
    LAS unsigned char* lds = F.lds;
    LAS float* U32 = (LAS float*)lds;
    LAS unsigned char* Ub = lds + 32768;
    LAS float* LA = (LAS float*)(lds + 51200);
    LAS float* IG = (LAS float*)(lds + 83968);
    LAS f32x2* SUM = (LAS f32x2*)(lds + 116736);
    LAS f32x2* PRE = (LAS f32x2*)(lds + 116736 + 4096);
    const float* cu = wsp<float>(F, WS_CU); const int tid = F.tid, lane = F.lane, w = F.wave, t0 = 128 * ch;
    const int gr_ = lane & 31, gh_ = lane >> 5, gt_ = w & 1;
    const bf16* WTg = wsp<bf16>(F, (gt_ ? WS_WX : WS_WA) + (size_t)layer * SZ_WG) + (size_t)n * 4096;
    bf16x8 bfr[2][4]; float bsv[2], splv[2];
#pragma unroll
    for (int et = 0; et < 2; ++et) { const int e = 32 * et + gr_;
#pragma unroll
        for (int ks = 0; ks < 4; ++ks) bfr[et][ks] = *(const bf16x8*)(WTg + (size_t)e * 64 + 16 * ks + 8 * gh_);
        bsv[et] = (gt_ ? inp<float>(F, I_BX) : inp<float>(F, I_BA))[(size_t)layer * 1024 + 64 * n + e];
        splv[et] = inp<float>(F, I_LAM)[(size_t)layer * 1024 + 64 * n + e]; }
    __syncthreads();
    {
        LAS unsigned char* RAW = lds + 51200; LAS float* CW = (LAS float*)(lds + 124928);
#pragma unroll
        for (int i = 0; i < 5; ++i) { const int c = tid + 512 * i; if (c < 131 * 16) *(LAS f32x4*)(RAW + (c >> 4) * 272 + (c & 15) * 16) = raw[i]; }
        if (load_cw && tid < 80) { const int j = tid >> 4, part = tid & 15;
            const float* src = (j < 4) ? inp<float>(F, I_CONVW) + ((size_t)layer * 4 + j) * 1024 + 64 * n + 4 * part : inp<float>(F, I_CONVB) + (size_t)layer * 1024 + 64 * n + 4 * part;
            *(LAS f32x4*)(CW + j * 64 + 4 * part) = *(const f32x4*)src; }
        if (has_next) lru_load_raw(cu, tid, nb, nch, n, raw);
    }
    __syncthreads();
    {
        const LAS unsigned char* RAW = lds + 51200; const LAS float* CW = (const LAS float*)(lds + 124928);
        const int t = tid >> 2, cg = (tid & 3) * 16;
        f32x4 acc4[4];
#pragma unroll
        for (int q = 0; q < 4; ++q) acc4[q] = *(const LAS f32x4*)(CW + 256 + cg + 4 * q);
#pragma unroll
        for (int j = 0; j < 4; ++j)
#pragma unroll
            for (int q = 0; q < 4; ++q) acc4[q] += *(const LAS f32x4*)(RAW + (t + j) * 272 + (cg + 4 * q) * 4) * *(const LAS f32x4*)(CW + j * 64 + cg + 4 * q);
#pragma unroll
        for (int q = 0; q < 4; ++q) *(LAS f32x4*)(U32 + t * 64 + cg + 4 * q) = acc4[q];
        *(LAS u32x4*)(Ub + t * 144 + cg * 2) = pack8(acc4[0], acc4[1]); *(LAS u32x4*)(Ub + t * 144 + cg * 2 + 16) = pack8(acc4[2], acc4[3]);
    }
    __syncthreads();
    {
        const int r = lane & 31, h = lane >> 5, rt = w >> 1, gt = w & 1;
        bf16x8 af[4];
#pragma unroll
        for (int ks = 0; ks < 4; ++ks) af[ks] = *(const LAS bf16x8*)(Ub + (32 * rt + r) * 144 + (16 * ks + 8 * h) * 2);
#pragma unroll
        for (int et = 0; et < 2; ++et) { const int e = 32 * et + r;
            f32x16 a;
#pragma unroll
            for (int i = 0; i < 16; ++i) a[i] = 0.f;
#pragma unroll
            for (int ks = 0; ks < 4; ++ks) a = MFMA32(af[ks], bfr[et][ks], a);
            const float bs = bsv[et];
            float spl = 0.f; if (gt == 0) spl = -8.0f * log1pf(expf(-splv[et]));
#pragma unroll
            for (int i = 0; i < 16; ++i) { const int tok = 32 * rt + (i & 3) + 8 * (i >> 2) + 4 * h; const float sg = frcp(1.0f + __expf(-(a[i] + bs)));
                if (gt == 0) LA[tok * 64 + e] = sg * spl; else IG[tok * 64 + e] = sg; } }
    }
    __syncthreads();
    float hloc[16], acum[16]; float hl = 0.f, ac = 1.f;
#pragma unroll
    for (int tt = 0; tt < 16; ++tt) { const int tok = 16 * w + tt; const float la = LA[tok * 64 + lane]; const float a = ex2(la * LOG2E); const float y2 = 2.0f * la;
        const float em = (y2 > -0.25f) ? -y2 * (1.0f + y2 * (0.5f + y2 * (0.16666667f + y2 * (0.041666668f + y2 * (0.0083333338f + y2 * 0.0013888889f))))) : 1.0f - a * a;
        const float mult = __builtin_sqrtf(em);
        const float xin = mult * IG[tok * 64 + lane] * U32[tok * 64 + lane]; hl = a * hl + xin; ac *= a; hloc[tt] = hl; acum[tt] = ac; }
    SUM[w * 64 + lane] = (f32x2){ac, hl};
    const f32x2* lsum = wsp<f32x2>(F, WS_LSUM); const int c = 64 * n + lane;
    if (FINAL) {
        float A = 1.f, H = 0.f;
#pragma unroll
        for (int q = 0; q < 4; ++q) { const int j = 4 * w + q; if (j < ch) { const f32x2 sj = lsum[((size_t)(b * 32 + j)) * 1024 + c]; H = sj.x * H + sj.y; A *= sj.x; } }
        PRE[w * 64 + lane] = (f32x2){A, H};
    }
    __syncthreads();
    float cin = 0.f;
    if (FINAL) {
#pragma unroll
        for (int q = 0; q < 8; ++q) { const f32x2 pq = PRE[q * 64 + lane]; cin = pq.x * cin + pq.y; }
    }
    float cw = cin, atot = 1.f, aw = 1.f;
#pragma unroll
    for (int q = 0; q < 8; ++q) { const f32x2 sq = SUM[q * 64 + lane]; if (q < w) { cw = sq.x * cw + sq.y; aw *= sq.x; } atot *= sq.x; }
    if (FINAL) {
        const bf16* G = wsp<bf16>(F, WS_G); bf16* mix = wsp<bf16>(F, WS_MIX);
#pragma unroll
        for (int tt = 0; tt < 16; ++tt) { const size_t o = (size_t)(b * S + t0 + 16 * w + tt) * 4096 + 2048 + c; const float hv = hloc[tt] + acum[tt] * cw; mix[o] = f2bf(hv * bf2f(G[o])); }
    } else {
        unsigned* hl32 = wsp<unsigned>(F, WS_HL);
#pragma unroll
        for (int tt = 0; tt < 16; ++tt) hl32[(size_t)(b * S + t0 + 16 * w + tt) * 1024 + c] = pk2(hloc[tt] + acum[tt] * cw, acum[tt] * aw);
        if (w == 7) { const f32x2 s7 = SUM[7 * 64 + lane]; wsp<f32x2>(F, WS_LSUM)[((size_t)(b * 32 + ch)) * 1024 + c] = (f32x2){atot, s7.x * cw + s7.y}; }
    }
}
DI void lru_final_phase(const Frame& F) {
    const f32x2* lsum = wsp<f32x2>(F, WS_LSUM); const unsigned* hl32 = wsp<unsigned>(F, WS_HL); const bf16* G = wsp<bf16>(F, WS_G); bf16* mix = wsp<bf16>(F, WS_MIX);
    LAS float* car = (LAS float*)F.lds;
    for (int u = F.bid; u < 256; u += F.G) {
        const int b = u >> 7, ch = (u >> 2) & 31, cq = u & 3;
        __syncthreads();
        if (F.tid < 256) { const int c = 256 * cq + F.tid; float H = 0.f;
            for (int j = 0; j < ch; ++j) { const f32x2 sj = lsum[((size_t)(b * 32 + j)) * 1024 + c]; H = sj.x * H + sj.y; }
            car[F.tid] = H; }
        __syncthreads();
        const int cg = F.tid & 31, tl = F.tid >> 5, c0 = 256 * cq + 8 * cg;
        float cr[8];
#pragma unroll
        for (int k = 0; k < 8; ++k) cr[k] = car[8 * cg + k];
#pragma unroll
        for (int i = 0; i < 8; ++i) { const size_t row = (size_t)(b * S + 128 * ch + tl + 16 * i);
            const u32x4 p0 = *(const u32x4*)(hl32 + row * 1024 + c0), p1 = *(const u32x4*)(hl32 + row * 1024 + c0 + 4); const u32x4 g = *(const u32x4*)(G + row * 4096 + 2048 + c0);
            float y[8];
            y[0] = (bflo(p0.x) + bfhi(p0.x) * cr[0]) * bflo(g.x); y[1] = (bflo(p0.y) + bfhi(p0.y) * cr[1]) * bfhi(g.x); y[2] = (bflo(p0.z) + bfhi(p0.z) * cr[2]) * bflo(g.y); y[3] = (bflo(p0.w) + bfhi(p0.w) * cr[3]) * bfhi(g.y);
            y[4] = (bflo(p1.x) + bfhi(p1.x) * cr[4]) * bflo(g.z); y[5] = (bflo(p1.y) + bfhi(p1.y) * cr[5]) * bfhi(g.z); y[6] = (bflo(p1.z) + bfhi(p1.z) * cr[6]) * bflo(g.w); y[7] = (bflo(p1.w) + bfhi(p1.w) * cr[7]) * bfhi(g.w);
            *(u32x4*)(mix + row * 4096 + 2048 + c0) = (u32x4){pk2(y[0], y[1]), pk2(y[2], y[3]), pk2(y[4], y[5]), pk2(y[6], y[7])}; }
    }
}
template <bool FINAL> DI void lru_phase(const Frame& F, int layer) {
    int u0, ustep, uend;
    if (F.G == 256) { if (F.bid < 192) { u0 = F.bid; ustep = 192; uend = 576; } else { u0 = 576 + (F.bid - 192); ustep = 64; uend = 1024; } }
    else { u0 = F.bid; ustep = F.G; uend = 1024; }
    f32x4 raw[5]; int nprev = -1;
    if (u0 < uend) lru_load_raw(wsp<float>(F, WS_CU), F.tid, u0 >> 9, (u0 >> 4) & 31, u0 & 15, raw);
    for (int u = u0; u < uend; u += ustep) { const int un = u + ustep, n = u & 15;
        lru_unit<FINAL>(F, layer, u >> 9, (u >> 4) & 31, n, raw, un < uend && (un & 15) == n, un >> 9, (un >> 4) & 31, n != nprev);
        if (un < uend && (un & 15) != n) lru_load_raw(wsp<float>(F, WS_CU), F.tid, un >> 9, (un >> 4) & 31, un & 15, raw);
        nprev = n; }
}

DI float wave_sum(float v) {
#pragma unroll
    for (int o = 1; o < 64; o <<= 1) v += __shfl_xor(v, o);
    return v;
}
DI void ln_phase(const Frame& F, int layer, bool last) {
    const float* z = wsp<float>(F, WS_Z); bf16* xb = wsp<bf16>(F, WS_XB); f32x2* st = wsp<f32x2>(F, WS_XN);
    const float* g = inp<float>(F, I_LNG) + (size_t)layer * D; const float* bb = inp<float>(F, I_LNB) + (size_t)layer * D;
    const int lane = F.lane;
    for (int row = F.bid * NWAVES + F.wave; row < M; row += F.G * NWAVES) {
        const f32x4* zr = (const f32x4*)(z + (size_t)row * D) + lane;
        f32x4 v[16]; float s = 0.f;
#pragma unroll
        for (int j = 0; j < 16; ++j) v[j] = __builtin_nontemporal_load(zr + 64 * j);
#pragma unroll
        for (int j = 0; j < 16; ++j) s += (v[j][0] + v[j][1]) + (v[j][2] + v[j][3]);
        const float mean = wave_sum(s) * (1.0f / D); float s2 = 0.f;
#pragma unroll
        for (int j = 0; j < 16; ++j) { v[j] = v[j] - mean; s2 += (v[j][0] * v[j][0] + v[j][1] * v[j][1]) + (v[j][2] * v[j][2] + v[j][3] * v[j][3]); }
        const float rstd = 1.0f / sqrtf(wave_sum(s2) * (1.0f / D) + LN_EPS);
        if (!last && lane == 0) st[row] = (f32x2){mean, rstd};
#pragma unroll
        for (int j = 0; j < 16; ++j) { const int col = 4 * (lane + 64 * j); const f32x4 gg = *(const f32x4*)(g + col), b4 = *(const f32x4*)(bb + col);
            const f32x4 y = v[j] * rstd * gg + b4;
            if (last) *(f32x4*)(F.out + (size_t)row * D + col) = y;
            else *(u32x2*)(xb + (size_t)row * D + col) = (u32x2){pk2(y[0], y[1]), pk2(y[2], y[3])}; }
    }
}

constexpr int NPH = 1 + 5 * DEPTH;
struct Args { const void* in[20]; float* out; unsigned char* ws; int ph_lo, ph_hi; };
static_assert(sizeof(Args) == 20 * 8 + 8 + 8 + 8, "Args has no padding bytes");

DI Frame make_frame(LAS unsigned char* lds, float* out, unsigned char* ws) {
    Frame F; F.lds = lds;
    int t = threadIdx.x; asm volatile("" : "+v"(t)); F.tid = t; F.lane = t & 63; F.wave = __builtin_amdgcn_readfirstlane(t >> 6);
    int b = blockIdx.x, g = gridDim.x; asm volatile("" : "+s"(b), "+s"(g)); F.bid = b; F.G = g;
    F.out = out; F.ws = ws;
    return F;
}
__global__ void __launch_bounds__(NTHR, 2) hybrid_fwd(Args args) {
    extern __shared__ __attribute__((aligned(16))) unsigned char lds_raw[];
    LAS unsigned char* lds = (LAS unsigned char*)lds_raw;
    volatile LAS unsigned* MISC = (volatile LAS unsigned*)(lds + MISC_OFF);
    for (int u = threadIdx.x; u < (LDS_BYTES - LDSCTL_OFF) / 4; u += NTHR) ((LAS unsigned*)(lds + LDSCTL_OFF))[u] = 0u;
    __syncthreads();
    if (threadIdx.x == 0) { LAS unsigned long long* tb = (LAS unsigned long long*)(lds + PTR_OFF);
#define PUT(k) tb[k] = (unsigned long long)args.in[k];
        PUT(0) PUT(1) PUT(2) PUT(3) PUT(4) PUT(5) PUT(6) PUT(7) PUT(8) PUT(9) PUT(10) PUT(11) PUT(12) PUT(13) PUT(14) PUT(15) PUT(16) PUT(17) PUT(18) PUT(19)
#undef PUT
    }
    __syncthreads();
    XcdBarrier bar; bar.bar = (unsigned*)(args.ws + WS_CTL) + CW_BAR; bar.x = 0; bar.st = nullptr;
    if (MK_N_LAUNCHES == 1) bar = xcd_barrier_post((unsigned*)(args.ws + WS_CTL) + CW_BAR, MISC + 8);
#define GRID_BAR() do { if (MK_N_LAUNCHES == 1) xcd_barrier(bar); } while (0)
#define FRAME() const Frame F = make_frame(lds, args.out, args.ws)
    const int lo = args.ph_lo, hi = args.ph_hi;
#define IN(k) (lo <= (k) && (k) < hi)
#define BOTH(k) (IN(k) && IN((k) + 1))

    if (EN(0) && IN(0)) REPS(0) { FRAME(); p0_prologue(F); }
    if (BOTH(0)) GRID_BAR();

    for (int l = 0; l < DEPTH; ++l) {
        const int base = 1 + 5 * l;
        if (IN(base)) {
            const int GA = (l + 1 < DEPTH) ? (int)gridDim.x - 32 : (int)gridDim.x;
            if ((int)blockIdx.x < GA) {
            if (EN(1)) REPS(1) { FRAME(); pg8::Gemm g{wsp<bf16>(F, WS_XB), wsp<bf16>(F, WS_WIN + (size_t)l * SZ_WIN), D, D, D}; pg8::TileOrder So; So.init(M / 256, NT_IN, GA, F.bid);
              EpiA E{F.ws};
              pg8::gemm_phase<EpiA, pg8::TileOrder, true, true>(F.lds, g, So, E); }
            if (EN(2)) REPS(2) { FRAME(); const int r5 = (M / 256) * NT_IN - 5 * GA;
              pg8::Gemm g{wsp<bf16>(F, WS_MEMB), wsp<bf16>(F, WS_WMKV + (size_t)l * SZ_WMKV), D, D, D}; pg8::TileOrder So; So.init(2, 8, GA, (F.bid + GA - r5) % GA);
              EpiMemKV E{F.ws};
              pg8::gemm_phase<EpiMemKV, pg8::TileOrder, true, true>(F.lds, g, So, E); }
            } else if (EN(14)) { FRAME(); if (l == 0) { conv_layer(F, 0, GA, I_IN, I_IN + I_O + I_UQ + I_UKV); conv_layer(F, 0, GA, I_IN + I_O + I_UQ + I_UKV + 2 * I_MK, I_LAYER); } conv_layer(F, l + 1, GA, 0, I_LAYER); }
        }
        if (BOTH(base)) GRID_BAR();
        if (IN(base + 1)) {
            if (EN(3)) REPS(3) { FRAME(); pg8::Gemm g{wsp<bf16>(F, WS_CQ), wsp<bf16>(F, WS_WUQ + (size_t)l * SZ_WUQ), 1024, 1024, 1024}; pg8::TileOrder So; So.init(M / 256, 6, F.G, F.bid);
              EpiUQ E{F.ws};
              pg8::gemm_phase<EpiUQ, pg8::TileOrder, true, true>(F.lds, g, So, E); }
            if (EN(4)) REPS(4) { FRAME(); pg8::Gemm g{wsp<bf16>(F, WS_CKV), wsp<bf16>(F, WS_WUKV + (size_t)l * SZ_WUKV), 512, 512, 512}; pg8::TileOrder So; So.init(M / 256, 8, F.G, F.bid);
              EpiUKV E{F.ws};
              pg8::gemm_phase<EpiUKV, pg8::TileOrder, true, true>(F.lds, g, So, E); }
            if (EN(5)) REPS(5) { FRAME(); idx_phase(F); }
            if (EN(6)) REPS(6) { FRAME(); mem_phase(F); }
            if (EN(7)) REPS(7) { FRAME(); lru_phase<false>(F, l); }
        }
        if (BOTH(base + 1)) GRID_BAR();
        if (IN(base + 2)) { if (EN(8)) REPS(8) { FRAME(); mla_phase(F); } if (EN(11)) REPS(11) { FRAME(); dsa_phase(F); } if (EN(10)) REPS(10) { FRAME(); lru_final_phase(F); } }
        if (BOTH(base + 2)) GRID_BAR();
        if (EN(12) && IN(base + 3)) REPS(12) {
            FRAME(); pg8::Gemm g{wsp<bf16>(F, WS_MIX), wsp<bf16>(F, WS_WO + (size_t)l * SZ_WO), D, D, D}; pg8::TileOrder So; So.init(M / 256, D / 256, F.G, F.bid);
            EpiO E{l == 0 ? inp<float>(F, I_X) : nullptr, inp<float>(F, I_LNG) + (size_t)(l > 0 ? l - 1 : 0) * D, inp<float>(F, I_LNB) + (size_t)(l > 0 ? l - 1 : 0) * D, F.ws};
            pg8::gemm_phase<EpiO, pg8::TileOrder, true, true>(F.lds, g, So, E);
        }
        if (BOTH(base + 3)) GRID_BAR();
        if (EN(13) && IN(base + 4)) REPS(13) { FRAME(); ln_phase(F, l, l == DEPTH - 1); }
        if (BOTH(base + 4)) GRID_BAR();
    }
#undef IN
#undef BOTH
}

extern "C" void kernel_launch(void* const* d_in, const int* in_sizes, int n_in, void* d_out, int out_size, void* d_ws, size_t ws_size, hipStream_t stream) {
    static int grid = 0;
    if (grid == 0) {
        if (n_in != 20 || out_size != M * D || ws_size < WS_END) { fprintf(stderr, "kernel_launch: unexpected shapes (n_in %d, out %d, ws %zu, need %zu)\n", n_in, out_size, ws_size, (size_t)WS_END); grid = -1; return; }
        int dev = 0, cus = 0, per_cu = 0;
        if (hipGetDevice(&dev) != hipSuccess || hipDeviceGetAttribute(&cus, hipDeviceAttributeMultiprocessorCount, dev) != hipSuccess) { grid = -1; return; }
        if (hipFuncSetAttribute((const void*)hybrid_fwd, hipFuncAttributeMaxDynamicSharedMemorySize, LDS_BYTES) != hipSuccess) { fprintf(stderr, "kernel_launch: hipFuncSetAttribute failed\n"); grid = -1; return; }
        if (hipOccupancyMaxActiveBlocksPerMultiprocessor(&per_cu, (const void*)hybrid_fwd, NTHR, LDS_BYTES) != hipSuccess || per_cu < 1) fprintf(stderr, "kernel_launch: occupancy query reports %d\n", per_cu);
        (void)hipGetLastError();
        grid = cus;
    }
    if (grid < 0) return;
    if (hipMemsetAsync((char*)d_ws + WS_CTL, 0, CTL_ZERO_BYTES, stream) != hipSuccess) return;
    Args a{};
    for (int i = 0; i < 20; ++i) a.in[i] = d_in[i];
    a.out = (float*)d_out; a.ws = (unsigned char*)d_ws;
#if MK_N_LAUNCHES == 1
    a.ph_lo = 0; a.ph_hi = NPH;
    hipLaunchKernelGGL(hybrid_fwd, dim3(grid), dim3(NTHR), LDS_BYTES, stream, a);
#else
    for (int p = 0; p < NPH; ++p) { a.ph_lo = p; a.ph_hi = p + 1; hipLaunchKernelGGL(hybrid_fwd, dim3(grid), dim3(NTHR), LDS_BYTES, stream, a); }
#endif
}
```
